# Optimizing an MI355X kernel written in HIP

```python
import math
import jax, jax.numpy as jnp
from jax import lax
import numpy as np

D_MODEL = 1024
BATCH = 16
SEQ = 256
DEPTH = 1
DEC_BATCH = 8
DEC_SEQ = 1024
PAST_LEN = 512

GRID_W = 64
ATT_WIDTH = D_MODEL // 2
RNN_WIDTH = D_MODEL - ATT_WIDTH
N_ATT_HEADS = 4
V_HEAD_DIM = ATT_WIDTH // N_ATT_HEADS
QK_HEAD_DIM = V_HEAD_DIM // 2
N_RNN_HEADS = 4
RNN_HEAD_DIM = RNN_WIDTH // N_RNN_HEADS
D_FF = 2816
CONV_W = 3
ROPE_BASE = 10000.0
Q_BLOCK = 128
CHUNK = 16
N_MOD = 6
SPLIT_WIDTHS = (ATT_WIDTH, ATT_WIDTH, ATT_WIDTH, RNN_WIDTH, RNN_WIDTH, RNN_WIDTH, RNN_WIDTH, RNN_WIDTH)
IN_COLS = 3 * ATT_WIDTH + 5 * RNN_WIDTH
DEEPNORM_ALPHA = (2.0 * DEPTH) ** 0.25
DEEPNORM_BETA = (8.0 * DEPTH) ** -0.25
NORM_EPS = 1e-5

kernel_name = 'hybrid_diffattn_hgrn2_dit_step'


def layer_norm(x, g, b):
    xf = x.astype(jnp.float32)
    mu = jnp.mean(xf, axis=-1, keepdims=True)
    var = jnp.mean(jnp.square(xf - mu), axis=-1, keepdims=True)
    y = (xf - mu) * lax.rsqrt(var + NORM_EPS) * g.astype(jnp.float32) + b.astype(jnp.float32)
    return y.astype(x.dtype)


def head_rms_norm(x, g):
    xf = x.astype(jnp.float32)
    y = xf * lax.rsqrt(jnp.mean(xf * xf, axis=-1, keepdims=True) + NORM_EPS)
    return y * g.astype(jnp.float32).reshape(x.shape[-2], x.shape[-1])


def axial_rope(x, rows, cols):
    half = QK_HEAD_DIM // 2
    quarter = half // 2
    freqs = 1.0 / (ROPE_BASE ** (jnp.arange(quarter, dtype=jnp.float32) / quarter))

    def rotate(xa, pos):
        ang = pos.astype(jnp.float32)[:, None] * freqs
        cos = jnp.cos(ang)[None, :, None, None, :].astype(x.dtype)
        sin = jnp.sin(ang)[None, :, None, None, :].astype(x.dtype)
        x1, x2 = xa[..., :quarter], xa[..., quarter:]
        return jnp.concatenate([x1 * cos - x2 * sin, x1 * sin + x2 * cos], axis=-1)

    return jnp.concatenate([rotate(x[..., :half], rows), rotate(x[..., half:], cols)], axis=-1)


def diff_attention(q, k, v, lam):
    b, lq = q.shape[0], q.shape[1]
    nblk = lq // Q_BLOCK
    qb = jnp.moveaxis(q.reshape(b, nblk, Q_BLOCK, N_ATT_HEADS, 2, QK_HEAD_DIM), 1, 0)
    scale = QK_HEAD_DIM ** -0.5

    def block(qblk):
        s = jnp.einsum('bqhmd,bkhmd->bmhqk', qblk, k).astype(jnp.float32) * scale
        p = jax.nn.softmax(s, axis=-1)
        pd = p[:, 0] - lam * p[:, 1]
        return jnp.einsum('bhqk,bkhe->bqhe', pd.astype(v.dtype), v)

    out = lax.map(block, qb)
    return jnp.moveaxis(out, 0, 1).reshape(b, lq, N_ATT_HEADS, V_HEAD_DIM)


def gla_chunk_scan(q, k, v, logf, s0):
    b, l, h, dk = q.shape
    dv = v.shape[-1]
    n = l // CHUNK
    q = q.reshape(b, n, CHUNK, h, dk)
    k = k.reshape(b, n, CHUNK, h, dk)
    logf = logf.reshape(b, n, CHUNK, h, dk)
    v = v.reshape(b, n, CHUNK, h, dv)
    cum = jnp.cumsum(logf, axis=2)
    last = cum[:, :, -1]
    causal = jnp.tril(jnp.ones((CHUNK, CHUNK), dtype=bool))[None, None, :, :, None, None]
    rel = cum[:, :, :, None] - cum[:, :, None, :]
    decay = jnp.where(causal, jnp.exp(jnp.where(causal, rel, 0.0)), 0.0)
    scores = jnp.einsum('bnthd,bntshd,bnshd->bnhts', q, decay, k)
    o_intra = jnp.einsum('bnhts,bnshe->bnthe', scores, v)
    k_end = k * jnp.exp(last[:, :, None] - cum)
    ds = jnp.einsum('bnshd,bnshe->bnhde', k_end, v)
    chunk_decay = jnp.exp(last)

    def step(s, inp):
        dec, d = inp
        return dec[..., None] * s + d, s

    s_final, s_in = lax.scan(step, s0, (jnp.moveaxis(chunk_decay, 1, 0), jnp.moveaxis(ds, 1, 0)))
    s_in = jnp.moveaxis(s_in, 0, 1)
    o_inter = jnp.einsum('bnthd,bnhde->bnthe', q * jnp.exp(cum), s_in)
    return (o_intra + o_inter).reshape(b, l, h, dv), s_final


def hgrn2_bidir(q, i, f_fwd, f_bwd, lb_fwd, lb_bwd, s0_fwd, s0_bwd):
    b, l, _ = q.shape

    def heads(t):
        return t.astype(jnp.float32).reshape(b, l, N_RNN_HEADS, RNN_HEAD_DIM)

    def gates(f_logit, lb):
        f = lb + (1.0 - lb) * jax.nn.sigmoid(f_logit.astype(jnp.float32))
        return heads(1.0 - f), heads(jnp.log(f))

    qh, vh = heads(q), heads(i)
    k_f, logf_f = gates(f_fwd, lb_fwd)
    o_f, s_f = gla_chunk_scan(qh, k_f, vh, logf_f, s0_fwd)
    k_b, logf_b = gates(f_bwd, lb_bwd)
    o_b, s_b = gla_chunk_scan(jnp.flip(qh, 1), jnp.flip(k_b, 1), jnp.flip(vh, 1), jnp.flip(logf_b, 1), s0_bwd)
    return o_f + jnp.flip(o_b, 1), s_f, s_b


def conv_ffn(x, w_up, conv_w, conv_b, w_down):
    h = x @ w_up
    pad = CONV_W // 2
    l = h.shape[1]
    hp = jnp.pad(h, ((0, 0), (pad, pad), (0, 0)))
    h = sum(hp[:, j:j + l] * conv_w[j] for j in range(CONV_W)) + conv_b
    a, u = jnp.split(h, 2, axis=-1)
    return (jax.nn.silu(a) * u) @ w_down


def trunk_layer(x, mod, p, rows=None, cols=None, ctx_k=None, ctx_v=None, s0_fwd=None, s0_bwd=None):
    b, l, _ = x.shape
    shift1, scale1, gate1, shift2, scale2, gate2 = jnp.split(mod, N_MOD, axis=-1)
    xm = x * (1 + scale1) + shift1
    offsets = np.cumsum(SPLIT_WIDTHS)[:-1].tolist()
    aq, ak, av, rq, rf, rb, ri, rg = jnp.split(xm @ p['w_in'], offsets, axis=-1)
    aq = aq.reshape(b, l, N_ATT_HEADS, 2, QK_HEAD_DIM)
    ak = ak.reshape(b, l, N_ATT_HEADS, 2, QK_HEAD_DIM)
    av = av.reshape(b, l, N_ATT_HEADS, V_HEAD_DIM)
    if rows is None:
        keys, vals = ak, av
    else:
        aq = axial_rope(aq, rows, cols)
        keys = jnp.concatenate([ctx_k, axial_rope(ak, rows, cols)], axis=1)
        vals = jnp.concatenate([ctx_v, av], axis=1)
    att = diff_attention(aq, keys, vals, p['lam'])
    att = head_rms_norm(att, p['att_g']) * (1.0 - p['lam_init'])
    if s0_fwd is None:
        s0_fwd = jnp.zeros((b, N_RNN_HEADS, RNN_HEAD_DIM, RNN_HEAD_DIM), jnp.float32)
        s0_bwd = s0_fwd
    rnn, s_fwd, s_bwd = hgrn2_bidir(rq, ri, rf, rb, p['lb_fwd'], p['lb_bwd'], s0_fwd, s0_bwd)
    out_gate = jax.nn.silu(rg.astype(jnp.float32)).reshape(b, l, N_RNN_HEADS, RNN_HEAD_DIM)
    rnn = head_rms_norm(rnn, p['rnn_g']) * out_gate
    mixed = jnp.concatenate([att.reshape(b, l, ATT_WIDTH), rnn.reshape(b, l, RNN_WIDTH)], axis=-1)
    mix = mixed.astype(x.dtype) @ p['w_out']
    x = layer_norm(DEEPNORM_ALPHA * x + gate1 * mix, p['ln1_g'], p['ln1_b'])
    xm2 = x * (1 + scale2) + shift2
    ffn = conv_ffn(xm2, p['w_up'], p['conv_w'], p['conv_b'], p['w_down'])
    x = layer_norm(DEEPNORM_ALPHA * x + gate2 * ffn, p['ln2_g'], p['ln2_b'])
    return x, ak, av, s_fwd, s_bwd


def setup_inputs(seed: int = 0) -> dict:
    key = jax.random.key(seed)
    ks = jax.random.split(key, 27)
    D = D_MODEL

    def nrm(i, shape, s):
        return jax.random.normal(ks[i], shape, jnp.float32) * s

    col_scale = jnp.concatenate([
        jnp.ones((2 * ATT_WIDTH,), jnp.float32),
        jnp.full((ATT_WIDTH,), DEEPNORM_BETA, jnp.float32),
        jnp.ones((3 * RNN_WIDTH,), jnp.float32),
        jnp.full((RNN_WIDTH,), DEEPNORM_BETA, jnp.float32),
        jnp.ones((RNN_WIDTH,), jnp.float32)])
    return {
        'x_prompt': nrm(0, (BATCH, SEQ, D), 1.0),
        'x_sample': nrm(1, (DEC_BATCH, DEC_SEQ, D), 1.0),
        'cache_k': nrm(2, (DEC_BATCH, DEPTH, PAST_LEN, N_ATT_HEADS, 2, QK_HEAD_DIM), 1.0),
        'cache_v': nrm(3, (DEC_BATCH, DEPTH, PAST_LEN, N_ATT_HEADS, V_HEAD_DIM), DEEPNORM_BETA),
        'state_rnn': nrm(4, (DEC_BATCH, DEPTH, 2, N_RNN_HEADS, RNN_HEAD_DIM, RNN_HEAD_DIM), 1.0),
        'c': nrm(5, (DEC_BATCH, D), 1.0),
        'c_ctx': nrm(6, (D,), 1.0),
        'w_ada': nrm(7, (DEPTH, D, N_MOD * D), 0.5 * D ** -0.5),
        'b_ada': nrm(8, (DEPTH, N_MOD * D), 0.01),
        'w_in': nrm(9, (DEPTH, D, IN_COLS), D ** -0.5) * col_scale,
        'lambda_q1': nrm(10, (DEPTH, QK_HEAD_DIM), 0.1),
        'lambda_k1': nrm(11, (DEPTH, QK_HEAD_DIM), 0.1),
        'lambda_q2': nrm(12, (DEPTH, QK_HEAD_DIM), 0.1),
        'lambda_k2': nrm(13, (DEPTH, QK_HEAD_DIM), 0.1),
        'lb_fwd_logits': nrm(14, (DEPTH + 1, RNN_WIDTH), 0.5),
        'lb_bwd_logits': nrm(15, (DEPTH + 1, RNN_WIDTH), 0.5),
        'att_norm_g': 1.0 + nrm(16, (DEPTH, ATT_WIDTH), 0.02),
        'rnn_norm_g': 1.0 + nrm(17, (DEPTH, RNN_WIDTH), 0.02),
        'w_out': nrm(18, (DEPTH, D, D), D ** -0.5 * DEEPNORM_BETA),
        'ln1_g': 1.0 + nrm(19, (DEPTH, D), 0.02),
        'ln1_b': nrm(20, (DEPTH, D), 0.02),
        'w_up': nrm(21, (DEPTH, D, 2 * D_FF), D ** -0.5),
        'conv_w': nrm(22, (DEPTH, CONV_W, 2 * D_FF), 0.5),
        'conv_b': nrm(23, (DEPTH, 2 * D_FF), 0.02),
        'w_down': nrm(24, (DEPTH, D_FF, D), D_FF ** -0.5 * DEEPNORM_BETA),
        'ln2_g': 1.0 + nrm(25, (DEPTH, D), 0.02),
        'ln2_b': nrm(26, (DEPTH, D), 0.02),
    }


def reference(x_prompt, x_sample, cache_k, cache_v, state_rnn, c, c_ctx, w_ada, b_ada, w_in,
              lambda_q1, lambda_k1, lambda_q2, lambda_k2, lb_fwd_logits, lb_bwd_logits,
              att_norm_g, rnn_norm_g, w_out, ln1_g, ln1_b, w_up, conv_w, conv_b, w_down,
              ln2_g, ln2_b):
    n_rows = x_sample.shape[1] // GRID_W
    t = jnp.arange(n_rows * GRID_W)
    rows = t // GRID_W
    cols = t % GRID_W
    lb_fwd = jnp.cumsum(jax.nn.softmax(lb_fwd_logits.astype(jnp.float32), axis=0), axis=0)
    lb_bwd = jnp.cumsum(jax.nn.softmax(lb_bwd_logits.astype(jnp.float32), axis=0), axis=0)

    y_p, y_s = x_prompt, x_sample
    new_k, new_v, new_s = [], [], []
    for l in range(DEPTH):
        lam_init = 0.8 - 0.6 * math.exp(-0.3 * l)
        lam = (jnp.exp(jnp.sum(lambda_q1[l].astype(jnp.float32) * lambda_k1[l].astype(jnp.float32)))
               - jnp.exp(jnp.sum(lambda_q2[l].astype(jnp.float32) * lambda_k2[l].astype(jnp.float32)))
               + lam_init)
        p = {'w_in': w_in[l], 'lam': lam, 'lam_init': lam_init, 'lb_fwd': lb_fwd[l], 'lb_bwd': lb_bwd[l],
             'att_g': att_norm_g[l], 'rnn_g': rnn_norm_g[l], 'w_out': w_out[l],
             'ln1_g': ln1_g[l], 'ln1_b': ln1_b[l], 'w_up': w_up[l], 'conv_w': conv_w[l],
             'conv_b': conv_b[l], 'w_down': w_down[l], 'ln2_g': ln2_g[l], 'ln2_b': ln2_b[l]}
        mod_ctx = (jax.nn.silu(c_ctx) @ w_ada[l] + b_ada[l])[None, None, :]
        mod_lat = (jax.nn.silu(c) @ w_ada[l] + b_ada[l])[:, None, :]
        y_p, k_l, v_l, sf_l, sb_l = trunk_layer(y_p, mod_ctx, p)
        new_k.append(k_l)
        new_v.append(v_l)
        new_s.append(jnp.stack([sf_l, sb_l], axis=1).astype(x_prompt.dtype))
        y_s, _, _, _, _ = trunk_layer(y_s, mod_lat, p, rows, cols, cache_k[:, l], cache_v[:, l],
                                      state_rnn[:, l, 0].astype(jnp.float32),
                                      state_rnn[:, l, 1].astype(jnp.float32))
    new_cache_k = jnp.stack(new_k, axis=1)
    new_cache_v = jnp.stack(new_v, axis=1)
    new_state_rnn = jnp.stack(new_s, axis=1)
    return (y_p, y_s, new_cache_k, new_cache_v, new_state_rnn)
```

```cpp
#include <hip/hip_runtime.h>
#include <cstdio>
#include <cstdint>
#define MK_N_LAUNCHES 10
namespace pg8 {
#define PG8_LAS __attribute__((address_space(3)))
typedef unsigned short bf16_t;
typedef short bf16x8 __attribute__((ext_vector_type(8)));
typedef float f32x4 __attribute__((ext_vector_type(4)));
typedef unsigned u32x4 __attribute__((ext_vector_type(4)));
constexpr int BM = 256, BK = 64, HALF = 128, HTB = HALF * BK * 2  , STAGE_BYTES = 8 * HTB, NXCD = 8, WGM = 8;

__host__ __device__ __forceinline__ int lds_byte(int r, int c) { const int st = (r >> 4) * 2 + (c >> 5), rr = r & 15, cc = c & 31, ob = rr * 64 + cc * 2; return st * 1024 + (ob ^ (((ob >> 9) & 1) << 5)); }
__host__ __device__ __forceinline__ void stage_rc(int b, int& R, int& C) { const int st = b / 1024, sb = b % 1024, swz = sb ^ (((sb >> 9) & 1) << 5); R = (st >> 1) * 16 + swz / 64; C = (st & 1) * 32 + (swz % 64) / 2; }
__host__ __device__ __forceinline__ int perm32(int rho) { const int n = rho >> 4, i = rho & 15; return 8 * (i >> 2) + 4 * n + (i & 3); }

struct Unit { int pm, pn; };
struct Gemm { const bf16_t* A; const bf16_t* Bt; int M, N, K; };

struct StaticOrder {
    int nM, nN, nwg, G, c;
    __host__ __device__ void init(int M, int N, int G_, int c_) { nM = M / BM; nN = N / BM; nwg = nM * nN; G = G_; c = c_; }
    __host__ __device__ bool next(int i, Unit& u) const {
        const long L = (long)i * G + c; if (L >= nwg) return false;
        int wgid = (int)L; { const int q = nwg / NXCD, r = nwg % NXCD, xcd = wgid % NXCD, off = wgid / NXCD; wgid = (xcd < r ? xcd * (q + 1) : r * (q + 1) + (xcd - r) * q) + off; }
        const int nig = WGM * nN, gid = wgid / nig, fm = gid * WGM, gsz = (nM - fm) < WGM ? (nM - fm) : WGM;
        u.pm = fm + ((wgid % nig) % gsz); u.pn = (wgid % nig) / gsz; return true;
    }
    __device__ __forceinline__ void a_ready(const Unit&) const {}
    __device__ __forceinline__ void done(const Unit&) const {}
};

__device__ __forceinline__ unsigned cvt_pk_bf16(float lo, float hi) { unsigned r; asm volatile("v_cvt_pk_bf16_f32 %0, %1, %2" : "=v"(r) : "v"(lo), "v"(hi)); return r; }
typedef float f32x2 __attribute__((ext_vector_type(2)));
template <class Epi, class Sched, bool ALIGN_EPI = false, bool SP2 = false>
__device__ __forceinline__ void gemm_phase(PG8_LAS unsigned char* lds, const Gemm g, const Sched& S, const Epi& E) {
    const int tid = threadIdx.x, wid = __builtin_amdgcn_readfirstlane(tid >> 6), lane = tid & 63, wr = wid >> 2, wc = wid & 3, fr = lane & 15, fq = lane >> 4;
    const int K = g.K, nt = K / BK;
    unsigned voffA[2], voffB[2];
#pragma unroll
    for (int i = 0; i < 2; ++i) { int R, C; stage_rc(tid * 16 + i * 8192, R, C); const int Rb = Epi::PERM ? ((R & ~31) + perm32(R & 31)) : R;
        voffA[i] = (unsigned)(R * K + C) * 2u; voffB[i] = (unsigned)(Rb * K + C) * 2u; }
    const size_t kstep = (size_t)(BK * 2);
    const size_t hstep = (size_t)HALF * K * 2;
    const size_t tstep = 2 * hstep;
    const unsigned ldsw = (unsigned)wid * 1024u;
    const int aoff = lds_byte(wr * 64 + fr, fq * 8), boff = lds_byte(wc * 32 + fr, fq * 8);
#define PG8_SA(b, h) (((b) * 2 + (h)) * HTB)
#define PG8_SB(b, h) ((4 + (b) * 2 + (h)) * HTB)
#define PG8_STAGE(bufoff, gbase, voff) do { _Pragma("unroll") for (int _i = 0; _i < 2; ++_i) \
        __builtin_amdgcn_global_load_lds((const unsigned*)((const char*)(gbase) + (voff)[_i]), (PG8_LAS unsigned*)(lds + (bufoff) + ldsw + _i * 8192), 16, 0, 0); } while (0)
#define PG8_LDA(dst, b, h) do { _Pragma("unroll") for (int m = 0; m < 4; ++m) _Pragma("unroll") for (int k = 0; k < 2; ++k) dst[m][k] = *(const PG8_LAS bf16x8*)(lds + PG8_SA(b, h) + aoff + m * 2048 + k * 1024); } while (0)
#define PG8_LDB(dst, b, h) do { _Pragma("unroll") for (int n = 0; n < 2; ++n) _Pragma("unroll") for (int k = 0; k < 2; ++k) dst[n][k] = *(const PG8_LAS bf16x8*)(lds + PG8_SB(b, h) + boff + n * 2048 + k * 1024); } while (0)
#define PG8_MMA(ai, bj, At, Bt) do { __builtin_amdgcn_s_setprio(1); _Pragma("unroll") for (int m = 0; m < 4; ++m) _Pragma("unroll") for (int n = 0; n < 2; ++n) _Pragma("unroll") for (int k = 0; k < 2; ++k) \
        acc[ai][bj][m][n] = __builtin_amdgcn_mfma_f32_16x16x32_bf16(Bt[n][k], At[m][k], acc[ai][bj][m][n], 0, 0, 0); __builtin_amdgcn_s_setprio(0); } while (0)
#define PG8_WAIT_V(n) asm volatile("s_waitcnt vmcnt(" #n ")" ::: "memory")
#define PG8_WAIT_L(n) asm volatile("s_waitcnt lgkmcnt(" #n ")" ::: "memory")
#define PG8_BAR __builtin_amdgcn_s_barrier()
#define PG8_SCHED __builtin_amdgcn_sched_barrier(0)
    Unit cur, nxt; int ui = 0;
    if (!S.next(0, cur)) return;
    f32x4 acc[2][2][4][2];
#pragma unroll
    for (int a = 0; a < 2; ++a)
#pragma unroll
        for (int b = 0; b < 2; ++b)
#pragma unroll
            for (int m = 0; m < 4; ++m)
#pragma unroll
                for (int n = 0; n < 2; ++n) acc[a][b][m][n] = (f32x4){0.f, 0.f, 0.f, 0.f};
    bf16x8 At[4][2], B0[2][2], B1[2][2];
    const char* cA = (const char*)g.A + (size_t)cur.pm * tstep; const char* cB = (const char*)g.Bt + (size_t)cur.pn * tstep;
    S.a_ready(cur);
    if constexpr (SP2) {
        PG8_STAGE(PG8_SB(0, 0), cB, voffB); PG8_STAGE(PG8_SB(0, 1), cB + hstep, voffB); PG8_STAGE(PG8_SA(0, 0), cA, voffA); PG8_STAGE(PG8_SA(0, 1), cA + hstep, voffA);
        if (wr == 1) PG8_BAR;
        PG8_WAIT_V(2); PG8_BAR;
        PG8_STAGE(PG8_SB(1, 0), cB + kstep, voffB); PG8_STAGE(PG8_SA(1, 0), cA + kstep, voffA); PG8_STAGE(PG8_SB(1, 1), cB + hstep + kstep, voffB);
        PG8_WAIT_V(6); PG8_BAR;
    } else {
        PG8_STAGE(PG8_SB(0, 0), cB, voffB); PG8_STAGE(PG8_SA(0, 0), cA, voffA); PG8_STAGE(PG8_SB(0, 1), cB + hstep, voffB); PG8_STAGE(PG8_SA(0, 1), cA + hstep, voffA);
        if (wr == 1) PG8_BAR;
        PG8_WAIT_V(4); PG8_BAR;
        PG8_STAGE(PG8_SB(1, 0), cB + kstep, voffB); PG8_STAGE(PG8_SA(1, 0), cA + kstep, voffA); PG8_STAGE(PG8_SB(1, 1), cB + hstep + kstep, voffB);
        PG8_WAIT_V(6); PG8_BAR;
    }
    for (;;) {
        const bool has_next = S.next(ui + 1, nxt);
        const char* nA = has_next ? (const char*)g.A + (size_t)nxt.pm * tstep : cA; const char* nB = has_next ? (const char*)g.Bt + (size_t)nxt.pn * tstep : cB;
        for (int t = 0; t < nt; t += 2) {
            const bool last = (t == nt - 2);
            const char* a1 = cA + (size_t)(t + 1) * kstep;
            const char* a2 = last ? nA : cA + (size_t)(t + 2) * kstep; const char* b2 = last ? nB : cB + (size_t)(t + 2) * kstep;
            const char* a3 = a2 + kstep; const char* b3 = b2 + kstep;
            if (last && has_next) S.a_ready(nxt);
            if constexpr (SP2) {
            PG8_LDB(B0, 0, 0); PG8_LDB(B1, 0, 1); PG8_SCHED; PG8_LDA(At, 0, 0); PG8_STAGE(PG8_SA(1, 1), a1 + hstep, voffA);
            PG8_WAIT_V(8); PG8_WAIT_L(0); PG8_BAR; PG8_MMA(0, 0, At, B0); PG8_MMA(0, 1, At, B1); PG8_BAR; PG8_SCHED;
            PG8_LDA(At, 0, 1); PG8_STAGE(PG8_SB(0, 0), b2, voffB); PG8_STAGE(PG8_SB(0, 1), b2 + hstep, voffB); PG8_STAGE(PG8_SA(0, 0), a2, voffA);
            PG8_WAIT_V(8); PG8_WAIT_L(0); PG8_BAR; PG8_MMA(1, 0, At, B0); PG8_MMA(1, 1, At, B1); PG8_BAR; PG8_SCHED;
            PG8_LDB(B0, 1, 0); PG8_LDB(B1, 1, 1); PG8_SCHED; PG8_LDA(At, 1, 0); PG8_STAGE(PG8_SA(0, 1), a2 + hstep, voffA);
            PG8_WAIT_V(8); PG8_WAIT_L(0); PG8_BAR; PG8_MMA(0, 0, At, B0); PG8_MMA(0, 1, At, B1); PG8_BAR; PG8_SCHED;
            PG8_LDA(At, 1, 1); PG8_STAGE(PG8_SB(1, 0), b3, voffB); PG8_STAGE(PG8_SB(1, 1), b3 + hstep, voffB); PG8_STAGE(PG8_SA(1, 0), a3, voffA);
            PG8_WAIT_V(8); PG8_WAIT_L(0); PG8_BAR; PG8_MMA(1, 0, At, B0); PG8_MMA(1, 1, At, B1); PG8_BAR; PG8_SCHED;
            } else {
            PG8_LDB(B0, 0, 0); PG8_SCHED; PG8_LDA(At, 0, 0); PG8_STAGE(PG8_SA(1, 1), a1 + hstep, voffA);
            PG8_WAIT_L(8); PG8_BAR; PG8_WAIT_L(0); PG8_MMA(0, 0, At, B0); PG8_BAR; PG8_SCHED;
            PG8_LDB(B1, 0, 1); PG8_STAGE(PG8_SB(0, 0), b2, voffB);
            PG8_BAR; PG8_WAIT_L(0); PG8_MMA(0, 1, At, B1); PG8_BAR;
            PG8_LDA(At, 0, 1); PG8_STAGE(PG8_SA(0, 0), a2, voffA);
            PG8_BAR; PG8_WAIT_L(0); PG8_MMA(1, 0, At, B0); PG8_BAR; PG8_SCHED;
            PG8_STAGE(PG8_SB(0, 1), b2 + hstep, voffB);
            PG8_WAIT_V(6); PG8_BAR; PG8_MMA(1, 1, At, B1); PG8_BAR;
            PG8_LDB(B0, 1, 0); PG8_SCHED; PG8_LDA(At, 1, 0); PG8_STAGE(PG8_SA(0, 1), a2 + hstep, voffA);
            PG8_WAIT_L(8); PG8_BAR; PG8_WAIT_L(0); PG8_MMA(0, 0, At, B0); PG8_BAR; PG8_SCHED;
            PG8_LDB(B1, 1, 1); PG8_STAGE(PG8_SB(1, 0), b3, voffB);
            PG8_BAR; PG8_WAIT_L(0); PG8_MMA(0, 1, At, B1); PG8_BAR;
            PG8_LDA(At, 1, 1); PG8_STAGE(PG8_SA(1, 0), a3, voffA);
            PG8_BAR; PG8_WAIT_L(0); PG8_MMA(1, 0, At, B0); PG8_BAR; PG8_SCHED;
            PG8_STAGE(PG8_SB(1, 1), b3 + hstep, voffB);
            PG8_WAIT_V(6); PG8_BAR; PG8_MMA(1, 1, At, B1); PG8_BAR;
            }
        }
        if constexpr (ALIGN_EPI) { if (wr == 0) PG8_BAR; }
        if constexpr (!Epi::AFTER_DRAIN) { E(acc, cur, wr, wc, fr, fq); S.done(cur); }
        if (!has_next) break;
#pragma unroll
        for (int a = 0; a < 2; ++a)
#pragma unroll
            for (int b = 0; b < 2; ++b)
#pragma unroll
                for (int m = 0; m < 4; ++m)
#pragma unroll
                    for (int n = 0; n < 2; ++n) acc[a][b][m][n] = (f32x4){0.f, 0.f, 0.f, 0.f};
        cur = nxt; cA = nA; cB = nB; ++ui;
        if constexpr (ALIGN_EPI) { if (wr == 1) PG8_BAR; }
    }
    PG8_WAIT_V(0);
    if constexpr (!ALIGN_EPI) { if (wr == 0) PG8_BAR; }
    PG8_BAR;
    if constexpr (Epi::AFTER_DRAIN) { E.fused(acc, cur, wr, wc, fr, fq, lds, wid, lane); S.done(cur); }
#undef PG8_SA
#undef PG8_SB
#undef PG8_STAGE
#undef PG8_LDA
#undef PG8_LDB
#undef PG8_MMA
#undef PG8_WAIT_V
#undef PG8_WAIT_L
#undef PG8_BAR
#undef PG8_SCHED
}
}
constexpr int DM = 1024, NCTX = 4096, NLAT = 8192, MROWS = 12288;
constexpr int CSEQ = 256, LSEQ = 1024, PAST = 512, LKEYS = 1536;
constexpr int INC = 4096, FF = 2816, FF2 = 5632, AW = 512;
constexpr float ALPHA = 1.189207115002721f, LN_EPS = 1e-5f;
constexpr float QSCALE = 0.125f * 1.4426950408889634f;
constexpr int NWAVES = 8, NTHR = 512;
constexpr int LDS_BYTES = 147456;
constexpr int RING_BYTES = 131072, MISC_OFF = RING_BYTES + 320;

constexpr size_t MiB = 1u << 20;
constexpr size_t WS_CTL = 0, CTL_ZERO_BYTES = 65536;
constexpr size_t WS_MOD = 1 * MiB;
constexpr size_t WS_ROPE = 1 * MiB + 512 * 1024;
constexpr size_t WS_WIN = 2 * MiB, WS_WOUT = 10 * MiB, WS_WUP = 12 * MiB, WS_WDN = 23 * MiB;
constexpr size_t WS_XM = 29 * MiB;
constexpr size_t WS_Q = 53 * MiB, WS_KC = 65 * MiB, WS_VC = 69 * MiB, WS_KL = 73 * MiB, WS_VL = 85 * MiB;
constexpr size_t WS_RQ = 97 * MiB, WS_RI = 109 * MiB, WS_RG = 121 * MiB, WS_GF = 133 * MiB, WS_GB = 157 * MiB, WS_OF = 181 * MiB, WS_MIX = 205 * MiB;
constexpr size_t WS_H = 53 * MiB;
constexpr size_t WS_G = 185 * MiB;
constexpr size_t WS_END = 251 * MiB;
constexpr size_t OUT_Y = 0, OUT_K = 12582912, OUT_V = OUT_K + 2097152, OUT_S = OUT_V + 2097152;
constexpr int CW_BAR = 4096;

#define GAS __attribute__((address_space(1)))
#define LAS __attribute__((address_space(3)))
typedef unsigned short bf16;
typedef unsigned v4u __attribute__((ext_vector_type(4)));
typedef unsigned v2u __attribute__((ext_vector_type(2)));
typedef float f32x4 __attribute__((ext_vector_type(4)));
typedef short bf16x8 __attribute__((ext_vector_type(8)));
typedef GAS unsigned gu32;
#define RLX_AGENT __ATOMIC_RELAXED, __HIP_MEMORY_SCOPE_AGENT
#define LDS_WAIT() asm volatile("s_waitcnt lgkmcnt(0)" ::: "memory")
#define VM_WAIT() asm volatile("s_waitcnt vmcnt(0)" ::: "memory")
__device__ __forceinline__ unsigned f2bf(float f) { unsigned u = __builtin_bit_cast(unsigned, f); return (u + 0x7fffu + ((u >> 16) & 1u)) >> 16; }
__device__ __forceinline__ unsigned pk2(float lo, float hi) { return f2bf(lo) | (f2bf(hi) << 16); }
__device__ __forceinline__ float bflo(unsigned w) { return __uint_as_float(w << 16); }
__device__ __forceinline__ float bfhi(unsigned w) { return __uint_as_float(w & 0xffff0000u); }
__device__ __forceinline__ float wave_sum(float v) {
#pragma unroll
    for (int o = 1; o < 64; o <<= 1) v += __shfl_xor(v, o);
    return v;
}
__device__ __forceinline__ float wave_max(float v) {
#pragma unroll
    for (int o = 1; o < 64; o <<= 1) v = fmaxf(v, __shfl_xor(v, o));
    return v;
}
__device__ __forceinline__ float sigmoidf_(float z) { return 1.0f / (1.0f + __expf(-z)); }
__device__ __forceinline__ float siluf_(float z) { return z / (1.0f + __expf(-z)); }

struct Args { const float* in[27]; float* out; unsigned char* ws; int ph_lo, ph_hi; };
#define XB_TMO      128
#define XB_XCNT(j)  (256  + 64 * (j))
#define XB_XSUB(j)  (1280 + 64 * (j))
#define XB_XGEN(j)  (2304 + 64 * (j))
#define XB_TOP      3328
#define XB_TOPGEN   3392
#define XCD_BAR_WORDS 3456
#define XB_SPIN_CAP (1u << 18)

__device__ __forceinline__ unsigned xb_ld(unsigned* p)              { return __hip_atomic_load(p, __ATOMIC_RELAXED, __HIP_MEMORY_SCOPE_AGENT); }
__device__ __forceinline__ unsigned xb_add(unsigned* p, unsigned v) { return __hip_atomic_fetch_add(p, v, __ATOMIC_RELAXED, __HIP_MEMORY_SCOPE_AGENT); }
__device__ __forceinline__ unsigned xb_xcc_id() { return (unsigned)__builtin_amdgcn_s_getreg((3 << 11) | 20) & 0xFu; }
#define XB_SPIN(cond, bar) do { unsigned _sp = 0; while (cond) { __builtin_amdgcn_s_sleep(1); \
    if ((++_sp & 255u) == 0u) { if (xb_ld(&(bar)[XB_TMO])) break; if (_sp > XB_SPIN_CAP) { atomicAdd(&(bar)[XB_TMO], 1u); break; } } } } while (0)

struct XcdBarrier {
    unsigned* bar; unsigned x;
    volatile LAS unsigned* st;
};

__device__ __forceinline__ XcdBarrier xcd_barrier_post(unsigned* bar, volatile LAS unsigned* st) {
    XcdBarrier b; b.bar = bar; b.x = xb_xcc_id(); b.st = st;
    if (threadIdx.x == 0) (void)xb_add(&bar[XB_XCNT(b.x)], 1u);
    return b;
}
__device__ __forceinline__ void xcd_barrier_complete(unsigned* bar, unsigned x, unsigned& nloc, unsigned& nx) {
    const unsigned G = gridDim.x * gridDim.y * gridDim.z;
    unsigned sum, cnt, mine, sp = 0u;
    for (;;) {
        sum = 0u; cnt = 0u; mine = 0u;
#pragma unroll
        for (unsigned j = 0; j < 16; ++j) { const unsigned c = xb_ld(&bar[XB_XCNT(j)]); sum += c; cnt += (c > 0u) ? 1u : 0u; mine = (j == x) ? c : mine; }
        if (sum == G) break;
        __builtin_amdgcn_s_sleep(1);
        if ((++sp & 255u) == 0u) { if (xb_ld(&bar[XB_TMO])) break; if (sp > XB_SPIN_CAP) { atomicAdd(&bar[XB_TMO], 1u); break; } }
    }
    nloc = mine > 0u ? mine : 1u; nx = cnt > 0u ? cnt : 1u;
}

__device__ __forceinline__ void xcd_barrier(const XcdBarrier& b) {
    asm volatile("s_waitcnt vmcnt(0)" ::: "memory");
    __syncthreads();
    if (threadIdx.x == 0) {
        unsigned* bar = b.bar;
        __builtin_amdgcn_s_waitcnt(0);
        unsigned nloc = b.st[0], nx = b.st[1];
        if (nloc == 0u) { xcd_barrier_complete(bar, b.x, nloc, nx); b.st[0] = nloc; b.st[1] = nx; }
        const unsigned old = xb_add(&bar[XB_XSUB(b.x)], 1u);
        const unsigned gen = old / nloc;
        if (old + 1u == (gen + 1u) * nloc) {
            __builtin_amdgcn_fence(__ATOMIC_RELEASE, "agent");
            asm volatile("s_waitcnt vmcnt(0)" ::: "memory");
            const unsigned og = xb_add(&bar[XB_TOP], 1u);
            const unsigned tg = og / nx;
            if (og + 1u == (tg + 1u) * nx) xb_add(&bar[XB_TOPGEN], 1u);
            else XB_SPIN(xb_ld(&bar[XB_TOPGEN]) == tg, bar);
            __builtin_amdgcn_fence(__ATOMIC_ACQUIRE, "agent");
            xb_add(&bar[XB_XGEN(b.x)], 1u);
            asm volatile("s_waitcnt vmcnt(0)" ::: "memory");
        } else {
            XB_SPIN(xb_ld(&bar[XB_XGEN(b.x)]) == gen, bar);
            __builtin_amdgcn_fence(__ATOMIC_ACQUIRE, "agent");
            asm volatile("s_waitcnt vmcnt(0)" ::: "memory");
        }
    }
    __syncthreads();
}

__device__ __forceinline__ int mod_index(int row) { return row < NCTX ? 0 : 1 + ((row - NCTX) >> 10); }
__device__ __forceinline__ const float* xrow_ptr(const float* xp, const float* xs, int row) { return row < NCTX ? xp + (size_t)row * DM : xs + (size_t)(row - NCTX) * DM; }
__device__ __forceinline__ v2u pk4(f32x4 v) { v2u w; w.x = pk2(v[0], v[1]); w.y = pk2(v[2], v[3]); return w; }

struct Epi1 {
    static constexpr bool PERM = false, AFTER_DRAIN = false;
    bf16 *Q, *KC, *VC, *KL, *VL, *RQ, *RI, *RG; float *GF, *GB; float *outK, *outV; const float* rope; const float *lbf, *lbb;
    __device__ __forceinline__ void operator()(const f32x4 (&acc)[2][2][4][2], const pg8::Unit& u, int wr, int wc, int fr, int fq) const {
        const int grp = u.pn >> 1, cbase = (u.pn & 1) * 256; const bool ctx = u.pm < 16;
        if (grp <= 1) {
            const int half = wc & 1;
#pragma unroll
            for (int ai = 0; ai < 2; ++ai)
#pragma unroll
                for (int m = 0; m < 4; ++m) {
                    const int row = u.pm * 256 + ai * 128 + wr * 64 + m * 16 + fr;
                    f32x4 cs0 = (f32x4){1.f, 0.f, 1.f, 0.f}, cs1 = cs0;
                    if (!ctx) { const int t = (row - NCTX) & 1023; const int pos = half ? (t & 63) : (t >> 6);
                        const float* tp = rope + (size_t)pos * 32 + 8 * fq; cs0 = *(const f32x4*)tp; cs1 = *(const f32x4*)(tp + 4); }
#pragma unroll
                    for (int bj = 0; bj < 2; ++bj) {
                        const f32x4 x1 = acc[ai][bj][m][0], x2 = acc[ai][bj][m][1]; f32x4 o1, o2;
                        o1[0] = x1[0] * cs0[0] - x2[0] * cs0[1]; o2[0] = x1[0] * cs0[1] + x2[0] * cs0[0];
                        o1[1] = x1[1] * cs0[2] - x2[1] * cs0[3]; o2[1] = x1[1] * cs0[3] + x2[1] * cs0[2];
                        o1[2] = x1[2] * cs1[0] - x2[2] * cs1[1]; o2[2] = x1[2] * cs1[1] + x2[2] * cs1[0];
                        o1[3] = x1[3] * cs1[2] - x2[3] * cs1[3]; o2[3] = x1[3] * cs1[3] + x2[3] * cs1[2];
                        const int cg = cbase + bj * 128 + wc * 32 + 4 * fq;
                        if (grp == 0) { *(v2u*)(Q + (size_t)row * AW + cg) = pk4(o1 * QSCALE); *(v2u*)(Q + (size_t)row * AW + cg + 16) = pk4(o2 * QSCALE); }
                        else if (ctx) { *(f32x4*)(outK + (size_t)row * AW + cg) = x1; *(f32x4*)(outK + (size_t)row * AW + cg + 16) = x2;
                                        *(v2u*)(KC + (size_t)row * AW + cg) = pk4(x1); *(v2u*)(KC + (size_t)row * AW + cg + 16) = pk4(x2); }
                        else { const int b = (row - NCTX) >> 10, t = (row - NCTX) & 1023; bf16* kp = KL + ((size_t)b * LKEYS + PAST + t) * AW + cg;
                               *(v2u*)kp = pk4(o1); *(v2u*)(kp + 16) = pk4(o2); }
                    }
                }
            return;
        }
        f32x4 lb[2][2];
        if (grp == 4 || grp == 5) { const float* lg = grp == 4 ? lbf : lbb;
#pragma unroll
            for (int bj = 0; bj < 2; ++bj)
#pragma unroll
                for (int n = 0; n < 2; ++n) { const int cg = cbase + bj * 128 + wc * 32 + n * 16 + 4 * fq; const f32x4 l0 = *(const f32x4*)(lg + cg), l1 = *(const f32x4*)(lg + AW + cg);
#pragma unroll
                    for (int i = 0; i < 4; ++i) lb[bj][n][i] = sigmoidf_(l0[i] - l1[i]); } }
#pragma unroll
        for (int ai = 0; ai < 2; ++ai)
#pragma unroll
            for (int m = 0; m < 4; ++m) {
                const int row = u.pm * 256 + ai * 128 + wr * 64 + m * 16 + fr;
#pragma unroll
                for (int bj = 0; bj < 2; ++bj)
#pragma unroll
                    for (int n = 0; n < 2; ++n) {
                        const int cg = cbase + bj * 128 + wc * 32 + n * 16 + 4 * fq; const f32x4 v = acc[ai][bj][m][n]; const size_t o = (size_t)row * AW + cg;
                        if (grp == 2) { if (ctx) { *(f32x4*)(outV + o) = v; *(v2u*)(VC + o) = pk4(v); }
                                        else { const int b = (row - NCTX) >> 10, t = (row - NCTX) & 1023; *(v2u*)(VL + ((size_t)b * LKEYS + PAST + t) * AW + cg) = pk4(v); } }
                        else if (grp == 3) *(v2u*)(RQ + o) = pk4(v);
                        else if (grp == 4 || grp == 5) { f32x4 w;
#pragma unroll
                            for (int i = 0; i < 4; ++i) { const float l = lb[bj][n][i]; w[i] = __logf(l + (1.0f - l) * sigmoidf_(v[i])); }
                            *(f32x4*)((grp == 4 ? GF : GB) + o) = w; }
                        else if (grp == 6) *(v2u*)(RI + o) = pk4(v);
                        else { f32x4 w;
#pragma unroll
                            for (int i = 0; i < 4; ++i) w[i] = siluf_(v[i]);
                            *(v2u*)(RG + o) = pk4(w); }
                    }
            }
    }
};
struct EpiRes {
    static constexpr bool PERM = false, AFTER_DRAIN = false;
    const float *xp, *xs; const float* ybase; float* out; const float* gate;
    __device__ __forceinline__ void operator()(const f32x4 (&acc)[2][2][4][2], const pg8::Unit& u, int wr, int wc, int fr, int fq) const {
        const int mi = u.pm < 16 ? 0 : 1 + ((u.pm - 16) >> 2); const float* gp = gate + (size_t)mi * 6144;
        f32x4 gv[2][2];
#pragma unroll
        for (int bj = 0; bj < 2; ++bj)
#pragma unroll
            for (int n = 0; n < 2; ++n) gv[bj][n] = *(const f32x4*)(gp + u.pn * 256 + bj * 128 + wc * 32 + n * 16 + 4 * fq);
#pragma unroll
        for (int ai = 0; ai < 2; ++ai)
#pragma unroll
            for (int m = 0; m < 4; ++m) {
                const int row = u.pm * 256 + ai * 128 + wr * 64 + m * 16 + fr;
                const float* bp = ybase ? ybase + (size_t)row * DM : xrow_ptr(xp, xs, row);
#pragma unroll
                for (int bj = 0; bj < 2; ++bj)
#pragma unroll
                    for (int n = 0; n < 2; ++n) { const int col = u.pn * 256 + bj * 128 + wc * 32 + n * 16 + 4 * fq;
                        const f32x4 b = *(const f32x4*)(bp + col); *(f32x4*)(out + (size_t)row * DM + col) = b * ALPHA + gv[bj][n] * acc[ai][bj][m][n]; }
            }
    }
};
struct EpiH {
    static constexpr bool PERM = false, AFTER_DRAIN = false;
    bf16* H;
    __device__ __forceinline__ void operator()(const f32x4 (&acc)[2][2][4][2], const pg8::Unit& u, int wr, int wc, int fr, int fq) const {
#pragma unroll
        for (int ai = 0; ai < 2; ++ai)
#pragma unroll
            for (int m = 0; m < 4; ++m) {
                const int row = u.pm * 256 + ai * 128 + wr * 64 + m * 16 + fr;
#pragma unroll
                for (int bj = 0; bj < 2; ++bj)
#pragma unroll
                    for (int n = 0; n < 2; ++n) { const int col = u.pn * 256 + bj * 128 + wc * 32 + n * 16 + 4 * fq; *(v2u*)(H + (size_t)row * FF2 + col) = pk4(acc[ai][bj][m][n]); }
            }
    }
};
__device__ __forceinline__ void p0_transpose_item(const float* W, int K, int N, bf16* WT, int k0, int n0, int orow0, LAS float* scr, int lane) {
#pragma unroll 8
    for (int i = 0; i < 32; ++i) { const int kk = 2 * i + (lane >> 5); scr[kk * 33 + (lane & 31)] = W[(size_t)(k0 + kk) * N + n0 + (lane & 31)]; }
    LDS_WAIT(); asm volatile("" ::: "memory");
    const int c = lane & 7;
#pragma unroll
    for (int j = 0; j < 4; ++j) { const int n = (lane >> 3) + 8 * j; const LAS float* s = scr + (8 * c) * 33 + n;
        v4u o; o.x = pk2(s[0 * 33], s[1 * 33]); o.y = pk2(s[2 * 33], s[3 * 33]); o.z = pk2(s[4 * 33], s[5 * 33]); o.w = pk2(s[6 * 33], s[7 * 33]);
        *(GAS v4u*)(WT + (size_t)(orow0 + n) * K + k0 + 8 * c) = o; }
    LDS_WAIT(); asm volatile("" ::: "memory");
}
__device__ __forceinline__ void p0_prologue(const Args& a, LAS unsigned char* lds, int vcu, int G, int tid, int lane, int wave) {
    unsigned char* ws = a.ws;
    {
        LAS float* cl = (LAS float*)lds;
        LAS float* red = (LAS float*)(lds + 40960);
        float* mod = (float*)(ws + WS_MOD);
        const float* wada = a.in[7]; const float* bada = a.in[8];
        bool filled = false;
        for (int cb = vcu; cb < 192; cb += G) {
            if (!filled) {
                for (int i = tid; i < 9 * 1024; i += NTHR) { const int m = i >> 10, k = i & 1023; const float v = (m == 0) ? a.in[6][k] : a.in[5][(m - 1) * 1024 + k]; cl[i] = siluf_(v); }
                filled = true; __syncthreads();
            }
            const int n0 = cb * 32, kr = lane >> 3, c4 = lane & 7;
            f32x4 acc[9];
#pragma unroll
            for (int m = 0; m < 9; ++m) acc[m] = (f32x4){0.f, 0.f, 0.f, 0.f};
            for (int it = 0; it < 16; ++it) { const int k = wave * 128 + it * 8 + kr; const f32x4 wv = *(const f32x4*)(wada + (size_t)k * 6144 + n0 + 4 * c4);
#pragma unroll
                for (int m = 0; m < 9; ++m) acc[m] += wv * cl[m * 1024 + k]; }
#pragma unroll
            for (int m = 0; m < 9; ++m)
#pragma unroll
                for (int i = 0; i < 4; ++i) { float v = acc[m][i]; v += __shfl_xor(v, 8); v += __shfl_xor(v, 16); v += __shfl_xor(v, 32); acc[m][i] = v; }
            if (kr == 0) {
#pragma unroll
                for (int m = 0; m < 9; ++m) *(LAS f32x4*)(red + (wave * 9 + m) * 32 + 4 * c4) = acc[m]; }
            __syncthreads();
            if (tid < 288) { const int m = tid >> 5, cc = tid & 31; float s = bada[n0 + cc];
#pragma unroll
                for (int w = 0; w < 8; ++w) s += red[(w * 9 + m) * 32 + cc];
                mod[(size_t)m * 6144 + n0 + cc] = s; }
            __syncthreads();
        }
        __syncthreads();
    }
    if (vcu == (G > 200 ? 200 : 0)) {
        float* rope = (float*)(ws + WS_ROPE);
        for (int i = tid; i < 1024; i += NTHR) { const int pos = i >> 4, j = i & 15;
            const float freq = 1.0f / powf(10000.0f, (float)j * (1.0f / 16.0f)); const float angf = (float)pos * freq; const double ang = (double)angf;
            const double nq = __builtin_rint(ang * 0.63661977236758134308); const double r = __builtin_fma(-nq, 1.5707963267948966192, ang) - nq * 6.123233995736766e-17; const double r2 = r * r;
            double sn = r * (1.0 + r2 * (-1.0 / 6 + r2 * (1.0 / 120 + r2 * (-1.0 / 5040 + r2 * (1.0 / 362880 + r2 * (-1.0 / 39916800 + r2 * (1.0 / 6227020800.0)))))));
            double cn = 1.0 + r2 * (-0.5 + r2 * (1.0 / 24 + r2 * (-1.0 / 720 + r2 * (1.0 / 40320 + r2 * (-1.0 / 3628800 + r2 * (1.0 / 479001600 + r2 * (-1.0 / 87178291200.0)))))));
            const int q = ((int)nq) & 3; double cc, ss;
            if (q == 0) { cc = cn; ss = sn; } else if (q == 1) { cc = -sn; ss = cn; } else if (q == 2) { cc = -cn; ss = -sn; } else { cc = sn; ss = -cn; }
            rope[2 * i] = (float)cc; rope[2 * i + 1] = (float)ss; }
    }
    {
        bf16* KL = (bf16*)(ws + WS_KL); bf16* VL = (bf16*)(ws + WS_VL);
        const int gt = vcu * NTHR + tid, NGT = G * NTHR;
        for (int i = gt; i < 2 * 524288; i += NGT) { const int which = i >= 524288, e4 = which ? i - 524288 : i;
            const int rowi = e4 >> 7, c4 = e4 & 127, b = rowi >> 9, j = rowi & 511;
            const f32x4 v = *(const f32x4*)((which ? a.in[3] : a.in[2]) + (size_t)e4 * 4);
            *(v2u*)((which ? VL : KL) + ((size_t)b * LKEYS + j) * AW + 4 * c4) = pk4(v); }
    }
    {
        LAS float* scr = (LAS float*)(lds + wave * 16384);
        const int gw = vcu * NWAVES + wave, NGW = G * NWAVES;
        constexpr int I_IN = 16 * 128, I_OUT = 16 * 32, I_UP = 16 * 176, I_DN = 44 * 32, NITEMS = I_IN + I_OUT + I_UP + I_DN;
        for (int it = gw; it < NITEMS; it += NGW) {
            int r = it;
            if (r < I_IN) { const int kb = r / 128, nb = r % 128; p0_transpose_item(a.in[9], DM, INC, (bf16*)(ws + WS_WIN), 64 * kb, 32 * nb, 32 * nb, scr, lane); continue; } r -= I_IN;
            if (r < I_OUT) { const int kb = r / 32, nb = r % 32; p0_transpose_item(a.in[18], DM, DM, (bf16*)(ws + WS_WOUT), 64 * kb, 32 * nb, 32 * nb, scr, lane); continue; } r -= I_OUT;
            if (r < I_UP) { const int kb = r / 176, nb = r % 176, n0 = 32 * nb; const int n1 = n0 < FF ? n0 : n0 - FF; const int orow = 256 * (n1 >> 7) + (n0 < FF ? 0 : 128) + (n1 & 127);
                p0_transpose_item(a.in[21], DM, FF2, (bf16*)(ws + WS_WUP), 64 * kb, n0, orow, scr, lane); continue; } r -= I_UP;
            { const int kb = r / 32, nb = r % 32; p0_transpose_item(a.in[24], FF, DM, (bf16*)(ws + WS_WDN), 64 * kb, 32 * nb, 32 * nb, scr, lane); }
        }
    }
}
__device__ __forceinline__ void p1_modulate(const Args& a, int vcu, int G, int lane, int wave) {
    const float* mod = (const float*)(a.ws + WS_MOD); bf16* XM = (bf16*)(a.ws + WS_XM);
    const int gw = vcu * NWAVES + wave, NGW = G * NWAVES;
    for (int row = gw; row < MROWS; row += NGW) {
        const float* xr = xrow_ptr(a.in[0], a.in[1], row); const float* mp = mod + (size_t)mod_index(row) * 6144;
#pragma unroll
        for (int j = 0; j < 4; ++j) { const int c = 4 * (lane + 64 * j); const f32x4 x = *(const f32x4*)(xr + c), sh = *(const f32x4*)(mp + c), sc = *(const f32x4*)(mp + 1024 + c);
            *(v2u*)(XM + (size_t)row * DM + c) = pk4(x * (sc + 1.0f) + sh); }
    }
}
__device__ __forceinline__ void ln_rows(const Args& a, const float* g, const float* bta, bool write_xm, int vcu, int G, int lane, int wave) {
    float* Y = a.out + OUT_Y; const float* mod = (const float*)(a.ws + WS_MOD); bf16* XM = (bf16*)(a.ws + WS_XM);
    const int gw = vcu * NWAVES + wave, NGW = G * NWAVES;
    for (int row = gw; row < MROWS; row += NGW) {
        float* yr = Y + (size_t)row * DM; f32x4 v[4]; float s = 0.f;
#pragma unroll
        for (int j = 0; j < 4; ++j) { v[j] = *(const f32x4*)(yr + 4 * (lane + 64 * j)); s += (v[j][0] + v[j][1]) + (v[j][2] + v[j][3]); }
        const float mean = wave_sum(s) * (1.0f / DM); float s2 = 0.f;
#pragma unroll
        for (int j = 0; j < 4; ++j) { v[j] = v[j] - mean; s2 += (v[j][0] * v[j][0] + v[j][1] * v[j][1]) + (v[j][2] * v[j][2] + v[j][3] * v[j][3]); }
        const float rstd = 1.0f / sqrtf(wave_sum(s2) * (1.0f / DM) + LN_EPS);
        const float* mp = mod + (size_t)mod_index(row) * 6144;
#pragma unroll
        for (int j = 0; j < 4; ++j) { const int c = 4 * (lane + 64 * j); const f32x4 x1 = v[j] * rstd * *(const f32x4*)(g + c) + *(const f32x4*)(bta + c);
            *(f32x4*)(yr + c) = x1;
            if (write_xm) { const f32x4 sh = *(const f32x4*)(mp + 3072 + c), sc = *(const f32x4*)(mp + 4096 + c); *(v2u*)(XM + (size_t)row * DM + c) = pk4(x1 * (sc + 1.0f) + sh); } }
    }
}
__device__ __forceinline__ void conv_gate(const Args& a, int vcu, int G, int tid) {
    const bf16* H = (const bf16*)(a.ws + WS_H); bf16* Gt = (bf16*)(a.ws + WS_G); const float* cw = a.in[22]; const float* cb = a.in[23];
    const int gt = vcu * NTHR + tid, NGT = G * NTHR; constexpr int PER_ROW = 22 * 32;
    for (int i = gt; i < MROWS * PER_ROW; i += NGT) {
        const int row = i / PER_ROW, r2 = i % PER_ROW, pn = r2 >> 5, jj = (r2 & 31) * 4;
        const int t = row < NCTX ? (row & 255) : ((row - NCTX) & 1023), L = row < NCTX ? CSEQ : LSEQ;
        const bool hp = t > 0, hn = t < L - 1;
        const int ca = 128 * pn + jj, cu = FF + ca;
        const bf16* hp0 = H + (size_t)row * FF2 + 256 * pn + jj;
        const v2u z = (v2u){0u, 0u};
        const v2u a0 = hp ? *(const v2u*)(hp0 - FF2) : z, a1 = *(const v2u*)hp0, a2 = hn ? *(const v2u*)(hp0 + FF2) : z;
        const v2u u0 = hp ? *(const v2u*)(hp0 - FF2 + 128) : z, u1 = *(const v2u*)(hp0 + 128), u2 = hn ? *(const v2u*)(hp0 + FF2 + 128) : z;
        const f32x4 wa0 = *(const f32x4*)(cw + ca), wa1 = *(const f32x4*)(cw + FF2 + ca), wa2 = *(const f32x4*)(cw + 2 * FF2 + ca), ba = *(const f32x4*)(cb + ca);
        const f32x4 wu0 = *(const f32x4*)(cw + cu), wu1 = *(const f32x4*)(cw + FF2 + cu), wu2 = *(const f32x4*)(cw + 2 * FF2 + cu), bu = *(const f32x4*)(cb + cu);
        const f32x4 A0 = (f32x4){bflo(a0.x), bfhi(a0.x), bflo(a0.y), bfhi(a0.y)}, A1 = (f32x4){bflo(a1.x), bfhi(a1.x), bflo(a1.y), bfhi(a1.y)}, A2 = (f32x4){bflo(a2.x), bfhi(a2.x), bflo(a2.y), bfhi(a2.y)};
        const f32x4 U0 = (f32x4){bflo(u0.x), bfhi(u0.x), bflo(u0.y), bfhi(u0.y)}, U1 = (f32x4){bflo(u1.x), bfhi(u1.x), bflo(u1.y), bfhi(u1.y)}, U2 = (f32x4){bflo(u2.x), bfhi(u2.x), bflo(u2.y), bfhi(u2.y)};
        const f32x4 av = A0 * wa0 + A1 * wa1 + A2 * wa2 + ba, uv = U0 * wu0 + U1 * wu1 + U2 * wu2 + bu; f32x4 gv;
#pragma unroll
        for (int k = 0; k < 4; ++k) gv[k] = siluf_(av[k]) * uv[k];
        *(v2u*)(Gt + (size_t)row * FF + ca) = pk4(gv);
    }
}
__device__ __forceinline__ float calc_lam(const Args& a, int lane) {
    const float s1 = wave_sum(a.in[10][lane] * a.in[11][lane]), s2 = wave_sum(a.in[12][lane] * a.in[13][lane]);
    return expf(s1) - expf(s2) + 0.2f;
}
__device__ __forceinline__ void attn_naive(const Args& a, LAS unsigned char* lds, int vcu, int G, int lane, int wave) {
    unsigned char* ws = a.ws;
    const bf16* Q = (const bf16*)(ws + WS_Q); bf16* MIX = (bf16*)(ws + WS_MIX); const float* attg = a.in[16];
    LAS float* qf = (LAS float*)(lds + wave * 12800);
    LAS float* sc = qf + 128;
    const float lam = calc_lam(a, lane);
    for (int it = vcu; it < 6144; it += G) {
        const int h = it & 3, row = (it >> 2) * 8 + wave; const bool ctx = row < NCTX;
        const int nk = ctx ? CSEQ : LKEYS;
        const bf16 *Kp, *Vp;
        if (ctx) { const int b = row >> 8; Kp = (const bf16*)(ws + WS_KC) + (size_t)b * CSEQ * AW + h * 128; Vp = (const bf16*)(ws + WS_VC) + (size_t)b * CSEQ * AW + h * 128; }
        else { const int b = (row - NCTX) >> 10; Kp = (const bf16*)(ws + WS_KL) + (size_t)b * LKEYS * AW + h * 128; Vp = (const bf16*)(ws + WS_VL) + (size_t)b * LKEYS * AW + h * 128; }
        { const unsigned w = *(const unsigned*)(Q + (size_t)row * AW + h * 128 + 2 * lane); qf[2 * lane] = bflo(w); qf[2 * lane + 1] = bfhi(w); }
        LDS_WAIT(); asm volatile("" ::: "memory");
        float m1 = -3.0e38f, m2 = -3.0e38f;
        for (int j = lane; j < nk; j += 64) {
            const bf16* kp = Kp + (size_t)j * AW; float s1 = 0.f, s2 = 0.f;
#pragma unroll
            for (int c = 0; c < 8; ++c) { const v4u k1 = *(const v4u*)(kp + 8 * c), k2 = *(const v4u*)(kp + 64 + 8 * c);
                const LAS float* q1 = qf + 8 * c; const LAS float* q2 = qf + 64 + 8 * c;
                s1 += bflo(k1.x) * q1[0] + bfhi(k1.x) * q1[1] + bflo(k1.y) * q1[2] + bfhi(k1.y) * q1[3] + bflo(k1.z) * q1[4] + bfhi(k1.z) * q1[5] + bflo(k1.w) * q1[6] + bfhi(k1.w) * q1[7];
                s2 += bflo(k2.x) * q2[0] + bfhi(k2.x) * q2[1] + bflo(k2.y) * q2[2] + bfhi(k2.y) * q2[3] + bflo(k2.z) * q2[4] + bfhi(k2.z) * q2[5] + bflo(k2.w) * q2[6] + bfhi(k2.w) * q2[7]; }
            sc[j] = s1; sc[1536 + j] = s2; m1 = fmaxf(m1, s1); m2 = fmaxf(m2, s2);
        }
        m1 = wave_max(m1); m2 = wave_max(m2);
        float l1 = 0.f, l2 = 0.f;
        for (int j = lane; j < nk; j += 64) { const float p1 = exp2f(sc[j] - m1), p2 = exp2f(sc[1536 + j] - m2); sc[j] = p1; sc[1536 + j] = p2; l1 += p1; l2 += p2; }
        l1 = wave_sum(l1); l2 = wave_sum(l2);
        const float i1 = 1.0f / l1, i2 = lam / l2;
        for (int j = lane; j < nk; j += 64) sc[j] = sc[j] * i1 - sc[1536 + j] * i2;
        LDS_WAIT(); asm volatile("" ::: "memory");
        float o0 = 0.f, o1 = 0.f;
#pragma unroll 8
        for (int j = 0; j < nk; ++j) { const unsigned w = *(const unsigned*)(Vp + (size_t)j * AW + 2 * lane); const float p = sc[j]; o0 += p * bflo(w); o1 += p * bfhi(w); }
        const float ss = wave_sum(o0 * o0 + o1 * o1); const float r = 1.0f / sqrtf(ss * (1.0f / 128.0f) + LN_EPS) * 0.8f;
        *(unsigned*)(MIX + (size_t)row * DM + h * 128 + 2 * lane) = pk2(o0 * r * attg[h * 128 + 2 * lane], o1 * r * attg[h * 128 + 2 * lane + 1]);
        LDS_WAIT(); asm volatile("" ::: "memory");
    }
}
__device__ __forceinline__ void rnn_naive(const Args& a, LAS unsigned char* lds, int vcu, int G, int tid) {
    unsigned char* ws = a.ws;
    const bf16* RQ = (const bf16*)(ws + WS_RQ); const bf16* RI = (const bf16*)(ws + WS_RI); const bf16* RG = (const bf16*)(ws + WS_RG);
    float* OF = (float*)(ws + WS_OF); bf16* MIX = (bf16*)(ws + WS_MIX); const float* rnng = a.in[17];
    LAS float* Fl = (LAS float*)lds;
    LAS float* Kl = Fl + 2048; LAS float* Ql = Kl + 2048; LAS float* Vl = Ql + 2048;
    LAS float* PO = Vl + 2048;
    const int e = tid & 127, qd = tid >> 7;
    for (int it = vcu; it < 96; it += G) {
        const bool ctx = it < 64; const int bi = ctx ? it : it - 64, b = bi >> 2, h = bi & 3;
        const int L = ctx ? CSEQ : LSEQ, row0 = ctx ? b * CSEQ : NCTX + b * LSEQ;
        for (int dir = 0; dir < 2; ++dir) {
            const float* GT = (const float*)(ws + (dir ? WS_GB : WS_GF));
            float S[32];
            if (ctx) {
#pragma unroll
                for (int i = 0; i < 32; ++i) S[i] = 0.f;
            } else { const float* s0 = a.in[4] + ((size_t)(b * 2 + dir) * 4 + h) * 16384;
#pragma unroll
                for (int i = 0; i < 32; ++i) S[i] = s0[(size_t)(32 * qd + i) * 128 + e]; }
            for (int tb = 0; tb < L / 16; ++tb) {
#pragma unroll
                for (int j = 0; j < 4; ++j) { const int idx = tid + NTHR * j, i = idx >> 7, d = idx & 127; const int s = tb * 16 + i, t = dir ? L - 1 - s : s;
                    const size_t o = (size_t)(row0 + t) * AW + h * 128 + d;
                    const float f = __expf(GT[o]); Fl[idx] = f; Kl[idx] = 1.0f - f; Ql[idx] = __uint_as_float((unsigned)RQ[o] << 16); Vl[idx] = __uint_as_float((unsigned)RI[o] << 16); }
                __syncthreads();
#pragma unroll 1
                for (int i = 0; i < 16; ++i) { const float v = Vl[i * 128 + e]; float po = 0.f;
#pragma unroll
                    for (int dd = 0; dd < 32; ++dd) { const int d = 32 * qd + dd; S[dd] = Fl[i * 128 + d] * S[dd] + Kl[i * 128 + d] * v; po += S[dd] * Ql[i * 128 + d]; }
                    PO[(i * 4 + qd) * 128 + e] = po; }
                __syncthreads();
                { const int i = tid >> 5, e4 = (tid & 31) * 4; const int s = tb * 16 + i, t = dir ? L - 1 - s : s; const size_t o = (size_t)(row0 + t) * AW + h * 128 + e4;
                    f32x4 ov = *(const LAS f32x4*)(PO + (i * 4 + 0) * 128 + e4) + *(const LAS f32x4*)(PO + (i * 4 + 1) * 128 + e4) + *(const LAS f32x4*)(PO + (i * 4 + 2) * 128 + e4) + *(const LAS f32x4*)(PO + (i * 4 + 3) * 128 + e4);
                    if (dir == 0) *(f32x4*)(OF + o) = ov;
                    else { ov += *(const f32x4*)(OF + o);
                        float ss = (ov[0] * ov[0] + ov[1] * ov[1]) + (ov[2] * ov[2] + ov[3] * ov[3]);
                        ss += __shfl_xor(ss, 1); ss += __shfl_xor(ss, 2); ss += __shfl_xor(ss, 4); ss += __shfl_xor(ss, 8); ss += __shfl_xor(ss, 16);
                        const float r = 1.0f / sqrtf(ss * (1.0f / 128.0f) + LN_EPS); const f32x4 g = *(const f32x4*)(rnng + h * 128 + e4); const v2u gw = *(const v2u*)(RG + o);
                        f32x4 res; res[0] = ov[0] * r * g[0] * bflo(gw.x); res[1] = ov[1] * r * g[1] * bfhi(gw.x); res[2] = ov[2] * r * g[2] * bflo(gw.y); res[3] = ov[3] * r * g[3] * bfhi(gw.y);
                        *(v2u*)(MIX + (size_t)(row0 + t) * DM + AW + h * 128 + e4) = pk4(res); } }
            }
            if (ctx) { float* so = a.out + OUT_S + ((size_t)(b * 2 + dir) * 4 + h) * 16384;
#pragma unroll
                for (int i = 0; i < 32; ++i) so[(size_t)(32 * qd + i) * 128 + e] = S[i]; }
            __threadfence(); __syncthreads();
        }
    }
}
#ifndef MK_N_LAUNCHES
#define MK_N_LAUNCHES 1
#endif
constexpr int NPH = 10;
__global__ void __launch_bounds__(NTHR, 2) fwd(Args args) {
    extern __shared__ __attribute__((aligned(16))) unsigned char lds_[];
    LAS unsigned char* lds = (LAS unsigned char*)lds_;
    const int tid = threadIdx.x, lane = tid & 63, wave = __builtin_amdgcn_readfirstlane(tid >> 6);
    const int G = gridDim.x, bx = blockIdx.x, vcu = (G % 8 == 0) ? (bx % 8) * (G / 8) + bx / 8 : bx;
    unsigned char* ws = args.ws;
    for (int u = tid; u < (LDS_BYTES - RING_BYTES) / 4; u += NTHR) ((LAS unsigned*)(lds + RING_BYTES))[u] = 0u;
    __syncthreads();
    const int lo = args.ph_lo, hi = args.ph_hi;
    XcdBarrier bar; bar.bar = (unsigned*)(ws + WS_CTL) + CW_BAR; bar.x = 0; bar.st = nullptr;
    if (hi - lo > 1) bar = xcd_barrier_post((unsigned*)(ws + WS_CTL) + CW_BAR, (volatile LAS unsigned*)(lds + MISC_OFF) + 8);
#define IN(k) (lo <= (k) && (k) < hi)
#define SEAM(k) do { if (IN(k) && IN((k) + 1)) xcd_barrier(bar); } while (0)
    float* mod = (float*)(ws + WS_MOD);
    if (IN(0)) { p0_prologue(args, lds, vcu, G, tid, lane, wave); SEAM(0); }
    if (IN(1)) { p1_modulate(args, vcu, G, lane, wave); SEAM(1); }
    if (IN(2)) {
        pg8::Gemm g{(const bf16*)(ws + WS_XM), (const bf16*)(ws + WS_WIN), MROWS, INC, DM}; pg8::StaticOrder S; S.init(MROWS, INC, G, bx);
        Epi1 E{(bf16*)(ws + WS_Q), (bf16*)(ws + WS_KC), (bf16*)(ws + WS_VC), (bf16*)(ws + WS_KL), (bf16*)(ws + WS_VL), (bf16*)(ws + WS_RQ), (bf16*)(ws + WS_RI), (bf16*)(ws + WS_RG),
               (float*)(ws + WS_GF), (float*)(ws + WS_GB), args.out + OUT_K, args.out + OUT_V, (const float*)(ws + WS_ROPE), args.in[14], args.in[15]};
        pg8::gemm_phase<Epi1, pg8::StaticOrder, true, true>(lds, g, S, E);
        SEAM(2);
    }
    if (IN(3)) {
        if (G >= 192) { if (vcu < 96) rnn_naive(args, lds, vcu, 96, tid); else attn_naive(args, lds, vcu - 96, G - 96, lane, wave); }
        else { rnn_naive(args, lds, vcu, G, tid); __syncthreads(); attn_naive(args, lds, vcu, G, lane, wave); }
        SEAM(3);
    }
    if (IN(4)) {
        pg8::Gemm g{(const bf16*)(ws + WS_MIX), (const bf16*)(ws + WS_WOUT), MROWS, DM, DM}; pg8::StaticOrder S; S.init(MROWS, DM, G, bx);
        EpiRes E{args.in[0], args.in[1], nullptr, args.out + OUT_Y, mod + 2048};
        pg8::gemm_phase<EpiRes, pg8::StaticOrder, true, true>(lds, g, S, E);
        SEAM(4);
    }
    if (IN(5)) { ln_rows(args, args.in[19], args.in[20], true, vcu, G, lane, wave); SEAM(5); }
    if (IN(6)) {
        pg8::Gemm g{(const bf16*)(ws + WS_XM), (const bf16*)(ws + WS_WUP), MROWS, FF2, DM}; pg8::StaticOrder S; S.init(MROWS, FF2, G, bx);
        EpiH E{(bf16*)(ws + WS_H)};
        pg8::gemm_phase<EpiH, pg8::StaticOrder, true, true>(lds, g, S, E);
        SEAM(6);
    }
    if (IN(7)) { conv_gate(args, vcu, G, tid); SEAM(7); }
    if (IN(8)) {
        pg8::Gemm g{(const bf16*)(ws + WS_G), (const bf16*)(ws + WS_WDN), MROWS, DM, FF}; pg8::StaticOrder S; S.init(MROWS, DM, G, bx);
        EpiRes E{args.in[0], args.in[1], args.out + OUT_Y, args.out + OUT_Y, mod + 5120};
        pg8::gemm_phase<EpiRes, pg8::StaticOrder, true, true>(lds, g, S, E);
        SEAM(8);
    }
    if (IN(9)) { ln_rows(args, args.in[25], args.in[26], false, vcu, G, lane, wave); }
#undef IN
#undef SEAM
}

extern "C" void kernel_launch(void* const* d_in, const int* in_sizes, int n_in, void* d_out, int out_size, void* d_ws, size_t ws_size, hipStream_t stream) {
    static int grid = 0;
    if (grid == 0) {
        if (n_in != 27 || out_size != 18874368 || ws_size < WS_END) { fprintf(stderr, "kernel_launch: unexpected shapes (n_in %d, out %d, ws %zu)\n", n_in, out_size, ws_size); grid = -1; return; }
        int dev = 0, cus = 0, per_cu = 0;
        if (hipGetDevice(&dev) != hipSuccess || hipDeviceGetAttribute(&cus, hipDeviceAttributeMultiprocessorCount, dev) != hipSuccess) { grid = -1; return; }
        if (hipFuncSetAttribute((const void*)fwd, hipFuncAttributeMaxDynamicSharedMemorySize, LDS_BYTES) != hipSuccess) { fprintf(stderr, "kernel_launch: hipFuncSetAttribute failed\n"); grid = -1; return; }
        if (hipOccupancyMaxActiveBlocksPerMultiprocessor(&per_cu, (const void*)fwd, NTHR, LDS_BYTES) != hipSuccess || per_cu < 1) { fprintf(stderr, "kernel_launch: occupancy query reports %d\n", per_cu); per_cu = 1; }
        (void)hipGetLastError();
        grid = cus;
    }
    if (grid < 0) return;
    (void)hipMemsetAsync((char*)d_ws + WS_CTL, 0, CTL_ZERO_BYTES, stream);
    Args a{};
    for (int i = 0; i < 27; ++i) a.in[i] = (const float*)d_in[i];
    a.out = (float*)d_out; a.ws = (unsigned char*)d_ws;
    if (MK_N_LAUNCHES == 1) { a.ph_lo = 0; a.ph_hi = NPH; hipLaunchKernelGGL(fwd, dim3(grid), dim3(NTHR), LDS_BYTES, stream, a); }
    else for (int li = 0; li < NPH; ++li) { a.ph_lo = li; a.ph_hi = li + 1; hipLaunchKernelGGL(fwd, dim3(grid), dim3(NTHR), LDS_BYTES, stream, a); }
}
```

```cpp
#include <hip/hip_runtime.h>
#include <cstdio>
#include <cstdint>
#define MK_N_LAUNCHES 1
namespace pg8 {
#define PG8_LAS __attribute__((address_space(3)))
typedef unsigned short bf16_t;
typedef short bf16x8 __attribute__((ext_vector_type(8)));
typedef float f32x4 __attribute__((ext_vector_type(4)));
typedef unsigned u32x4 __attribute__((ext_vector_type(4)));
constexpr int BM = 256, BK = 64, HALF = 128, HTB = HALF * BK * 2  , STAGE_BYTES = 8 * HTB, NXCD = 8, WGM = 8;

__host__ __device__ __forceinline__ int lds_byte(int r, int c) { const int st = (r >> 4) * 2 + (c >> 5), rr = r & 15, cc = c & 31, ob = rr * 64 + cc * 2; return st * 1024 + (ob ^ (((ob >> 9) & 1) << 5)); }
__host__ __device__ __forceinline__ void stage_rc(int b, int& R, int& C) { const int st = b / 1024, sb = b % 1024, swz = sb ^ (((sb >> 9) & 1) << 5); R = (st >> 1) * 16 + swz / 64; C = (st & 1) * 32 + (swz % 64) / 2; }
__host__ __device__ __forceinline__ int perm32(int rho) { const int n = rho >> 4, i = rho & 15; return 8 * (i >> 2) + 4 * n + (i & 3); }

struct Unit { int pm, pn; };
struct Gemm { const bf16_t* A; const bf16_t* Bt; int M, N, K; };

struct StaticOrder {
    int nM, nN, nwg, G, c;
    __host__ __device__ void init(int M, int N, int G_, int c_) { nM = M / BM; nN = N / BM; nwg = nM * nN; G = G_; c = c_; }
    __host__ __device__ bool next(int i, Unit& u) const {
        const long L = (long)i * G + c; if (L >= nwg) return false;
        int wgid = (int)L; { const int q = nwg / NXCD, r = nwg % NXCD, xcd = wgid % NXCD, off = wgid / NXCD; wgid = (xcd < r ? xcd * (q + 1) : r * (q + 1) + (xcd - r) * q) + off; }
        const int nig = WGM * nN, gid = wgid / nig, fm = gid * WGM, gsz = (nM - fm) < WGM ? (nM - fm) : WGM;
        u.pm = fm + ((wgid % nig) % gsz); u.pn = (wgid % nig) / gsz; return true;
    }
    __device__ __forceinline__ void a_ready(const Unit&) const {}
    __device__ __forceinline__ void done(const Unit&) const {}
};

__device__ __forceinline__ unsigned cvt_pk_bf16(float lo, float hi) { unsigned r; asm volatile("v_cvt_pk_bf16_f32 %0, %1, %2" : "=v"(r) : "v"(lo), "v"(hi)); return r; }
typedef float f32x2 __attribute__((ext_vector_type(2)));
template <class Epi, class Sched, bool ALIGN_EPI = false, bool SP2 = false>
__device__ __forceinline__ void gemm_phase(PG8_LAS unsigned char* lds, const Gemm g, const Sched& S, const Epi& E) {
    const int tid = threadIdx.x, wid = __builtin_amdgcn_readfirstlane(tid >> 6), lane = tid & 63, wr = wid >> 2, wc = wid & 3, fr = lane & 15, fq = lane >> 4;
    const int K = g.K, nt = K / BK;
    unsigned voffA[2], voffB[2];
#pragma unroll
    for (int i = 0; i < 2; ++i) { int R, C; stage_rc(tid * 16 + i * 8192, R, C); const int Rb = Epi::PERM ? ((R & ~31) + perm32(R & 31)) : R;
        voffA[i] = (unsigned)(R * K + C) * 2u; voffB[i] = (unsigned)(Rb * K + C) * 2u; }
    const size_t kstep = (size_t)(BK * 2);
    const size_t hstep = (size_t)HALF * K * 2;
    const size_t tstep = 2 * hstep;
    const unsigned ldsw = (unsigned)wid * 1024u;
    const int aoff = lds_byte(wr * 64 + fr, fq * 8), boff = lds_byte(wc * 32 + fr, fq * 8);
#define PG8_SA(b, h) (((b) * 2 + (h)) * HTB)
#define PG8_SB(b, h) ((4 + (b) * 2 + (h)) * HTB)
#define PG8_STAGE(bufoff, gbase, voff) do { _Pragma("unroll") for (int _i = 0; _i < 2; ++_i) \
        __builtin_amdgcn_global_load_lds((const unsigned*)((const char*)(gbase) + (voff)[_i]), (PG8_LAS unsigned*)(lds + (bufoff) + ldsw + _i * 8192), 16, 0, 0); } while (0)
#define PG8_LDA(dst, b, h) do { _Pragma("unroll") for (int m = 0; m < 4; ++m) _Pragma("unroll") for (int k = 0; k < 2; ++k) dst[m][k] = *(const PG8_LAS bf16x8*)(lds + PG8_SA(b, h) + aoff + m * 2048 + k * 1024); } while (0)
#define PG8_LDB(dst, b, h) do { _Pragma("unroll") for (int n = 0; n < 2; ++n) _Pragma("unroll") for (int k = 0; k < 2; ++k) dst[n][k] = *(const PG8_LAS bf16x8*)(lds + PG8_SB(b, h) + boff + n * 2048 + k * 1024); } while (0)
#define PG8_MMA(ai, bj, At, Bt) do { __builtin_amdgcn_s_setprio(1); _Pragma("unroll") for (int m = 0; m < 4; ++m) _Pragma("unroll") for (int n = 0; n < 2; ++n) _Pragma("unroll") for (int k = 0; k < 2; ++k) \
        acc[ai][bj][m][n] = __builtin_amdgcn_mfma_f32_16x16x32_bf16(Bt[n][k], At[m][k], acc[ai][bj][m][n], 0, 0, 0); __builtin_amdgcn_s_setprio(0); } while (0)
#define PG8_WAIT_V(n) asm volatile("s_waitcnt vmcnt(" #n ")" ::: "memory")
#define PG8_WAIT_L(n) asm volatile("s_waitcnt lgkmcnt(" #n ")" ::: "memory")
#define PG8_BAR __builtin_amdgcn_s_barrier()
#define PG8_SCHED __builtin_amdgcn_sched_barrier(0)
    Unit cur, nxt; int ui = 0;
    if (!S.next(0, cur)) return;
    f32x4 acc[2][2][4][2];
#pragma unroll
    for (int a = 0; a < 2; ++a)
#pragma unroll
        for (int b = 0; b < 2; ++b)
#pragma unroll
            for (int m = 0; m < 4; ++m)
#pragma unroll
                for (int n = 0; n < 2; ++n) acc[a][b][m][n] = (f32x4){0.f, 0.f, 0.f, 0.f};
    bf16x8 At[4][2], B0[2][2], B1[2][2];
    const char* cA = (const char*)g.A + (size_t)cur.pm * tstep; const char* cB = (const char*)g.Bt + (size_t)cur.pn * tstep;
    S.a_ready(cur);
    if constexpr (SP2) {
        PG8_STAGE(PG8_SB(0, 0), cB, voffB); PG8_STAGE(PG8_SB(0, 1), cB + hstep, voffB); PG8_STAGE(PG8_SA(0, 0), cA, voffA); PG8_STAGE(PG8_SA(0, 1), cA + hstep, voffA);
        if (wr == 1) PG8_BAR;
        PG8_WAIT_V(2); PG8_BAR;
        PG8_STAGE(PG8_SB(1, 0), cB + kstep, voffB); PG8_STAGE(PG8_SA(1, 0), cA + kstep, voffA); PG8_STAGE(PG8_SB(1, 1), cB + hstep + kstep, voffB);
        PG8_WAIT_V(6); PG8_BAR;
    } else {
        PG8_STAGE(PG8_SB(0, 0), cB, voffB); PG8_STAGE(PG8_SA(0, 0), cA, voffA); PG8_STAGE(PG8_SB(0, 1), cB + hstep, voffB); PG8_STAGE(PG8_SA(0, 1), cA + hstep, voffA);
        if (wr == 1) PG8_BAR;
        PG8_WAIT_V(4); PG8_BAR;
        PG8_STAGE(PG8_SB(1, 0), cB + kstep, voffB); PG8_STAGE(PG8_SA(1, 0), cA + kstep, voffA); PG8_STAGE(PG8_SB(1, 1), cB + hstep + kstep, voffB);
        PG8_WAIT_V(6); PG8_BAR;
    }
    for (;;) {
        const bool has_next = S.next(ui + 1, nxt);
        const char* nA = has_next ? (const char*)g.A + (size_t)nxt.pm * tstep : cA; const char* nB = has_next ? (const char*)g.Bt + (size_t)nxt.pn * tstep : cB;
        for (int t = 0; t < nt; t += 2) {
            const bool last = (t == nt - 2);
            const char* a1 = cA + (size_t)(t + 1) * kstep;
            const char* a2 = last ? nA : cA + (size_t)(t + 2) * kstep; const char* b2 = last ? nB : cB + (size_t)(t + 2) * kstep;
            const char* a3 = a2 + kstep; const char* b3 = b2 + kstep;
            if (last && has_next) S.a_ready(nxt);
            if constexpr (SP2) {
            PG8_LDB(B0, 0, 0); PG8_LDB(B1, 0, 1); PG8_SCHED; PG8_LDA(At, 0, 0); PG8_STAGE(PG8_SA(1, 1), a1 + hstep, voffA);
            PG8_WAIT_V(8); PG8_WAIT_L(0); PG8_BAR; PG8_MMA(0, 0, At, B0); PG8_MMA(0, 1, At, B1); PG8_BAR; PG8_SCHED;
            PG8_LDA(At, 0, 1); PG8_STAGE(PG8_SB(0, 0), b2, voffB); PG8_STAGE(PG8_SB(0, 1), b2 + hstep, voffB); PG8_STAGE(PG8_SA(0, 0), a2, voffA);
            PG8_WAIT_V(8); PG8_WAIT_L(0); PG8_BAR; PG8_MMA(1, 0, At, B0); PG8_MMA(1, 1, At, B1); PG8_BAR; PG8_SCHED;
            PG8_LDB(B0, 1, 0); PG8_LDB(B1, 1, 1); PG8_SCHED; PG8_LDA(At, 1, 0); PG8_STAGE(PG8_SA(0, 1), a2 + hstep, voffA);
            PG8_WAIT_V(8); PG8_WAIT_L(0); PG8_BAR; PG8_MMA(0, 0, At, B0); PG8_MMA(0, 1, At, B1); PG8_BAR; PG8_SCHED;
            PG8_LDA(At, 1, 1); PG8_STAGE(PG8_SB(1, 0), b3, voffB); PG8_STAGE(PG8_SB(1, 1), b3 + hstep, voffB); PG8_STAGE(PG8_SA(1, 0), a3, voffA);
            PG8_WAIT_V(8); PG8_WAIT_L(0); PG8_BAR; PG8_MMA(1, 0, At, B0); PG8_MMA(1, 1, At, B1); PG8_BAR; PG8_SCHED;
            } else {
            PG8_LDB(B0, 0, 0); PG8_SCHED; PG8_LDA(At, 0, 0); PG8_STAGE(PG8_SA(1, 1), a1 + hstep, voffA);
            PG8_WAIT_L(8); PG8_BAR; PG8_WAIT_L(0); PG8_MMA(0, 0, At, B0); PG8_BAR; PG8_SCHED;
            PG8_LDB(B1, 0, 1); PG8_STAGE(PG8_SB(0, 0), b2, voffB);
            PG8_BAR; PG8_WAIT_L(0); PG8_MMA(0, 1, At, B1); PG8_BAR;
            PG8_LDA(At, 0, 1); PG8_STAGE(PG8_SA(0, 0), a2, voffA);
            PG8_BAR; PG8_WAIT_L(0); PG8_MMA(1, 0, At, B0); PG8_BAR; PG8_SCHED;
            PG8_STAGE(PG8_SB(0, 1), b2 + hstep, voffB);
            PG8_WAIT_V(6); PG8_BAR; PG8_MMA(1, 1, At, B1); PG8_BAR;
            PG8_LDB(B0, 1, 0); PG8_SCHED; PG8_LDA(At, 1, 0); PG8_STAGE(PG8_SA(0, 1), a2 + hstep, voffA);
            PG8_WAIT_L(8); PG8_BAR; PG8_WAIT_L(0); PG8_MMA(0, 0, At, B0); PG8_BAR; PG8_SCHED;
            PG8_LDB(B1, 1, 1); PG8_STAGE(PG8_SB(1, 0), b3, voffB);
            PG8_BAR; PG8_WAIT_L(0); PG8_MMA(0, 1, At, B1); PG8_BAR;
            PG8_LDA(At, 1, 1); PG8_STAGE(PG8_SA(1, 0), a3, voffA);
            PG8_BAR; PG8_WAIT_L(0); PG8_MMA(1, 0, At, B0); PG8_BAR; PG8_SCHED;
            PG8_STAGE(PG8_SB(1, 1), b3 + hstep, voffB);
            PG8_WAIT_V(6); PG8_BAR; PG8_MMA(1, 1, At, B1); PG8_BAR;
            }
        }
        if constexpr (ALIGN_EPI) { if (wr == 0) PG8_BAR; }
        if constexpr (!Epi::AFTER_DRAIN) { E(acc, cur, wr, wc, fr, fq); S.done(cur); }
        if (!has_next) break;
#pragma unroll
        for (int a = 0; a < 2; ++a)
#pragma unroll
            for (int b = 0; b < 2; ++b)
#pragma unroll
                for (int m = 0; m < 4; ++m)
#pragma unroll
                    for (int n = 0; n < 2; ++n) acc[a][b][m][n] = (f32x4){0.f, 0.f, 0.f, 0.f};
        cur = nxt; cA = nA; cB = nB; ++ui;
        if constexpr (ALIGN_EPI) { if (wr == 1) PG8_BAR; }
    }
    PG8_WAIT_V(0);
    if constexpr (!ALIGN_EPI) { if (wr == 0) PG8_BAR; }
    PG8_BAR;
    if constexpr (Epi::AFTER_DRAIN) { E.fused(acc, cur, wr, wc, fr, fq, lds, wid, lane); S.done(cur); }
#undef PG8_SA
#undef PG8_SB
#undef PG8_STAGE
#undef PG8_LDA
#undef PG8_LDB
#undef PG8_MMA
#undef PG8_WAIT_V
#undef PG8_WAIT_L
#undef PG8_BAR
#undef PG8_SCHED
}
}
constexpr int DM = 1024, NCTX = 4096, NLAT = 8192, MROWS = 12288;
constexpr int CSEQ = 256, LSEQ = 1024, PAST = 512, LKEYS = 1536;
constexpr int INC = 4096, FF = 2816, FF2 = 5632, AW = 512;
constexpr float ALPHA = 1.189207115002721f, LN_EPS = 1e-5f;
constexpr float QSCALE = 0.125f * 1.4426950408889634f;
constexpr int NWAVES = 8, NTHR = 512;
constexpr int LDS_BYTES = 147456;
constexpr int RING_BYTES = 131072, MISC_OFF = RING_BYTES + 320;

constexpr size_t MiB = 1u << 20;
constexpr size_t WS_CTL = 0, CTL_ZERO_BYTES = 65536;
constexpr size_t WS_MOD = 1 * MiB;
constexpr size_t WS_ROPE = 1 * MiB + 512 * 1024;
constexpr size_t WS_WIN = 2 * MiB, WS_WOUT = 10 * MiB, WS_WUP = 12 * MiB, WS_WDN = 23 * MiB;
constexpr size_t WS_XM = 29 * MiB;
constexpr size_t WS_Q = 53 * MiB, WS_KC = 65 * MiB, WS_VC = 69 * MiB, WS_KL = 73 * MiB, WS_VL = 85 * MiB;
constexpr size_t WS_RQ = 97 * MiB, WS_RI = 109 * MiB, WS_RG = 121 * MiB, WS_GF = 133 * MiB, WS_GB = 157 * MiB, WS_OF = 181 * MiB, WS_MIX = 205 * MiB;
constexpr size_t WS_H = 53 * MiB;
constexpr size_t WS_G = 185 * MiB;
constexpr size_t WS_END = 251 * MiB;
constexpr size_t OUT_Y = 0, OUT_K = 12582912, OUT_V = OUT_K + 2097152, OUT_S = OUT_V + 2097152;
constexpr int CW_BAR = 4096;

#define GAS __attribute__((address_space(1)))
#define LAS __attribute__((address_space(3)))
typedef unsigned short bf16;
typedef unsigned v4u __attribute__((ext_vector_type(4)));
typedef unsigned v2u __attribute__((ext_vector_type(2)));
typedef float f32x4 __attribute__((ext_vector_type(4)));
typedef short bf16x8 __attribute__((ext_vector_type(8)));
typedef GAS unsigned gu32;
#define RLX_AGENT __ATOMIC_RELAXED, __HIP_MEMORY_SCOPE_AGENT
#define LDS_WAIT() asm volatile("s_waitcnt lgkmcnt(0)" ::: "memory")
#define VM_WAIT() asm volatile("s_waitcnt vmcnt(0)" ::: "memory")
__device__ __forceinline__ unsigned f2bf(float f) { unsigned u = __builtin_bit_cast(unsigned, f); return (u + 0x7fffu + ((u >> 16) & 1u)) >> 16; }
__device__ __forceinline__ unsigned pk2(float lo, float hi) { return f2bf(lo) | (f2bf(hi) << 16); }
__device__ __forceinline__ float bflo(unsigned w) { return __uint_as_float(w << 16); }
__device__ __forceinline__ float bfhi(unsigned w) { return __uint_as_float(w & 0xffff0000u); }
__device__ __forceinline__ float wave_sum(float v) {
#pragma unroll
    for (int o = 1; o < 64; o <<= 1) v += __shfl_xor(v, o);
    return v;
}
__device__ __forceinline__ float wave_max(float v) {
#pragma unroll
    for (int o = 1; o < 64; o <<= 1) v = fmaxf(v, __shfl_xor(v, o));
    return v;
}
__device__ __forceinline__ float sigmoidf_(float z) { return 1.0f / (1.0f + __expf(-z)); }
__device__ __forceinline__ float siluf_(float z) { return z / (1.0f + __expf(-z)); }

struct Args { const float* in[27]; float* out; unsigned char* ws; int ph_lo, ph_hi; };
#define XB_TMO      128
#define XB_XCNT(j)  (256  + 64 * (j))
#define XB_XSUB(j)  (1280 + 64 * (j))
#define XB_XGEN(j)  (2304 + 64 * (j))
#define XB_TOP      3328
#define XB_TOPGEN   3392
#define XCD_BAR_WORDS 3456
#define XB_SPIN_CAP (1u << 18)

__device__ __forceinline__ unsigned xb_ld(unsigned* p)              { return __hip_atomic_load(p, __ATOMIC_RELAXED, __HIP_MEMORY_SCOPE_AGENT); }
__device__ __forceinline__ unsigned xb_add(unsigned* p, unsigned v) { return __hip_atomic_fetch_add(p, v, __ATOMIC_RELAXED, __HIP_MEMORY_SCOPE_AGENT); }
__device__ __forceinline__ unsigned xb_xcc_id() { return (unsigned)__builtin_amdgcn_s_getreg((3 << 11) | 20) & 0xFu; }
#define XB_SPIN(cond, bar) do { unsigned _sp = 0; while (cond) { __builtin_amdgcn_s_sleep(1); \
    if ((++_sp & 255u) == 0u) { if (xb_ld(&(bar)[XB_TMO])) break; if (_sp > XB_SPIN_CAP) { atomicAdd(&(bar)[XB_TMO], 1u); break; } } } } while (0)

struct XcdBarrier {
    unsigned* bar; unsigned x;
    volatile LAS unsigned* st;
};

__device__ __forceinline__ XcdBarrier xcd_barrier_post(unsigned* bar, volatile LAS unsigned* st) {
    XcdBarrier b; b.bar = bar; b.x = xb_xcc_id(); b.st = st;
    if (threadIdx.x == 0) (void)xb_add(&bar[XB_XCNT(b.x)], 1u);
    return b;
}
__device__ __forceinline__ void xcd_barrier_complete(unsigned* bar, unsigned x, unsigned& nloc, unsigned& nx) {
    const unsigned G = gridDim.x * gridDim.y * gridDim.z;
    unsigned sum, cnt, mine, sp = 0u;
    for (;;) {
        sum = 0u; cnt = 0u; mine = 0u;
#pragma unroll
        for (unsigned j = 0; j < 16; ++j) { const unsigned c = xb_ld(&bar[XB_XCNT(j)]); sum += c; cnt += (c > 0u) ? 1u : 0u; mine = (j == x) ? c : mine; }
        if (sum == G) break;
        __builtin_amdgcn_s_sleep(1);
        if ((++sp & 255u) == 0u) { if (xb_ld(&bar[XB_TMO])) break; if (sp > XB_SPIN_CAP) { atomicAdd(&bar[XB_TMO], 1u); break; } }
    }
    nloc = mine > 0u ? mine : 1u; nx = cnt > 0u ? cnt : 1u;
}

__device__ __forceinline__ void xcd_barrier(const XcdBarrier& b) {
    asm volatile("s_waitcnt vmcnt(0)" ::: "memory");
    __syncthreads();
    if (threadIdx.x == 0) {
        unsigned* bar = b.bar;
        __builtin_amdgcn_s_waitcnt(0);
        unsigned nloc = b.st[0], nx = b.st[1];
        if (nloc == 0u) { xcd_barrier_complete(bar, b.x, nloc, nx); b.st[0] = nloc; b.st[1] = nx; }
        const unsigned old = xb_add(&bar[XB_XSUB(b.x)], 1u);
        const unsigned gen = old / nloc;
        if (old + 1u == (gen + 1u) * nloc) {
            __builtin_amdgcn_fence(__ATOMIC_RELEASE, "agent");
            asm volatile("s_waitcnt vmcnt(0)" ::: "memory");
            const unsigned og = xb_add(&bar[XB_TOP], 1u);
            const unsigned tg = og / nx;
            if (og + 1u == (tg + 1u) * nx) xb_add(&bar[XB_TOPGEN], 1u);
            else XB_SPIN(xb_ld(&bar[XB_TOPGEN]) == tg, bar);
            __builtin_amdgcn_fence(__ATOMIC_ACQUIRE, "agent");
            xb_add(&bar[XB_XGEN(b.x)], 1u);
            asm volatile("s_waitcnt vmcnt(0)" ::: "memory");
        } else {
            XB_SPIN(xb_ld(&bar[XB_XGEN(b.x)]) == gen, bar);
            __builtin_amdgcn_fence(__ATOMIC_ACQUIRE, "agent");
            asm volatile("s_waitcnt vmcnt(0)" ::: "memory");
        }
    }
    __syncthreads();
}

__device__ __forceinline__ int mod_index(int row) { return row < NCTX ? 0 : 1 + ((row - NCTX) >> 10); }
__device__ __forceinline__ const float* xrow_ptr(const float* xp, const float* xs, int row) { return row < NCTX ? xp + (size_t)row * DM : xs + (size_t)(row - NCTX) * DM; }
__device__ __forceinline__ v2u pk4(f32x4 v) { v2u w; w.x = pk2(v[0], v[1]); w.y = pk2(v[2], v[3]); return w; }

struct Epi1 {
    static constexpr bool PERM = false, AFTER_DRAIN = false;
    bf16 *Q, *KC, *VC, *KL, *VL, *RQ, *RI, *RG; float *GF, *GB; float *outK, *outV; const float* rope; const float *lbf, *lbb;
    __device__ __forceinline__ void operator()(const f32x4 (&acc)[2][2][4][2], const pg8::Unit& u, int wr, int wc, int fr, int fq) const {
        const int grp = u.pn >> 1, cbase = (u.pn & 1) * 256; const bool ctx = u.pm < 16;
        if (grp <= 1) {
            const int half = wc & 1;
#pragma unroll
            for (int ai = 0; ai < 2; ++ai)
#pragma unroll
                for (int m = 0; m < 4; ++m) {
                    const int row = u.pm * 256 + ai * 128 + wr * 64 + m * 16 + fr;
                    f32x4 cs0 = (f32x4){1.f, 0.f, 1.f, 0.f}, cs1 = cs0;
                    if (!ctx) { const int t = (row - NCTX) & 1023; const int pos = half ? (t & 63) : (t >> 6);
                        const float* tp = rope + (size_t)pos * 32 + 8 * fq; cs0 = *(const f32x4*)tp; cs1 = *(const f32x4*)(tp + 4); }
#pragma unroll
                    for (int bj = 0; bj < 2; ++bj) {
                        const f32x4 x1 = acc[ai][bj][m][0], x2 = acc[ai][bj][m][1]; f32x4 o1, o2;
                        o1[0] = x1[0] * cs0[0] - x2[0] * cs0[1]; o2[0] = x1[0] * cs0[1] + x2[0] * cs0[0];
                        o1[1] = x1[1] * cs0[2] - x2[1] * cs0[3]; o2[1] = x1[1] * cs0[3] + x2[1] * cs0[2];
                        o1[2] = x1[2] * cs1[0] - x2[2] * cs1[1]; o2[2] = x1[2] * cs1[1] + x2[2] * cs1[0];
                        o1[3] = x1[3] * cs1[2] - x2[3] * cs1[3]; o2[3] = x1[3] * cs1[3] + x2[3] * cs1[2];
                        const int cg = cbase + bj * 128 + wc * 32 + 4 * fq;
                        if (grp == 0) { *(v2u*)(Q + (size_t)row * AW + cg) = pk4(o1 * QSCALE); *(v2u*)(Q + (size_t)row * AW + cg + 16) = pk4(o2 * QSCALE); }
                        else if (ctx) { *(f32x4*)(outK + (size_t)row * AW + cg) = x1; *(f32x4*)(outK + (size_t)row * AW + cg + 16) = x2;
                                        *(v2u*)(KC + (size_t)row * AW + cg) = pk4(x1); *(v2u*)(KC + (size_t)row * AW + cg + 16) = pk4(x2); }
                        else { const int b = (row - NCTX) >> 10, t = (row - NCTX) & 1023; bf16* kp = KL + ((size_t)b * LKEYS + PAST + t) * AW + cg;
                               *(v2u*)kp = pk4(o1); *(v2u*)(kp + 16) = pk4(o2); }
                    }
                }
            return;
        }
        f32x4 lb[2][2];
        if (grp == 4 || grp == 5) { const float* lg = grp == 4 ? lbf : lbb;
#pragma unroll
            for (int bj = 0; bj < 2; ++bj)
#pragma unroll
                for (int n = 0; n < 2; ++n) { const int cg = cbase + bj * 128 + wc * 32 + n * 16 + 4 * fq; const f32x4 l0 = *(const f32x4*)(lg + cg), l1 = *(const f32x4*)(lg + AW + cg);
#pragma unroll
                    for (int i = 0; i < 4; ++i) lb[bj][n][i] = sigmoidf_(l0[i] - l1[i]); } }
#pragma unroll
        for (int ai = 0; ai < 2; ++ai)
#pragma unroll
            for (int m = 0; m < 4; ++m) {
                const int row = u.pm * 256 + ai * 128 + wr * 64 + m * 16 + fr;
#pragma unroll
                for (int bj = 0; bj < 2; ++bj)
#pragma unroll
                    for (int n = 0; n < 2; ++n) {
                        const int cg = cbase + bj * 128 + wc * 32 + n * 16 + 4 * fq; const f32x4 v = acc[ai][bj][m][n]; const size_t o = (size_t)row * AW + cg;
                        if (grp == 2) { if (ctx) { *(f32x4*)(outV + o) = v; *(v2u*)(VC + o) = pk4(v); }
                                        else { const int b = (row - NCTX) >> 10, t = (row - NCTX) & 1023; *(v2u*)(VL + ((size_t)b * LKEYS + PAST + t) * AW + cg) = pk4(v); } }
                        else if (grp == 3) *(v2u*)(RQ + o) = pk4(v);
                        else if (grp == 4 || grp == 5) { f32x4 w;
#pragma unroll
                            for (int i = 0; i < 4; ++i) { const float l = lb[bj][n][i]; w[i] = __logf(l + (1.0f - l) * sigmoidf_(v[i])); }
                            *(f32x4*)((grp == 4 ? GF : GB) + o) = w; }
                        else if (grp == 6) *(v2u*)(RI + o) = pk4(v);
                        else { f32x4 w;
#pragma unroll
                            for (int i = 0; i < 4; ++i) w[i] = siluf_(v[i]);
                            *(v2u*)(RG + o) = pk4(w); }
                    }
            }
    }
};
struct EpiRes {
    static constexpr bool PERM = false, AFTER_DRAIN = false;
    const float *xp, *xs; const float* ybase; float* out; const float* gate;
    __device__ __forceinline__ void operator()(const f32x4 (&acc)[2][2][4][2], const pg8::Unit& u, int wr, int wc, int fr, int fq) const {
        const int mi = u.pm < 16 ? 0 : 1 + ((u.pm - 16) >> 2); const float* gp = gate + (size_t)mi * 6144;
        f32x4 gv[2][2];
#pragma unroll
        for (int bj = 0; bj < 2; ++bj)
#pragma unroll
            for (int n = 0; n < 2; ++n) gv[bj][n] = *(const f32x4*)(gp + u.pn * 256 + bj * 128 + wc * 32 + n * 16 + 4 * fq);
#pragma unroll
        for (int ai = 0; ai < 2; ++ai)
#pragma unroll
            for (int m = 0; m < 4; ++m) {
                const int row = u.pm * 256 + ai * 128 + wr * 64 + m * 16 + fr;
                const float* bp = ybase ? ybase + (size_t)row * DM : xrow_ptr(xp, xs, row);
#pragma unroll
                for (int bj = 0; bj < 2; ++bj)
#pragma unroll
                    for (int n = 0; n < 2; ++n) { const int col = u.pn * 256 + bj * 128 + wc * 32 + n * 16 + 4 * fq;
                        const f32x4 b = *(const f32x4*)(bp + col); *(f32x4*)(out + (size_t)row * DM + col) = b * ALPHA + gv[bj][n] * acc[ai][bj][m][n]; }
            }
    }
};
struct EpiH {
    static constexpr bool PERM = false, AFTER_DRAIN = false;
    bf16* H;
    __device__ __forceinline__ void operator()(const f32x4 (&acc)[2][2][4][2], const pg8::Unit& u, int wr, int wc, int fr, int fq) const {
#pragma unroll
        for (int ai = 0; ai < 2; ++ai)
#pragma unroll
            for (int m = 0; m < 4; ++m) {
                const int row = u.pm * 256 + ai * 128 + wr * 64 + m * 16 + fr;
#pragma unroll
                for (int bj = 0; bj < 2; ++bj)
#pragma unroll
                    for (int n = 0; n < 2; ++n) { const int col = u.pn * 256 + bj * 128 + wc * 32 + n * 16 + 4 * fq; *(v2u*)(H + (size_t)row * FF2 + col) = pk4(acc[ai][bj][m][n]); }
            }
    }
};
__device__ __forceinline__ void p0_transpose_item(const float* W, int K, int N, bf16* WT, int k0, int n0, int orow0, LAS float* scr, int lane) {
#pragma unroll 8
    for (int i = 0; i < 32; ++i) { const int kk = 2 * i + (lane >> 5); scr[kk * 33 + (lane & 31)] = W[(size_t)(k0 + kk) * N + n0 + (lane & 31)]; }
    LDS_WAIT(); asm volatile("" ::: "memory");
    const int c = lane & 7;
#pragma unroll
    for (int j = 0; j < 4; ++j) { const int n = (lane >> 3) + 8 * j; const LAS float* s = scr + (8 * c) * 33 + n;
        v4u o; o.x = pk2(s[0 * 33], s[1 * 33]); o.y = pk2(s[2 * 33], s[3 * 33]); o.z = pk2(s[4 * 33], s[5 * 33]); o.w = pk2(s[6 * 33], s[7 * 33]);
        *(GAS v4u*)(WT + (size_t)(orow0 + n) * K + k0 + 8 * c) = o; }
    LDS_WAIT(); asm volatile("" ::: "memory");
}
__device__ __forceinline__ void p0_prologue(const Args& a, LAS unsigned char* lds, int vcu, int G, int tid, int lane, int wave) {
    unsigned char* ws = a.ws;
    {
        LAS float* cl = (LAS float*)lds;
        LAS float* red = (LAS float*)(lds + 40960);
        float* mod = (float*)(ws + WS_MOD);
        const float* wada = a.in[7]; const float* bada = a.in[8];
        bool filled = false;
        for (int cb = vcu; cb < 192; cb += G) {
            if (!filled) {
                for (int i = tid; i < 9 * 1024; i += NTHR) { const int m = i >> 10, k = i & 1023; const float v = (m == 0) ? a.in[6][k] : a.in[5][(m - 1) * 1024 + k]; cl[i] = siluf_(v); }
                filled = true; __syncthreads();
            }
            const int n0 = cb * 32, kr = lane >> 3, c4 = lane & 7;
            f32x4 acc[9];
#pragma unroll
            for (int m = 0; m < 9; ++m) acc[m] = (f32x4){0.f, 0.f, 0.f, 0.f};
            for (int it = 0; it < 16; ++it) { const int k = wave * 128 + it * 8 + kr; const f32x4 wv = *(const f32x4*)(wada + (size_t)k * 6144 + n0 + 4 * c4);
#pragma unroll
                for (int m = 0; m < 9; ++m) acc[m] += wv * cl[m * 1024 + k]; }
#pragma unroll
            for (int m = 0; m < 9; ++m)
#pragma unroll
                for (int i = 0; i < 4; ++i) { float v = acc[m][i]; v += __shfl_xor(v, 8); v += __shfl_xor(v, 16); v += __shfl_xor(v, 32); acc[m][i] = v; }
            if (kr == 0) {
#pragma unroll
                for (int m = 0; m < 9; ++m) *(LAS f32x4*)(red + (wave * 9 + m) * 32 + 4 * c4) = acc[m]; }
            __syncthreads();
            if (tid < 288) { const int m = tid >> 5, cc = tid & 31; float s = bada[n0 + cc];
#pragma unroll
                for (int w = 0; w < 8; ++w) s += red[(w * 9 + m) * 32 + cc];
                mod[(size_t)m * 6144 + n0 + cc] = s; }
            __syncthreads();
        }
        __syncthreads();
    }
    if (vcu == (G > 200 ? 200 : 0)) {
        float* rope = (float*)(ws + WS_ROPE);
        for (int i = tid; i < 1024; i += NTHR) { const int pos = i >> 4, j = i & 15;
            const float freq = 1.0f / powf(10000.0f, (float)j * (1.0f / 16.0f)); const float angf = (float)pos * freq; const double ang = (double)angf;
            const double nq = __builtin_rint(ang * 0.63661977236758134308); const double r = __builtin_fma(-nq, 1.5707963267948966192, ang) - nq * 6.123233995736766e-17; const double r2 = r * r;
            double sn = r * (1.0 + r2 * (-1.0 / 6 + r2 * (1.0 / 120 + r2 * (-1.0 / 5040 + r2 * (1.0 / 362880 + r2 * (-1.0 / 39916800 + r2 * (1.0 / 6227020800.0)))))));
            double cn = 1.0 + r2 * (-0.5 + r2 * (1.0 / 24 + r2 * (-1.0 / 720 + r2 * (1.0 / 40320 + r2 * (-1.0 / 3628800 + r2 * (1.0 / 479001600 + r2 * (-1.0 / 87178291200.0)))))));
            const int q = ((int)nq) & 3; double cc, ss;
            if (q == 0) { cc = cn; ss = sn; } else if (q == 1) { cc = -sn; ss = cn; } else if (q == 2) { cc = -cn; ss = -sn; } else { cc = sn; ss = -cn; }
            rope[2 * i] = (float)cc; rope[2 * i + 1] = (float)ss; }
    }
    {
        bf16* KL = (bf16*)(ws + WS_KL); bf16* VL = (bf16*)(ws + WS_VL);
        const int gt = vcu * NTHR + tid, NGT = G * NTHR;
        for (int i = gt; i < 2 * 524288; i += NGT) { const int which = i >= 524288, e4 = which ? i - 524288 : i;
            const int rowi = e4 >> 7, c4 = e4 & 127, b = rowi >> 9, j = rowi & 511;
            const f32x4 v = *(const f32x4*)((which ? a.in[3] : a.in[2]) + (size_t)e4 * 4);
            *(v2u*)((which ? VL : KL) + ((size_t)b * LKEYS + j) * AW + 4 * c4) = pk4(v); }
    }
    {
        LAS float* scr = (LAS float*)(lds + wave * 16384);
        const int gw = vcu * NWAVES + wave, NGW = G * NWAVES;
        constexpr int I_IN = 16 * 128, I_OUT = 16 * 32, I_UP = 16 * 176, I_DN = 44 * 32, NITEMS = I_IN + I_OUT + I_UP + I_DN;
        for (int it = gw; it < NITEMS; it += NGW) {
            int r = it;
            if (r < I_IN) { const int kb = r / 128, nb = r % 128; p0_transpose_item(a.in[9], DM, INC, (bf16*)(ws + WS_WIN), 64 * kb, 32 * nb, 32 * nb, scr, lane); continue; } r -= I_IN;
            if (r < I_OUT) { const int kb = r / 32, nb = r % 32; p0_transpose_item(a.in[18], DM, DM, (bf16*)(ws + WS_WOUT), 64 * kb, 32 * nb, 32 * nb, scr, lane); continue; } r -= I_OUT;
            if (r < I_UP) { const int kb = r / 176, nb = r % 176, n0 = 32 * nb; const int n1 = n0 < FF ? n0 : n0 - FF; const int orow = 256 * (n1 >> 7) + (n0 < FF ? 0 : 128) + (n1 & 127);
                p0_transpose_item(a.in[21], DM, FF2, (bf16*)(ws + WS_WUP), 64 * kb, n0, orow, scr, lane); continue; } r -= I_UP;
            { const int kb = r / 32, nb = r % 32; p0_transpose_item(a.in[24], FF, DM, (bf16*)(ws + WS_WDN), 64 * kb, 32 * nb, 32 * nb, scr, lane); }
        }
    }
}
__device__ __forceinline__ void p1_modulate(const Args& a, int vcu, int G, int lane, int wave) {
    const float* mod = (const float*)(a.ws + WS_MOD); bf16* XM = (bf16*)(a.ws + WS_XM);
    const int gw = vcu * NWAVES + wave, NGW = G * NWAVES;
    for (int row = gw; row < MROWS; row += NGW) {
        const float* xr = xrow_ptr(a.in[0], a.in[1], row); const float* mp = mod + (size_t)mod_index(row) * 6144;
#pragma unroll
        for (int j = 0; j < 4; ++j) { const int c = 4 * (lane + 64 * j); const f32x4 x = *(const f32x4*)(xr + c), sh = *(const f32x4*)(mp + c), sc = *(const f32x4*)(mp + 1024 + c);
            *(v2u*)(XM + (size_t)row * DM + c) = pk4(x * (sc + 1.0f) + sh); }
    }
}
__device__ __forceinline__ void ln_rows(const Args& a, const float* g, const float* bta, bool write_xm, int vcu, int G, int lane, int wave) {
    float* Y = a.out + OUT_Y; const float* mod = (const float*)(a.ws + WS_MOD); bf16* XM = (bf16*)(a.ws + WS_XM);
    const int gw = vcu * NWAVES + wave, NGW = G * NWAVES;
    for (int row = gw; row < MROWS; row += NGW) {
        float* yr = Y + (size_t)row * DM; f32x4 v[4]; float s = 0.f;
#pragma unroll
        for (int j = 0; j < 4; ++j) { v[j] = *(const f32x4*)(yr + 4 * (lane + 64 * j)); s += (v[j][0] + v[j][1]) + (v[j][2] + v[j][3]); }
        const float mean = wave_sum(s) * (1.0f / DM); float s2 = 0.f;
#pragma unroll
        for (int j = 0; j < 4; ++j) { v[j] = v[j] - mean; s2 += (v[j][0] * v[j][0] + v[j][1] * v[j][1]) + (v[j][2] * v[j][2] + v[j][3] * v[j][3]); }
        const float rstd = 1.0f / sqrtf(wave_sum(s2) * (1.0f / DM) + LN_EPS);
        const float* mp = mod + (size_t)mod_index(row) * 6144;
#pragma unroll
        for (int j = 0; j < 4; ++j) { const int c = 4 * (lane + 64 * j); const f32x4 x1 = v[j] * rstd * *(const f32x4*)(g + c) + *(const f32x4*)(bta + c);
            *(f32x4*)(yr + c) = x1;
            if (write_xm) { const f32x4 sh = *(const f32x4*)(mp + 3072 + c), sc = *(const f32x4*)(mp + 4096 + c); *(v2u*)(XM + (size_t)row * DM + c) = pk4(x1 * (sc + 1.0f) + sh); } }
    }
}
__device__ __forceinline__ void conv_gate(const Args& a, int vcu, int G, int tid) {
    const bf16* H = (const bf16*)(a.ws + WS_H); bf16* Gt = (bf16*)(a.ws + WS_G); const float* cw = a.in[22]; const float* cb = a.in[23];
    const int gt = vcu * NTHR + tid, NGT = G * NTHR; constexpr int PER_ROW = 22 * 32;
    for (int i = gt; i < MROWS * PER_ROW; i += NGT) {
        const int row = i / PER_ROW, r2 = i % PER_ROW, pn = r2 >> 5, jj = (r2 & 31) * 4;
        const int t = row < NCTX ? (row & 255) : ((row - NCTX) & 1023), L = row < NCTX ? CSEQ : LSEQ;
        const bool hp = t > 0, hn = t < L - 1;
        const int ca = 128 * pn + jj, cu = FF + ca;
        const bf16* hp0 = H + (size_t)row * FF2 + 256 * pn + jj;
        const v2u z = (v2u){0u, 0u};
        const v2u a0 = hp ? *(const v2u*)(hp0 - FF2) : z, a1 = *(const v2u*)hp0, a2 = hn ? *(const v2u*)(hp0 + FF2) : z;
        const v2u u0 = hp ? *(const v2u*)(hp0 - FF2 + 128) : z, u1 = *(const v2u*)(hp0 + 128), u2 = hn ? *(const v2u*)(hp0 + FF2 + 128) : z;
        const f32x4 wa0 = *(const f32x4*)(cw + ca), wa1 = *(const f32x4*)(cw + FF2 + ca), wa2 = *(const f32x4*)(cw + 2 * FF2 + ca), ba = *(const f32x4*)(cb + ca);
        const f32x4 wu0 = *(const f32x4*)(cw + cu), wu1 = *(const f32x4*)(cw + FF2 + cu), wu2 = *(const f32x4*)(cw + 2 * FF2 + cu), bu = *(const f32x4*)(cb + cu);
        const f32x4 A0 = (f32x4){bflo(a0.x), bfhi(a0.x), bflo(a0.y), bfhi(a0.y)}, A1 = (f32x4){bflo(a1.x), bfhi(a1.x), bflo(a1.y), bfhi(a1.y)}, A2 = (f32x4){bflo(a2.x), bfhi(a2.x), bflo(a2.y), bfhi(a2.y)};
        const f32x4 U0 = (f32x4){bflo(u0.x), bfhi(u0.x), bflo(u0.y), bfhi(u0.y)}, U1 = (f32x4){bflo(u1.x), bfhi(u1.x), bflo(u1.y), bfhi(u1.y)}, U2 = (f32x4){bflo(u2.x), bfhi(u2.x), bflo(u2.y), bfhi(u2.y)};
        const f32x4 av = A0 * wa0 + A1 * wa1 + A2 * wa2 + ba, uv = U0 * wu0 + U1 * wu1 + U2 * wu2 + bu; f32x4 gv;
#pragma unroll
        for (int k = 0; k < 4; ++k) gv[k] = siluf_(av[k]) * uv[k];
        *(v2u*)(Gt + (size_t)row * FF + ca) = pk4(gv);
    }
}
__device__ __forceinline__ float calc_lam(const Args& a, int lane) {
    const float s1 = wave_sum(a.in[10][lane] * a.in[11][lane]), s2 = wave_sum(a.in[12][lane] * a.in[13][lane]);
    return expf(s1) - expf(s2) + 0.2f;
}
__device__ __forceinline__ void attn_naive(const Args& a, LAS unsigned char* lds, int vcu, int G, int lane, int wave) {
    unsigned char* ws = a.ws;
    const bf16* Q = (const bf16*)(ws + WS_Q); bf16* MIX = (bf16*)(ws + WS_MIX); const float* attg = a.in[16];
    LAS float* qf = (LAS float*)(lds + wave * 12800);
    LAS float* sc = qf + 128;
    const float lam = calc_lam(a, lane);
    for (int it = vcu; it < 6144; it += G) {
        const int h = it & 3, row = (it >> 2) * 8 + wave; const bool ctx = row < NCTX;
        const int nk = ctx ? CSEQ : LKEYS;
        const bf16 *Kp, *Vp;
        if (ctx) { const int b = row >> 8; Kp = (const bf16*)(ws + WS_KC) + (size_t)b * CSEQ * AW + h * 128; Vp = (const bf16*)(ws + WS_VC) + (size_t)b * CSEQ * AW + h * 128; }
        else { const int b = (row - NCTX) >> 10; Kp = (const bf16*)(ws + WS_KL) + (size_t)b * LKEYS * AW + h * 128; Vp = (const bf16*)(ws + WS_VL) + (size_t)b * LKEYS * AW + h * 128; }
        { const unsigned w = *(const unsigned*)(Q + (size_t)row * AW + h * 128 + 2 * lane); qf[2 * lane] = bflo(w); qf[2 * lane + 1] = bfhi(w); }
        LDS_WAIT(); asm volatile("" ::: "memory");
        float m1 = -3.0e38f, m2 = -3.0e38f;
        for (int j = lane; j < nk; j += 64) {
            const bf16* kp = Kp + (size_t)j * AW; float s1 = 0.f, s2 = 0.f;
#pragma unroll
            for (int c = 0; c < 8; ++c) { const v4u k1 = *(const v4u*)(kp + 8 * c), k2 = *(const v4u*)(kp + 64 + 8 * c);
                const LAS float* q1 = qf + 8 * c; const LAS float* q2 = qf + 64 + 8 * c;
                s1 += bflo(k1.x) * q1[0] + bfhi(k1.x) * q1[1] + bflo(k1.y) * q1[2] + bfhi(k1.y) * q1[3] + bflo(k1.z) * q1[4] + bfhi(k1.z) * q1[5] + bflo(k1.w) * q1[6] + bfhi(k1.w) * q1[7];
                s2 += bflo(k2.x) * q2[0] + bfhi(k2.x) * q2[1] + bflo(k2.y) * q2[2] + bfhi(k2.y) * q2[3] + bflo(k2.z) * q2[4] + bfhi(k2.z) * q2[5] + bflo(k2.w) * q2[6] + bfhi(k2.w) * q2[7]; }
            sc[j] = s1; sc[1536 + j] = s2; m1 = fmaxf(m1, s1); m2 = fmaxf(m2, s2);
        }
        m1 = wave_max(m1); m2 = wave_max(m2);
        float l1 = 0.f, l2 = 0.f;
        for (int j = lane; j < nk; j += 64) { const float p1 = exp2f(sc[j] - m1), p2 = exp2f(sc[1536 + j] - m2); sc[j] = p1; sc[1536 + j] = p2; l1 += p1; l2 += p2; }
        l1 = wave_sum(l1); l2 = wave_sum(l2);
        const float i1 = 1.0f / l1, i2 = lam / l2;
        for (int j = lane; j < nk; j += 64) sc[j] = sc[j] * i1 - sc[1536 + j] * i2;
        LDS_WAIT(); asm volatile("" ::: "memory");
        float o0 = 0.f, o1 = 0.f;
#pragma unroll 8
        for (int j = 0; j < nk; ++j) { const unsigned w = *(const unsigned*)(Vp + (size_t)j * AW + 2 * lane); const float p = sc[j]; o0 += p * bflo(w); o1 += p * bfhi(w); }
        const float ss = wave_sum(o0 * o0 + o1 * o1); const float r = 1.0f / sqrtf(ss * (1.0f / 128.0f) + LN_EPS) * 0.8f;
        *(unsigned*)(MIX + (size_t)row * DM + h * 128 + 2 * lane) = pk2(o0 * r * attg[h * 128 + 2 * lane], o1 * r * attg[h * 128 + 2 * lane + 1]);
        LDS_WAIT(); asm volatile("" ::: "memory");
    }
}
__device__ __forceinline__ void rnn_naive(const Args& a, LAS unsigned char* lds, int vcu, int G, int tid) {
    unsigned char* ws = a.ws;
    const bf16* RQ = (const bf16*)(ws + WS_RQ); const bf16* RI = (const bf16*)(ws + WS_RI); const bf16* RG = (const bf16*)(ws + WS_RG);
    float* OF = (float*)(ws + WS_OF); bf16* MIX = (bf16*)(ws + WS_MIX); const float* rnng = a.in[17];
    LAS float* Fl = (LAS float*)lds;
    LAS float* Kl = Fl + 2048; LAS float* Ql = Kl + 2048; LAS float* Vl = Ql + 2048;
    LAS float* PO = Vl + 2048;
    const int e = tid & 127, qd = tid >> 7;
    for (int it = vcu; it < 96; it += G) {
        const bool ctx = it < 64; const int bi = ctx ? it : it - 64, b = bi >> 2, h = bi & 3;
        const int L = ctx ? CSEQ : LSEQ, row0 = ctx ? b * CSEQ : NCTX + b * LSEQ;
        for (int dir = 0; dir < 2; ++dir) {
            const float* GT = (const float*)(ws + (dir ? WS_GB : WS_GF));
            float S[32];
            if (ctx) {
#pragma unroll
                for (int i = 0; i < 32; ++i) S[i] = 0.f;
            } else { const float* s0 = a.in[4] + ((size_t)(b * 2 + dir) * 4 + h) * 16384;
#pragma unroll
                for (int i = 0; i < 32; ++i) S[i] = s0[(size_t)(32 * qd + i) * 128 + e]; }
            for (int tb = 0; tb < L / 16; ++tb) {
#pragma unroll
                for (int j = 0; j < 4; ++j) { const int idx = tid + NTHR * j, i = idx >> 7, d = idx & 127; const int s = tb * 16 + i, t = dir ? L - 1 - s : s;
                    const size_t o = (size_t)(row0 + t) * AW + h * 128 + d;
                    const float f = __expf(GT[o]); Fl[idx] = f; Kl[idx] = 1.0f - f; Ql[idx] = __uint_as_float((unsigned)RQ[o] << 16); Vl[idx] = __uint_as_float((unsigned)RI[o] << 16); }
                __syncthreads();
#pragma unroll 1
                for (int i = 0; i < 16; ++i) { const float v = Vl[i * 128 + e]; float po = 0.f;
#pragma unroll
                    for (int dd = 0; dd < 32; ++dd) { const int d = 32 * qd + dd; S[dd] = Fl[i * 128 + d] * S[dd] + Kl[i * 128 + d] * v; po += S[dd] * Ql[i * 128 + d]; }
                    PO[(i * 4 + qd) * 128 + e] = po; }
                __syncthreads();
                { const int i = tid >> 5, e4 = (tid & 31) * 4; const int s = tb * 16 + i, t = dir ? L - 1 - s : s; const size_t o = (size_t)(row0 + t) * AW + h * 128 + e4;
                    f32x4 ov = *(const LAS f32x4*)(PO + (i * 4 + 0) * 128 + e4) + *(const LAS f32x4*)(PO + (i * 4 + 1) * 128 + e4) + *(const LAS f32x4*)(PO + (i * 4 + 2) * 128 + e4) + *(const LAS f32x4*)(PO + (i * 4 + 3) * 128 + e4);
                    if (dir == 0) *(f32x4*)(OF + o) = ov;
                    else { ov += *(const f32x4*)(OF + o);
                        float ss = (ov[0] * ov[0] + ov[1] * ov[1]) + (ov[2] * ov[2] + ov[3] * ov[3]);
                        ss += __shfl_xor(ss, 1); ss += __shfl_xor(ss, 2); ss += __shfl_xor(ss, 4); ss += __shfl_xor(ss, 8); ss += __shfl_xor(ss, 16);
                        const float r = 1.0f / sqrtf(ss * (1.0f / 128.0f) + LN_EPS); const f32x4 g = *(const f32x4*)(rnng + h * 128 + e4); const v2u gw = *(const v2u*)(RG + o);
                        f32x4 res; res[0] = ov[0] * r * g[0] * bflo(gw.x); res[1] = ov[1] * r * g[1] * bfhi(gw.x); res[2] = ov[2] * r * g[2] * bflo(gw.y); res[3] = ov[3] * r * g[3] * bfhi(gw.y);
                        *(v2u*)(MIX + (size_t)(row0 + t) * DM + AW + h * 128 + e4) = pk4(res); } }
            }
            if (ctx) { float* so = a.out + OUT_S + ((size_t)(b * 2 + dir) * 4 + h) * 16384;
#pragma unroll
                for (int i = 0; i < 32; ++i) so[(size_t)(32 * qd + i) * 128 + e] = S[i]; }
            __threadfence(); __syncthreads();
        }
    }
}
#ifndef MK_N_LAUNCHES
#define MK_N_LAUNCHES 1
#endif
constexpr int NPH = 10;
__global__ void __launch_bounds__(NTHR, 2) fwd(Args args) {
    extern __shared__ __attribute__((aligned(16))) unsigned char lds_[];
    LAS unsigned char* lds = (LAS unsigned char*)lds_;
    const int tid = threadIdx.x, lane = tid & 63, wave = __builtin_amdgcn_readfirstlane(tid >> 6);
    const int G = gridDim.x, bx = blockIdx.x, vcu = (G % 8 == 0) ? (bx % 8) * (G / 8) + bx / 8 : bx;
    unsigned char* ws = args.ws;
    for (int u = tid; u < (LDS_BYTES - RING_BYTES) / 4; u += NTHR) ((LAS unsigned*)(lds + RING_BYTES))[u] = 0u;
    __syncthreads();
    const int lo = args.ph_lo, hi = args.ph_hi;
    XcdBarrier bar; bar.bar = (unsigned*)(ws + WS_CTL) + CW_BAR; bar.x = 0; bar.st = nullptr;
    if (hi - lo > 1) bar = xcd_barrier_post((unsigned*)(ws + WS_CTL) + CW_BAR, (volatile LAS unsigned*)(lds + MISC_OFF) + 8);
#define IN(k) (lo <= (k) && (k) < hi)
#define SEAM(k) do { if (IN(k) && IN((k) + 1)) xcd_barrier(bar); } while (0)
    float* mod = (float*)(ws + WS_MOD);
    if (IN(0)) { p0_prologue(args, lds, vcu, G, tid, lane, wave); SEAM(0); }
    if (IN(1)) { p1_modulate(args, vcu, G, lane, wave); SEAM(1); }
    if (IN(2)) {
        pg8::Gemm g{(const bf16*)(ws + WS_XM), (const bf16*)(ws + WS_WIN), MROWS, INC, DM}; pg8::StaticOrder S; S.init(MROWS, INC, G, bx);
        Epi1 E{(bf16*)(ws + WS_Q), (bf16*)(ws + WS_KC), (bf16*)(ws + WS_VC), (bf16*)(ws + WS_KL), (bf16*)(ws + WS_VL), (bf16*)(ws + WS_RQ), (bf16*)(ws + WS_RI), (bf16*)(ws + WS_RG),
               (float*)(ws + WS_GF), (float*)(ws + WS_GB), args.out + OUT_K, args.out + OUT_V, (const float*)(ws + WS_ROPE), args.in[14], args.in[15]};
        pg8::gemm_phase<Epi1, pg8::StaticOrder, true, true>(lds, g, S, E);
        SEAM(2);
    }
    if (IN(3)) {
        if (G >= 192) { if (vcu < 96) rnn_naive(args, lds, vcu, 96, tid); else attn_naive(args, lds, vcu - 96, G - 96, lane, wave); }
        else { rnn_naive(args, lds, vcu, G, tid); __syncthreads(); attn_naive(args, lds, vcu, G, lane, wave); }
        SEAM(3);
    }
    if (IN(4)) {
        pg8::Gemm g{(const bf16*)(ws + WS_MIX), (const bf16*)(ws + WS_WOUT), MROWS, DM, DM}; pg8::StaticOrder S; S.init(MROWS, DM, G, bx);
        EpiRes E{args.in[0], args.in[1], nullptr, args.out + OUT_Y, mod + 2048};
        pg8::gemm_phase<EpiRes, pg8::StaticOrder, true, true>(lds, g, S, E);
        SEAM(4);
    }
    if (IN(5)) { ln_rows(args, args.in[19], args.in[20], true, vcu, G, lane, wave); SEAM(5); }
    if (IN(6)) {
        pg8::Gemm g{(const bf16*)(ws + WS_XM), (const bf16*)(ws + WS_WUP), MROWS, FF2, DM}; pg8::StaticOrder S; S.init(MROWS, FF2, G, bx);
        EpiH E{(bf16*)(ws + WS_H)};
        pg8::gemm_phase<EpiH, pg8::StaticOrder, true, true>(lds, g, S, E);
        SEAM(6);
    }
    if (IN(7)) { conv_gate(args, vcu, G, tid); SEAM(7); }
    if (IN(8)) {
        pg8::Gemm g{(const bf16*)(ws + WS_G), (const bf16*)(ws + WS_WDN), MROWS, DM, FF}; pg8::StaticOrder S; S.init(MROWS, DM, G, bx);
        EpiRes E{args.in[0], args.in[1], args.out + OUT_Y, args.out + OUT_Y, mod + 5120};
        pg8::gemm_phase<EpiRes, pg8::StaticOrder, true, true>(lds, g, S, E);
        SEAM(8);
    }
    if (IN(9)) { ln_rows(args, args.in[25], args.in[26], false, vcu, G, lane, wave); }
#undef IN
#undef SEAM
}

extern "C" void kernel_launch(void* const* d_in, const int* in_sizes, int n_in, void* d_out, int out_size, void* d_ws, size_t ws_size, hipStream_t stream) {
    static int grid = 0;
    if (grid == 0) {
        if (n_in != 27 || out_size != 18874368 || ws_size < WS_END) { fprintf(stderr, "kernel_launch: unexpected shapes (n_in %d, out %d, ws %zu)\n", n_in, out_size, ws_size); grid = -1; return; }
        int dev = 0, cus = 0, per_cu = 0;
        if (hipGetDevice(&dev) != hipSuccess || hipDeviceGetAttribute(&cus, hipDeviceAttributeMultiprocessorCount, dev) != hipSuccess) { grid = -1; return; }
        if (hipFuncSetAttribute((const void*)fwd, hipFuncAttributeMaxDynamicSharedMemorySize, LDS_BYTES) != hipSuccess) { fprintf(stderr, "kernel_launch: hipFuncSetAttribute failed\n"); grid = -1; return; }
        if (hipOccupancyMaxActiveBlocksPerMultiprocessor(&per_cu, (const void*)fwd, NTHR, LDS_BYTES) != hipSuccess || per_cu < 1) { fprintf(stderr, "kernel_launch: occupancy query reports %d\n", per_cu); per_cu = 1; }
        (void)hipGetLastError();
        grid = cus;
    }
    if (grid < 0) return;
    (void)hipMemsetAsync((char*)d_ws + WS_CTL, 0, CTL_ZERO_BYTES, stream);
    Args a{};
    for (int i = 0; i < 27; ++i) a.in[i] = (const float*)d_in[i];
    a.out = (float*)d_out; a.ws = (unsigned char*)d_ws;
    if (MK_N_LAUNCHES == 1) { a.ph_lo = 0; a.ph_hi = NPH; hipLaunchKernelGGL(fwd, dim3(grid), dim3(NTHR), LDS_BYTES, stream, a); }
    else for (int li = 0; li < NPH; ++li) { a.ph_lo = li; a.ph_hi = li + 1; hipLaunchKernelGGL(fwd, dim3(grid), dim3(NTHR), LDS_BYTES, stream, a); }
}
```

```cpp
#include <hip/hip_runtime.h>
#include <cstdio>
#include <cstdint>
#define MK_N_LAUNCHES 1
namespace pg8 {
#define PG8_LAS __attribute__((address_space(3)))
typedef unsigned short bf16_t;
typedef short bf16x8 __attribute__((ext_vector_type(8)));
typedef float f32x4 __attribute__((ext_vector_type(4)));
typedef unsigned u32x4 __attribute__((ext_vector_type(4)));
constexpr int BM = 256, BK = 64, HALF = 128, HTB = HALF * BK * 2  , STAGE_BYTES = 8 * HTB, NXCD = 8, WGM = 8;

__host__ __device__ __forceinline__ int lds_byte(int r, int c) { const int st = (r >> 4) * 2 + (c >> 5), rr = r & 15, cc = c & 31, ob = rr * 64 + cc * 2; return st * 1024 + (ob ^ (((ob >> 9) & 1) << 5)); }
__host__ __device__ __forceinline__ void stage_rc(int b, int& R, int& C) { const int st = b / 1024, sb = b % 1024, swz = sb ^ (((sb >> 9) & 1) << 5); R = (st >> 1) * 16 + swz / 64; C = (st & 1) * 32 + (swz % 64) / 2; }
__host__ __device__ __forceinline__ int perm32(int rho) { const int n = rho >> 4, i = rho & 15; return 8 * (i >> 2) + 4 * n + (i & 3); }

struct Unit { int pm, pn; };
struct Gemm { const bf16_t* A; const bf16_t* Bt; int M, N, K; };

struct StaticOrder {
    int nM, nN, nwg, G, c;
    __host__ __device__ void init(int M, int N, int G_, int c_) { nM = M / BM; nN = N / BM; nwg = nM * nN; G = G_; c = c_; }
    __host__ __device__ bool next(int i, Unit& u) const {
        const long L = (long)i * G + c; if (L >= nwg) return false;
        int wgid = (int)L; { const int q = nwg / NXCD, r = nwg % NXCD, xcd = wgid % NXCD, off = wgid / NXCD; wgid = (xcd < r ? xcd * (q + 1) : r * (q + 1) + (xcd - r) * q) + off; }
        const int nig = WGM * nN, gid = wgid / nig, fm = gid * WGM, gsz = (nM - fm) < WGM ? (nM - fm) : WGM;
        u.pm = fm + ((wgid % nig) % gsz); u.pn = (wgid % nig) / gsz; return true;
    }
    __device__ __forceinline__ void a_ready(const Unit&) const {}
    __device__ __forceinline__ void done(const Unit&) const {}
};

__device__ __forceinline__ unsigned cvt_pk_bf16(float lo, float hi) { unsigned r; asm volatile("v_cvt_pk_bf16_f32 %0, %1, %2" : "=v"(r) : "v"(lo), "v"(hi)); return r; }
typedef float f32x2 __attribute__((ext_vector_type(2)));
template <class Epi, class Sched, bool ALIGN_EPI = false, bool SP2 = false>
__device__ __forceinline__ void gemm_phase(PG8_LAS unsigned char* lds, const Gemm g, const Sched& S, const Epi& E) {
    const int tid = threadIdx.x, wid = __builtin_amdgcn_readfirstlane(tid >> 6), lane = tid & 63, wr = wid >> 2, wc = wid & 3, fr = lane & 15, fq = lane >> 4;
    const int K = g.K, nt = K / BK;
    unsigned voffA[2], voffB[2];
#pragma unroll
    for (int i = 0; i < 2; ++i) { int R, C; stage_rc(tid * 16 + i * 8192, R, C); const int Rb = Epi::PERM ? ((R & ~31) + perm32(R & 31)) : R;
        voffA[i] = (unsigned)(R * K + C) * 2u; voffB[i] = (unsigned)(Rb * K + C) * 2u; }
    const size_t kstep = (size_t)(BK * 2);
    const size_t hstep = (size_t)HALF * K * 2;
    const size_t tstep = 2 * hstep;
    const unsigned ldsw = (unsigned)wid * 1024u;
    const int aoff = lds_byte(wr * 64 + fr, fq * 8), boff = lds_byte(wc * 32 + fr, fq * 8);
#define PG8_SA(b, h) (((b) * 2 + (h)) * HTB)
#define PG8_SB(b, h) ((4 + (b) * 2 + (h)) * HTB)
#define PG8_STAGE(bufoff, gbase, voff) do { _Pragma("unroll") for (int _i = 0; _i < 2; ++_i) \
        __builtin_amdgcn_global_load_lds((const unsigned*)((const char*)(gbase) + (voff)[_i]), (PG8_LAS unsigned*)(lds + (bufoff) + ldsw + _i * 8192), 16, 0, 0); } while (0)
#define PG8_LDA(dst, b, h) do { _Pragma("unroll") for (int m = 0; m < 4; ++m) _Pragma("unroll") for (int k = 0; k < 2; ++k) dst[m][k] = *(const PG8_LAS bf16x8*)(lds + PG8_SA(b, h) + aoff + m * 2048 + k * 1024); } while (0)
#define PG8_LDB(dst, b, h) do { _Pragma("unroll") for (int n = 0; n < 2; ++n) _Pragma("unroll") for (int k = 0; k < 2; ++k) dst[n][k] = *(const PG8_LAS bf16x8*)(lds + PG8_SB(b, h) + boff + n * 2048 + k * 1024); } while (0)
#define PG8_MMA(ai, bj, At, Bt) do { __builtin_amdgcn_s_setprio(1); _Pragma("unroll") for (int m = 0; m < 4; ++m) _Pragma("unroll") for (int n = 0; n < 2; ++n) _Pragma("unroll") for (int k = 0; k < 2; ++k) \
        acc[ai][bj][m][n] = __builtin_amdgcn_mfma_f32_16x16x32_bf16(Bt[n][k], At[m][k], acc[ai][bj][m][n], 0, 0, 0); __builtin_amdgcn_s_setprio(0); } while (0)
#define PG8_WAIT_V(n) asm volatile("s_waitcnt vmcnt(" #n ")" ::: "memory")
#define PG8_WAIT_L(n) asm volatile("s_waitcnt lgkmcnt(" #n ")" ::: "memory")
#define PG8_BAR __builtin_amdgcn_s_barrier()
#define PG8_SCHED __builtin_amdgcn_sched_barrier(0)
    Unit cur, nxt; int ui = 0;
    if (!S.next(0, cur)) return;
    f32x4 acc[2][2][4][2];
#pragma unroll
    for (int a = 0; a < 2; ++a)
#pragma unroll
        for (int b = 0; b < 2; ++b)
#pragma unroll
            for (int m = 0; m < 4; ++m)
#pragma unroll
                for (int n = 0; n < 2; ++n) acc[a][b][m][n] = (f32x4){0.f, 0.f, 0.f, 0.f};
    bf16x8 At[4][2], B0[2][2], B1[2][2];
    const char* cA = (const char*)g.A + (size_t)cur.pm * tstep; const char* cB = (const char*)g.Bt + (size_t)cur.pn * tstep;
    S.a_ready(cur);
    if constexpr (SP2) {
        PG8_STAGE(PG8_SB(0, 0), cB, voffB); PG8_STAGE(PG8_SB(0, 1), cB + hstep, voffB); PG8_STAGE(PG8_SA(0, 0), cA, voffA); PG8_STAGE(PG8_SA(0, 1), cA + hstep, voffA);
        if (wr == 1) PG8_BAR;
        PG8_WAIT_V(2); PG8_BAR;
        PG8_STAGE(PG8_SB(1, 0), cB + kstep, voffB); PG8_STAGE(PG8_SA(1, 0), cA + kstep, voffA); PG8_STAGE(PG8_SB(1, 1), cB + hstep + kstep, voffB);
        PG8_WAIT_V(6); PG8_BAR;
    } else {
        PG8_STAGE(PG8_SB(0, 0), cB, voffB); PG8_STAGE(PG8_SA(0, 0), cA, voffA); PG8_STAGE(PG8_SB(0, 1), cB + hstep, voffB); PG8_STAGE(PG8_SA(0, 1), cA + hstep, voffA);
        if (wr == 1) PG8_BAR;
        PG8_WAIT_V(4); PG8_BAR;
        PG8_STAGE(PG8_SB(1, 0), cB + kstep, voffB); PG8_STAGE(PG8_SA(1, 0), cA + kstep, voffA); PG8_STAGE(PG8_SB(1, 1), cB + hstep + kstep, voffB);
        PG8_WAIT_V(6); PG8_BAR;
    }
    for (;;) {
        const bool has_next = S.next(ui + 1, nxt);
        const char* nA = has_next ? (const char*)g.A + (size_t)nxt.pm * tstep : cA; const char* nB = has_next ? (const char*)g.Bt + (size_t)nxt.pn * tstep : cB;
        for (int t = 0; t < nt; t += 2) {
            const bool last = (t == nt - 2);
            const char* a1 = cA + (size_t)(t + 1) * kstep;
            const char* a2 = last ? nA : cA + (size_t)(t + 2) * kstep; const char* b2 = last ? nB : cB + (size_t)(t + 2) * kstep;
            const char* a3 = a2 + kstep; const char* b3 = b2 + kstep;
            if (last && has_next) S.a_ready(nxt);
            if constexpr (SP2) {
            PG8_LDB(B0, 0, 0); PG8_LDB(B1, 0, 1); PG8_SCHED; PG8_LDA(At, 0, 0); PG8_STAGE(PG8_SA(1, 1), a1 + hstep, voffA);
            PG8_WAIT_V(8); PG8_WAIT_L(0); PG8_BAR; PG8_MMA(0, 0, At, B0); PG8_MMA(0, 1, At, B1); PG8_BAR; PG8_SCHED;
            PG8_LDA(At, 0, 1); PG8_STAGE(PG8_SB(0, 0), b2, voffB); PG8_STAGE(PG8_SB(0, 1), b2 + hstep, voffB); PG8_STAGE(PG8_SA(0, 0), a2, voffA);
            PG8_WAIT_V(8); PG8_WAIT_L(0); PG8_BAR; PG8_MMA(1, 0, At, B0); PG8_MMA(1, 1, At, B1); PG8_BAR; PG8_SCHED;
            PG8_LDB(B0, 1, 0); PG8_LDB(B1, 1, 1); PG8_SCHED; PG8_LDA(At, 1, 0); PG8_STAGE(PG8_SA(0, 1), a2 + hstep, voffA);
            PG8_WAIT_V(8); PG8_WAIT_L(0); PG8_BAR; PG8_MMA(0, 0, At, B0); PG8_MMA(0, 1, At, B1); PG8_BAR; PG8_SCHED;
            PG8_LDA(At, 1, 1); PG8_STAGE(PG8_SB(1, 0), b3, voffB); PG8_STAGE(PG8_SB(1, 1), b3 + hstep, voffB); PG8_STAGE(PG8_SA(1, 0), a3, voffA);
            PG8_WAIT_V(8); PG8_WAIT_L(0); PG8_BAR; PG8_MMA(1, 0, At, B0); PG8_MMA(1, 1, At, B1); PG8_BAR; PG8_SCHED;
            } else {
            PG8_LDB(B0, 0, 0); PG8_SCHED; PG8_LDA(At, 0, 0); PG8_STAGE(PG8_SA(1, 1), a1 + hstep, voffA);
            PG8_WAIT_L(8); PG8_BAR; PG8_WAIT_L(0); PG8_MMA(0, 0, At, B0); PG8_BAR; PG8_SCHED;
            PG8_LDB(B1, 0, 1); PG8_STAGE(PG8_SB(0, 0), b2, voffB);
            PG8_BAR; PG8_WAIT_L(0); PG8_MMA(0, 1, At, B1); PG8_BAR;
            PG8_LDA(At, 0, 1); PG8_STAGE(PG8_SA(0, 0), a2, voffA);
            PG8_BAR; PG8_WAIT_L(0); PG8_MMA(1, 0, At, B0); PG8_BAR; PG8_SCHED;
            PG8_STAGE(PG8_SB(0, 1), b2 + hstep, voffB);
            PG8_WAIT_V(6); PG8_BAR; PG8_MMA(1, 1, At, B1); PG8_BAR;
            PG8_LDB(B0, 1, 0); PG8_SCHED; PG8_LDA(At, 1, 0); PG8_STAGE(PG8_SA(0, 1), a2 + hstep, voffA);
            PG8_WAIT_L(8); PG8_BAR; PG8_WAIT_L(0); PG8_MMA(0, 0, At, B0); PG8_BAR; PG8_SCHED;
            PG8_LDB(B1, 1, 1); PG8_STAGE(PG8_SB(1, 0), b3, voffB);
            PG8_BAR; PG8_WAIT_L(0); PG8_MMA(0, 1, At, B1); PG8_BAR;
            PG8_LDA(At, 1, 1); PG8_STAGE(PG8_SA(1, 0), a3, voffA);
            PG8_BAR; PG8_WAIT_L(0); PG8_MMA(1, 0, At, B0); PG8_BAR; PG8_SCHED;
            PG8_STAGE(PG8_SB(1, 1), b3 + hstep, voffB);
            PG8_WAIT_V(6); PG8_BAR; PG8_MMA(1, 1, At, B1); PG8_BAR;
            }
        }
        if constexpr (ALIGN_EPI) { if (wr == 0) PG8_BAR; }
        if constexpr (!Epi::AFTER_DRAIN) { E(acc, cur, wr, wc, fr, fq); S.done(cur); }
        if (!has_next) break;
#pragma unroll
        for (int a = 0; a < 2; ++a)
#pragma unroll
            for (int b = 0; b < 2; ++b)
#pragma unroll
                for (int m = 0; m < 4; ++m)
#pragma unroll
                    for (int n = 0; n < 2; ++n) acc[a][b][m][n] = (f32x4){0.f, 0.f, 0.f, 0.f};
        cur = nxt; cA = nA; cB = nB; ++ui;
        if constexpr (ALIGN_EPI) { if (wr == 1) PG8_BAR; }
    }
    PG8_WAIT_V(0);
    if constexpr (!ALIGN_EPI) { if (wr == 0) PG8_BAR; }
    PG8_BAR;
    if constexpr (Epi::AFTER_DRAIN) { E.fused(acc, cur, wr, wc, fr, fq, lds, wid, lane); S.done(cur); }
#undef PG8_SA
#undef PG8_SB
#undef PG8_STAGE
#undef PG8_LDA
#undef PG8_LDB
#undef PG8_MMA
#undef PG8_WAIT_V
#undef PG8_WAIT_L
#undef PG8_BAR
#undef PG8_SCHED
}
}
constexpr int DM = 1024, NCTX = 4096, NLAT = 8192, MROWS = 12288;
constexpr int CSEQ = 256, LSEQ = 1024, PAST = 512, LKEYS = 1536;
constexpr int INC = 4096, FF = 2816, FF2 = 5632, AW = 512;
constexpr float ALPHA = 1.189207115002721f, LN_EPS = 1e-5f;
constexpr float QSCALE = 0.125f * 1.4426950408889634f;
constexpr int NWAVES = 8, NTHR = 512;
constexpr int LDS_BYTES = 147456;
constexpr int RING_BYTES = 131072, MISC_OFF = RING_BYTES + 320;

constexpr size_t MiB = 1u << 20;
constexpr size_t WS_CTL = 0, CTL_ZERO_BYTES = 65536;
constexpr size_t WS_MOD = 1 * MiB;
constexpr size_t WS_ROPE = 1 * MiB + 512 * 1024;
constexpr size_t WS_WIN = 2 * MiB, WS_WOUT = 10 * MiB, WS_WUP = 12 * MiB, WS_WDN = 23 * MiB;
constexpr size_t WS_XM = 29 * MiB;
constexpr size_t WS_Q = 53 * MiB, WS_KC = 65 * MiB, WS_VC = 69 * MiB, WS_KL = 73 * MiB, WS_VL = 85 * MiB;
constexpr size_t WS_RQ = 97 * MiB, WS_RI = 109 * MiB, WS_RG = 121 * MiB, WS_GF = 133 * MiB, WS_GB = 157 * MiB, WS_OF = 181 * MiB, WS_MIX = 205 * MiB;
constexpr size_t WS_H = 53 * MiB;
constexpr size_t WS_G = 185 * MiB;
constexpr size_t WS_END = 251 * MiB;
constexpr size_t OUT_Y = 0, OUT_K = 12582912, OUT_V = OUT_K + 2097152, OUT_S = OUT_V + 2097152;
constexpr int CW_BAR = 4096;

#define GAS __attribute__((address_space(1)))
#define LAS __attribute__((address_space(3)))
typedef unsigned short bf16;
typedef unsigned v4u __attribute__((ext_vector_type(4)));
typedef unsigned v2u __attribute__((ext_vector_type(2)));
typedef float f32x4 __attribute__((ext_vector_type(4)));
typedef short bf16x8 __attribute__((ext_vector_type(8)));
typedef GAS unsigned gu32;
#define RLX_AGENT __ATOMIC_RELAXED, __HIP_MEMORY_SCOPE_AGENT
#define LDS_WAIT() asm volatile("s_waitcnt lgkmcnt(0)" ::: "memory")
#define VM_WAIT() asm volatile("s_waitcnt vmcnt(0)" ::: "memory")
__device__ __forceinline__ unsigned f2bf(float f) { unsigned u = __builtin_bit_cast(unsigned, f); return (u + 0x7fffu + ((u >> 16) & 1u)) >> 16; }
__device__ __forceinline__ unsigned pk2(float lo, float hi) { return f2bf(lo) | (f2bf(hi) << 16); }
__device__ __forceinline__ float bflo(unsigned w) { return __uint_as_float(w << 16); }
__device__ __forceinline__ float bfhi(unsigned w) { return __uint_as_float(w & 0xffff0000u); }
__device__ __forceinline__ float wave_sum(float v) {
#pragma unroll
    for (int o = 1; o < 64; o <<= 1) v += __shfl_xor(v, o);
    return v;
}
__device__ __forceinline__ float wave_max(float v) {
#pragma unroll
    for (int o = 1; o < 64; o <<= 1) v = fmaxf(v, __shfl_xor(v, o));
    return v;
}
__device__ __forceinline__ float sigmoidf_(float z) { return 1.0f / (1.0f + __expf(-z)); }
__device__ __forceinline__ float siluf_(float z) { return z / (1.0f + __expf(-z)); }

struct Args { const float* in[27]; float* out; unsigned char* ws; int ph_lo, ph_hi; };
#define XB_TMO      128
#define XB_XCNT(j)  (256  + 64 * (j))
#define XB_XSUB(j)  (1280 + 64 * (j))
#define XB_XGEN(j)  (2304 + 64 * (j))
#define XB_TOP      3328
#define XB_TOPGEN   3392
#define XCD_BAR_WORDS 3456
#define XB_SPIN_CAP (1u << 18)

__device__ __forceinline__ unsigned xb_ld(unsigned* p)              { return __hip_atomic_load(p, __ATOMIC_RELAXED, __HIP_MEMORY_SCOPE_AGENT); }
__device__ __forceinline__ unsigned xb_add(unsigned* p, unsigned v) { return __hip_atomic_fetch_add(p, v, __ATOMIC_RELAXED, __HIP_MEMORY_SCOPE_AGENT); }
__device__ __forceinline__ unsigned xb_xcc_id() { return (unsigned)__builtin_amdgcn_s_getreg((3 << 11) | 20) & 0xFu; }
#define XB_SPIN(cond, bar) do { unsigned _sp = 0; while (cond) { __builtin_amdgcn_s_sleep(1); \
    if ((++_sp & 255u) == 0u) { if (xb_ld(&(bar)[XB_TMO])) break; if (_sp > XB_SPIN_CAP) { atomicAdd(&(bar)[XB_TMO], 1u); break; } } } } while (0)

struct XcdBarrier {
    unsigned* bar; unsigned x;
    volatile LAS unsigned* st;
};

__device__ __forceinline__ XcdBarrier xcd_barrier_post(unsigned* bar, volatile LAS unsigned* st) {
    XcdBarrier b; b.bar = bar; b.x = xb_xcc_id(); b.st = st;
    if (threadIdx.x == 0) (void)xb_add(&bar[XB_XCNT(b.x)], 1u);
    return b;
}
__device__ __forceinline__ void xcd_barrier_complete(unsigned* bar, unsigned x, unsigned& nloc, unsigned& nx) {
    const unsigned G = gridDim.x * gridDim.y * gridDim.z;
    unsigned sum, cnt, mine, sp = 0u;
    for (;;) {
        sum = 0u; cnt = 0u; mine = 0u;
#pragma unroll
        for (unsigned j = 0; j < 16; ++j) { const unsigned c = xb_ld(&bar[XB_XCNT(j)]); sum += c; cnt += (c > 0u) ? 1u : 0u; mine = (j == x) ? c : mine; }
        if (sum == G) break;
        __builtin_amdgcn_s_sleep(1);
        if ((++sp & 255u) == 0u) { if (xb_ld(&bar[XB_TMO])) break; if (sp > XB_SPIN_CAP) { atomicAdd(&bar[XB_TMO], 1u); break; } }
    }
    nloc = mine > 0u ? mine : 1u; nx = cnt > 0u ? cnt : 1u;
}

__device__ __forceinline__ void xcd_barrier(const XcdBarrier& b) {
    asm volatile("s_waitcnt vmcnt(0)" ::: "memory");
    __syncthreads();
    if (threadIdx.x == 0) {
        unsigned* bar = b.bar;
        __builtin_amdgcn_s_waitcnt(0);
        unsigned nloc = b.st[0], nx = b.st[1];
        if (nloc == 0u) { xcd_barrier_complete(bar, b.x, nloc, nx); b.st[0] = nloc; b.st[1] = nx; }
        const unsigned old = xb_add(&bar[XB_XSUB(b.x)], 1u);
        const unsigned gen = old / nloc;
        if (old + 1u == (gen + 1u) * nloc) {
            __builtin_amdgcn_fence(__ATOMIC_RELEASE, "agent");
            asm volatile("s_waitcnt vmcnt(0)" ::: "memory");
            const unsigned og = xb_add(&bar[XB_TOP], 1u);
            const unsigned tg = og / nx;
            if (og + 1u == (tg + 1u) * nx) xb_add(&bar[XB_TOPGEN], 1u);
            else XB_SPIN(xb_ld(&bar[XB_TOPGEN]) == tg, bar);
            __builtin_amdgcn_fence(__ATOMIC_ACQUIRE, "agent");
            xb_add(&bar[XB_XGEN(b.x)], 1u);
            asm volatile("s_waitcnt vmcnt(0)" ::: "memory");
        } else {
            XB_SPIN(xb_ld(&bar[XB_XGEN(b.x)]) == gen, bar);
            __builtin_amdgcn_fence(__ATOMIC_ACQUIRE, "agent");
            asm volatile("s_waitcnt vmcnt(0)" ::: "memory");
        }
    }
    __syncthreads();
}

__device__ __forceinline__ int mod_index(int row) { return row < NCTX ? 0 : 1 + ((row - NCTX) >> 10); }
__device__ __forceinline__ const float* xrow_ptr(const float* xp, const float* xs, int row) { return row < NCTX ? xp + (size_t)row * DM : xs + (size_t)(row - NCTX) * DM; }
__device__ __forceinline__ v2u pk4(f32x4 v) { v2u w; w.x = pk2(v[0], v[1]); w.y = pk2(v[2], v[3]); return w; }

struct Epi1 {
    static constexpr bool PERM = false, AFTER_DRAIN = false;
    bf16 *Q, *KC, *VC, *KL, *VL, *RQ, *RI, *RG; float *GF, *GB; float *outK, *outV; const float* rope; const float *lbf, *lbb;
    __device__ __forceinline__ void operator()(const f32x4 (&acc)[2][2][4][2], const pg8::Unit& u, int wr, int wc, int fr, int fq) const {
        const int grp = u.pn >> 1, cbase = (u.pn & 1) * 256; const bool ctx = u.pm < 16;
        if (grp <= 1) {
            const int half = wc & 1;
#pragma unroll
            for (int ai = 0; ai < 2; ++ai)
#pragma unroll
                for (int m = 0; m < 4; ++m) {
                    const int row = u.pm * 256 + ai * 128 + wr * 64 + m * 16 + fr;
                    f32x4 cs0 = (f32x4){1.f, 0.f, 1.f, 0.f}, cs1 = cs0;
                    if (!ctx) { const int t = (row - NCTX) & 1023; const int pos = half ? (t & 63) : (t >> 6);
                        const float* tp = rope + (size_t)pos * 32 + 8 * fq; cs0 = *(const f32x4*)tp; cs1 = *(const f32x4*)(tp + 4); }
#pragma unroll
                    for (int bj = 0; bj < 2; ++bj) {
                        const f32x4 x1 = acc[ai][bj][m][0], x2 = acc[ai][bj][m][1]; f32x4 o1, o2;
                        o1[0] = x1[0] * cs0[0] - x2[0] * cs0[1]; o2[0] = x1[0] * cs0[1] + x2[0] * cs0[0];
                        o1[1] = x1[1] * cs0[2] - x2[1] * cs0[3]; o2[1] = x1[1] * cs0[3] + x2[1] * cs0[2];
                        o1[2] = x1[2] * cs1[0] - x2[2] * cs1[1]; o2[2] = x1[2] * cs1[1] + x2[2] * cs1[0];
                        o1[3] = x1[3] * cs1[2] - x2[3] * cs1[3]; o2[3] = x1[3] * cs1[3] + x2[3] * cs1[2];
                        const int cg = cbase + bj * 128 + wc * 32 + 4 * fq;
                        if (grp == 0) { *(v2u*)(Q + (size_t)row * AW + cg) = pk4(o1 * QSCALE); *(v2u*)(Q + (size_t)row * AW + cg + 16) = pk4(o2 * QSCALE); }
                        else if (ctx) { *(f32x4*)(outK + (size_t)row * AW + cg) = x1; *(f32x4*)(outK + (size_t)row * AW + cg + 16) = x2;
                                        *(v2u*)(KC + (size_t)row * AW + cg) = pk4(x1); *(v2u*)(KC + (size_t)row * AW + cg + 16) = pk4(x2); }
                        else { const int b = (row - NCTX) >> 10, t = (row - NCTX) & 1023; bf16* kp = KL + ((size_t)b * LKEYS + PAST + t) * AW + cg;
                               *(v2u*)kp = pk4(o1); *(v2u*)(kp + 16) = pk4(o2); }
                    }
                }
            return;
        }
        f32x4 lb[2][2];
        if (grp == 4 || grp == 5) { const float* lg = grp == 4 ? lbf : lbb;
#pragma unroll
            for (int bj = 0; bj < 2; ++bj)
#pragma unroll
                for (int n = 0; n < 2; ++n) { const int cg = cbase + bj * 128 + wc * 32 + n * 16 + 4 * fq; const f32x4 l0 = *(const f32x4*)(lg + cg), l1 = *(const f32x4*)(lg + AW + cg);
#pragma unroll
                    for (int i = 0; i < 4; ++i) lb[bj][n][i] = sigmoidf_(l0[i] - l1[i]); } }
#pragma unroll
        for (int ai = 0; ai < 2; ++ai)
#pragma unroll
            for (int m = 0; m < 4; ++m) {
                const int row = u.pm * 256 + ai * 128 + wr * 64 + m * 16 + fr;
#pragma unroll
                for (int bj = 0; bj < 2; ++bj)
#pragma unroll
                    for (int n = 0; n < 2; ++n) {
                        const int cg = cbase + bj * 128 + wc * 32 + n * 16 + 4 * fq; const f32x4 v = acc[ai][bj][m][n]; const size_t o = (size_t)row * AW + cg;
                        if (grp == 2) { if (ctx) { *(f32x4*)(outV + o) = v; *(v2u*)(VC + o) = pk4(v); }
                                        else { const int b = (row - NCTX) >> 10, t = (row - NCTX) & 1023; *(v2u*)(VL + ((size_t)b * LKEYS + PAST + t) * AW + cg) = pk4(v); } }
                        else if (grp == 3) *(v2u*)(RQ + o) = pk4(v);
                        else if (grp == 4 || grp == 5) { f32x4 w;
#pragma unroll
                            for (int i = 0; i < 4; ++i) { const float l = lb[bj][n][i]; w[i] = __logf(l + (1.0f - l) * sigmoidf_(v[i])); }
                            *(f32x4*)((grp == 4 ? GF : GB) + o) = w; }
                        else if (grp == 6) *(v2u*)(RI + o) = pk4(v);
                        else { f32x4 w;
#pragma unroll
                            for (int i = 0; i < 4; ++i) w[i] = siluf_(v[i]);
                            *(v2u*)(RG + o) = pk4(w); }
                    }
            }
    }
};
struct EpiRes {
    static constexpr bool PERM = false, AFTER_DRAIN = false;
    const float *xp, *xs; const float* ybase; float* out; const float* gate;
    __device__ __forceinline__ void operator()(const f32x4 (&acc)[2][2][4][2], const pg8::Unit& u, int wr, int wc, int fr, int fq) const {
        const int mi = u.pm < 16 ? 0 : 1 + ((u.pm - 16) >> 2); const float* gp = gate + (size_t)mi * 6144;
        f32x4 gv[2][2];
#pragma unroll
        for (int bj = 0; bj < 2; ++bj)
#pragma unroll
            for (int n = 0; n < 2; ++n) gv[bj][n] = *(const f32x4*)(gp + u.pn * 256 + bj * 128 + wc * 32 + n * 16 + 4 * fq);
#pragma unroll
        for (int ai = 0; ai < 2; ++ai)
#pragma unroll
            for (int m = 0; m < 4; ++m) {
                const int row = u.pm * 256 + ai * 128 + wr * 64 + m * 16 + fr;
                const float* bp = ybase ? ybase + (size_t)row * DM : xrow_ptr(xp, xs, row);
#pragma unroll
                for (int bj = 0; bj < 2; ++bj)
#pragma unroll
                    for (int n = 0; n < 2; ++n) { const int col = u.pn * 256 + bj * 128 + wc * 32 + n * 16 + 4 * fq;
                        const f32x4 b = *(const f32x4*)(bp + col); *(f32x4*)(out + (size_t)row * DM + col) = b * ALPHA + gv[bj][n] * acc[ai][bj][m][n]; }
            }
    }
};
struct EpiH {
    static constexpr bool PERM = false, AFTER_DRAIN = false;
    bf16* H;
    __device__ __forceinline__ void operator()(const f32x4 (&acc)[2][2][4][2], const pg8::Unit& u, int wr, int wc, int fr, int fq) const {
#pragma unroll
        for (int ai = 0; ai < 2; ++ai)
#pragma unroll
            for (int m = 0; m < 4; ++m) {
                const int row = u.pm * 256 + ai * 128 + wr * 64 + m * 16 + fr;
#pragma unroll
                for (int bj = 0; bj < 2; ++bj)
#pragma unroll
                    for (int n = 0; n < 2; ++n) { const int col = u.pn * 256 + bj * 128 + wc * 32 + n * 16 + 4 * fq; *(v2u*)(H + (size_t)row * FF2 + col) = pk4(acc[ai][bj][m][n]); }
            }
    }
};
__device__ __forceinline__ void p0_transpose_item(const float* W, int K, int N, bf16* WT, int k0, int n0, int orow0, LAS float* scr, int lane) {
#pragma unroll 8
    for (int i = 0; i < 32; ++i) { const int kk = 2 * i + (lane >> 5); scr[kk * 33 + (lane & 31)] = W[(size_t)(k0 + kk) * N + n0 + (lane & 31)]; }
    LDS_WAIT(); asm volatile("" ::: "memory");
    const int c = lane & 7;
#pragma unroll
    for (int j = 0; j < 4; ++j) { const int n = (lane >> 3) + 8 * j; const LAS float* s = scr + (8 * c) * 33 + n;
        v4u o; o.x = pk2(s[0 * 33], s[1 * 33]); o.y = pk2(s[2 * 33], s[3 * 33]); o.z = pk2(s[4 * 33], s[5 * 33]); o.w = pk2(s[6 * 33], s[7 * 33]);
        *(GAS v4u*)(WT + (size_t)(orow0 + n) * K + k0 + 8 * c) = o; }
    LDS_WAIT(); asm volatile("" ::: "memory");
}
__device__ __forceinline__ void p0_prologue(const Args& a, LAS unsigned char* lds, int vcu, int G, int tid, int lane, int wave) {
    unsigned char* ws = a.ws;
    {
        LAS float* cl = (LAS float*)lds;
        LAS float* red = (LAS float*)(lds + 40960);
        float* mod = (float*)(ws + WS_MOD);
        const float* wada = a.in[7]; const float* bada = a.in[8];
        bool filled = false;
        for (int cb = vcu; cb < 192; cb += G) {
            if (!filled) {
                for (int i = tid; i < 9 * 1024; i += NTHR) { const int m = i >> 10, k = i & 1023; const float v = (m == 0) ? a.in[6][k] : a.in[5][(m - 1) * 1024 + k]; cl[i] = siluf_(v); }
                filled = true; __syncthreads();
            }
            const int n0 = cb * 32, kr = lane >> 3, c4 = lane & 7;
            f32x4 acc[9];
#pragma unroll
            for (int m = 0; m < 9; ++m) acc[m] = (f32x4){0.f, 0.f, 0.f, 0.f};
            for (int it = 0; it < 16; ++it) { const int k = wave * 128 + it * 8 + kr; const f32x4 wv = *(const f32x4*)(wada + (size_t)k * 6144 + n0 + 4 * c4);
#pragma unroll
                for (int m = 0; m < 9; ++m) acc[m] += wv * cl[m * 1024 + k]; }
#pragma unroll
            for (int m = 0; m < 9; ++m)
#pragma unroll
                for (int i = 0; i < 4; ++i) { float v = acc[m][i]; v += __shfl_xor(v, 8); v += __shfl_xor(v, 16); v += __shfl_xor(v, 32); acc[m][i] = v; }
            if (kr == 0) {
#pragma unroll
                for (int m = 0; m < 9; ++m) *(LAS f32x4*)(red + (wave * 9 + m) * 32 + 4 * c4) = acc[m]; }
            __syncthreads();
            if (tid < 288) { const int m = tid >> 5, cc = tid & 31; float s = bada[n0 + cc];
#pragma unroll
                for (int w = 0; w < 8; ++w) s += red[(w * 9 + m) * 32 + cc];
                mod[(size_t)m * 6144 + n0 + cc] = s; }
            __syncthreads();
        }
        __syncthreads();
    }
    if (vcu == (G > 200 ? 200 : 0)) {
        float* rope = (float*)(ws + WS_ROPE);
        for (int i = tid; i < 1024; i += NTHR) { const int pos = i >> 4, j = i & 15;
            const float freq = 1.0f / powf(10000.0f, (float)j * (1.0f / 16.0f)); const float angf = (float)pos * freq; const double ang = (double)angf;
            const double nq = __builtin_rint(ang * 0.63661977236758134308); const double r = __builtin_fma(-nq, 1.5707963267948966192, ang) - nq * 6.123233995736766e-17; const double r2 = r * r;
            double sn = r * (1.0 + r2 * (-1.0 / 6 + r2 * (1.0 / 120 + r2 * (-1.0 / 5040 + r2 * (1.0 / 362880 + r2 * (-1.0 / 39916800 + r2 * (1.0 / 6227020800.0)))))));
            double cn = 1.0 + r2 * (-0.5 + r2 * (1.0 / 24 + r2 * (-1.0 / 720 + r2 * (1.0 / 40320 + r2 * (-1.0 / 3628800 + r2 * (1.0 / 479001600 + r2 * (-1.0 / 87178291200.0)))))));
            const int q = ((int)nq) & 3; double cc, ss;
            if (q == 0) { cc = cn; ss = sn; } else if (q == 1) { cc = -sn; ss = cn; } else if (q == 2) { cc = -cn; ss = -sn; } else { cc = sn; ss = -cn; }
            rope[2 * i] = (float)cc; rope[2 * i + 1] = (float)ss; }
    }
    {
        bf16* KL = (bf16*)(ws + WS_KL); bf16* VL = (bf16*)(ws + WS_VL);
        const int gt = vcu * NTHR + tid, NGT = G * NTHR;
        for (int i = gt; i < 2 * 524288; i += NGT) { const int which = i >= 524288, e4 = which ? i - 524288 : i;
            const int rowi = e4 >> 7, c4 = e4 & 127, b = rowi >> 9, j = rowi & 511;
            const f32x4 v = *(const f32x4*)((which ? a.in[3] : a.in[2]) + (size_t)e4 * 4);
            *(v2u*)((which ? VL : KL) + ((size_t)b * LKEYS + j) * AW + 4 * c4) = pk4(v); }
    }
    {
        LAS float* scr = (LAS float*)(lds + wave * 16384);
        const int gw = vcu * NWAVES + wave, NGW = G * NWAVES;
        constexpr int I_IN = 16 * 128, I_OUT = 16 * 32, I_UP = 16 * 176, I_DN = 44 * 32, NITEMS = I_IN + I_OUT + I_UP + I_DN;
        for (int it = gw; it < NITEMS; it += NGW) {
            int r = it;
            if (r < I_IN) { const int kb = r / 128, nb = r % 128; p0_transpose_item(a.in[9], DM, INC, (bf16*)(ws + WS_WIN), 64 * kb, 32 * nb, 32 * nb, scr, lane); continue; } r -= I_IN;
            if (r < I_OUT) { const int kb = r / 32, nb = r % 32; p0_transpose_item(a.in[18], DM, DM, (bf16*)(ws + WS_WOUT), 64 * kb, 32 * nb, 32 * nb, scr, lane); continue; } r -= I_OUT;
            if (r < I_UP) { const int kb = r / 176, nb = r % 176, n0 = 32 * nb; const int n1 = n0 < FF ? n0 : n0 - FF; const int orow = 256 * (n1 >> 7) + (n0 < FF ? 0 : 128) + (n1 & 127);
                p0_transpose_item(a.in[21], DM, FF2, (bf16*)(ws + WS_WUP), 64 * kb, n0, orow, scr, lane); continue; } r -= I_UP;
            { const int kb = r / 32, nb = r % 32; p0_transpose_item(a.in[24], FF, DM, (bf16*)(ws + WS_WDN), 64 * kb, 32 * nb, 32 * nb, scr, lane); }
        }
    }
}
__device__ __forceinline__ void p1_modulate(const Args& a, int vcu, int G, int lane, int wave) {
    const float* mod = (const float*)(a.ws + WS_MOD); bf16* XM = (bf16*)(a.ws + WS_XM);
    const int gw = vcu * NWAVES + wave, NGW = G * NWAVES;
    for (int row = gw; row < MROWS; row += NGW) {
        const float* xr = xrow_ptr(a.in[0], a.in[1], row); const float* mp = mod + (size_t)mod_index(row) * 6144;
#pragma unroll
        for (int j = 0; j < 4; ++j) { const int c = 4 * (lane + 64 * j); const f32x4 x = *(const f32x4*)(xr + c), sh = *(const f32x4*)(mp + c), sc = *(const f32x4*)(mp + 1024 + c);
            *(v2u*)(XM + (size_t)row * DM + c) = pk4(x * (sc + 1.0f) + sh); }
    }
}
__device__ __forceinline__ void ln_rows(const Args& a, const float* g, const float* bta, bool write_xm, int vcu, int G, int lane, int wave) {
    float* Y = a.out + OUT_Y; const float* mod = (const float*)(a.ws + WS_MOD); bf16* XM = (bf16*)(a.ws + WS_XM);
    const int gw = vcu * NWAVES + wave, NGW = G * NWAVES;
    for (int row = gw; row < MROWS; row += NGW) {
        float* yr = Y + (size_t)row * DM; f32x4 v[4]; float s = 0.f;
#pragma unroll
        for (int j = 0; j < 4; ++j) { v[j] = *(const f32x4*)(yr + 4 * (lane + 64 * j)); s += (v[j][0] + v[j][1]) + (v[j][2] + v[j][3]); }
        const float mean = wave_sum(s) * (1.0f / DM); float s2 = 0.f;
#pragma unroll
        for (int j = 0; j < 4; ++j) { v[j] = v[j] - mean; s2 += (v[j][0] * v[j][0] + v[j][1] * v[j][1]) + (v[j][2] * v[j][2] + v[j][3] * v[j][3]); }
        const float rstd = 1.0f / sqrtf(wave_sum(s2) * (1.0f / DM) + LN_EPS);
        const float* mp = mod + (size_t)mod_index(row) * 6144;
#pragma unroll
        for (int j = 0; j < 4; ++j) { const int c = 4 * (lane + 64 * j); const f32x4 x1 = v[j] * rstd * *(const f32x4*)(g + c) + *(const f32x4*)(bta + c);
            *(f32x4*)(yr + c) = x1;
            if (write_xm) { const f32x4 sh = *(const f32x4*)(mp + 3072 + c), sc = *(const f32x4*)(mp + 4096 + c); *(v2u*)(XM + (size_t)row * DM + c) = pk4(x1 * (sc + 1.0f) + sh); } }
    }
}
__device__ __forceinline__ void conv_gate(const Args& a, int vcu, int G, int tid) {
    const bf16* H = (const bf16*)(a.ws + WS_H); bf16* Gt = (bf16*)(a.ws + WS_G); const float* cw = a.in[22]; const float* cb = a.in[23];
    const int gt = vcu * NTHR + tid, NGT = G * NTHR; constexpr int PER_ROW = 22 * 32;
    for (int i = gt; i < MROWS * PER_ROW; i += NGT) {
        const int row = i / PER_ROW, r2 = i % PER_ROW, pn = r2 >> 5, jj = (r2 & 31) * 4;
        const int t = row < NCTX ? (row & 255) : ((row - NCTX) & 1023), L = row < NCTX ? CSEQ : LSEQ;
        const bool hp = t > 0, hn = t < L - 1;
        const int ca = 128 * pn + jj, cu = FF + ca;
        const bf16* hp0 = H + (size_t)row * FF2 + 256 * pn + jj;
        const v2u z = (v2u){0u, 0u};
        const v2u a0 = hp ? *(const v2u*)(hp0 - FF2) : z, a1 = *(const v2u*)hp0, a2 = hn ? *(const v2u*)(hp0 + FF2) : z;
        const v2u u0 = hp ? *(const v2u*)(hp0 - FF2 + 128) : z, u1 = *(const v2u*)(hp0 + 128), u2 = hn ? *(const v2u*)(hp0 + FF2 + 128) : z;
        const f32x4 wa0 = *(const f32x4*)(cw + ca), wa1 = *(const f32x4*)(cw + FF2 + ca), wa2 = *(const f32x4*)(cw + 2 * FF2 + ca), ba = *(const f32x4*)(cb + ca);
        const f32x4 wu0 = *(const f32x4*)(cw + cu), wu1 = *(const f32x4*)(cw + FF2 + cu), wu2 = *(const f32x4*)(cw + 2 * FF2 + cu), bu = *(const f32x4*)(cb + cu);
        const f32x4 A0 = (f32x4){bflo(a0.x), bfhi(a0.x), bflo(a0.y), bfhi(a0.y)}, A1 = (f32x4){bflo(a1.x), bfhi(a1.x), bflo(a1.y), bfhi(a1.y)}, A2 = (f32x4){bflo(a2.x), bfhi(a2.x), bflo(a2.y), bfhi(a2.y)};
        const f32x4 U0 = (f32x4){bflo(u0.x), bfhi(u0.x), bflo(u0.y), bfhi(u0.y)}, U1 = (f32x4){bflo(u1.x), bfhi(u1.x), bflo(u1.y), bfhi(u1.y)}, U2 = (f32x4){bflo(u2.x), bfhi(u2.x), bflo(u2.y), bfhi(u2.y)};
        const f32x4 av = A0 * wa0 + A1 * wa1 + A2 * wa2 + ba, uv = U0 * wu0 + U1 * wu1 + U2 * wu2 + bu; f32x4 gv;
#pragma unroll
        for (int k = 0; k < 4; ++k) gv[k] = siluf_(av[k]) * uv[k];
        *(v2u*)(Gt + (size_t)row * FF + ca) = pk4(gv);
    }
}
__device__ __forceinline__ float calc_lam(const Args& a, int lane) {
    const float s1 = wave_sum(a.in[10][lane] * a.in[11][lane]), s2 = wave_sum(a.in[12][lane] * a.in[13][lane]);
    return expf(s1) - expf(s2) + 0.2f;
}
__device__ __forceinline__ void attn_naive(const Args& a, LAS unsigned char* lds, int vcu, int G, int lane, int wave) {
    unsigned char* ws = a.ws;
    const bf16* Q = (const bf16*)(ws + WS_Q); bf16* MIX = (bf16*)(ws + WS_MIX); const float* attg = a.in[16];
    LAS float* qf = (LAS float*)(lds + wave * 12800);
    LAS float* sc = qf + 128;
    const float lam = calc_lam(a, lane);
    for (int it = vcu; it < 6144; it += G) {
        const int h = it & 3, row = (it >> 2) * 8 + wave; const bool ctx = row < NCTX;
        const int nk = ctx ? CSEQ : LKEYS;
        const bf16 *Kp, *Vp;
        if (ctx) { const int b = row >> 8; Kp = (const bf16*)(ws + WS_KC) + (size_t)b * CSEQ * AW + h * 128; Vp = (const bf16*)(ws + WS_VC) + (size_t)b * CSEQ * AW + h * 128; }
        else { const int b = (row - NCTX) >> 10; Kp = (const bf16*)(ws + WS_KL) + (size_t)b * LKEYS * AW + h * 128; Vp = (const bf16*)(ws + WS_VL) + (size_t)b * LKEYS * AW + h * 128; }
        { const unsigned w = *(const unsigned*)(Q + (size_t)row * AW + h * 128 + 2 * lane); qf[2 * lane] = bflo(w); qf[2 * lane + 1] = bfhi(w); }
        LDS_WAIT(); asm volatile("" ::: "memory");
        float m1 = -3.0e38f, m2 = -3.0e38f;
        for (int j = lane; j < nk; j += 64) {
            const bf16* kp = Kp + (size_t)j * AW; float s1 = 0.f, s2 = 0.f;
#pragma unroll
            for (int c = 0; c < 8; ++c) { const v4u k1 = *(const v4u*)(kp + 8 * c), k2 = *(const v4u*)(kp + 64 + 8 * c);
                const LAS float* q1 = qf + 8 * c; const LAS float* q2 = qf + 64 + 8 * c;
                s1 += bflo(k1.x) * q1[0] + bfhi(k1.x) * q1[1] + bflo(k1.y) * q1[2] + bfhi(k1.y) * q1[3] + bflo(k1.z) * q1[4] + bfhi(k1.z) * q1[5] + bflo(k1.w) * q1[6] + bfhi(k1.w) * q1[7];
                s2 += bflo(k2.x) * q2[0] + bfhi(k2.x) * q2[1] + bflo(k2.y) * q2[2] + bfhi(k2.y) * q2[3] + bflo(k2.z) * q2[4] + bfhi(k2.z) * q2[5] + bflo(k2.w) * q2[6] + bfhi(k2.w) * q2[7]; }
            sc[j] = s1; sc[1536 + j] = s2; m1 = fmaxf(m1, s1); m2 = fmaxf(m2, s2);
        }
        m1 = wave_max(m1); m2 = wave_max(m2);
        float l1 = 0.f, l2 = 0.f;
        for (int j = lane; j < nk; j += 64) { const float p1 = exp2f(sc[j] - m1), p2 = exp2f(sc[1536 + j] - m2); sc[j] = p1; sc[1536 + j] = p2; l1 += p1; l2 += p2; }
        l1 = wave_sum(l1); l2 = wave_sum(l2);
        const float i1 = 1.0f / l1, i2 = lam / l2;
        for (int j = lane; j < nk; j += 64) sc[j] = sc[j] * i1 - sc[1536 + j] * i2;
        LDS_WAIT(); asm volatile("" ::: "memory");
        float o0 = 0.f, o1 = 0.f;
#pragma unroll 8
        for (int j = 0; j < nk; ++j) { const unsigned w = *(const unsigned*)(Vp + (size_t)j * AW + 2 * lane); const float p = sc[j]; o0 += p * bflo(w); o1 += p * bfhi(w); }
        const float ss = wave_sum(o0 * o0 + o1 * o1); const float r = 1.0f / sqrtf(ss * (1.0f / 128.0f) + LN_EPS) * 0.8f;
        *(unsigned*)(MIX + (size_t)row * DM + h * 128 + 2 * lane) = pk2(o0 * r * attg[h * 128 + 2 * lane], o1 * r * attg[h * 128 + 2 * lane + 1]);
        LDS_WAIT(); asm volatile("" ::: "memory");
    }
}
__device__ __forceinline__ void rnn_naive(const Args& a, LAS unsigned char* lds, int vcu, int G, int tid) {
    unsigned char* ws = a.ws;
    const bf16* RQ = (const bf16*)(ws + WS_RQ); const bf16* RI = (const bf16*)(ws + WS_RI); const bf16* RG = (const bf16*)(ws + WS_RG);
    float* OF = (float*)(ws + WS_OF); bf16* MIX = (bf16*)(ws + WS_MIX); const float* rnng = a.in[17];
    LAS float* Fl = (LAS float*)lds;
    LAS float* Kl = Fl + 2048; LAS float* Ql = Kl + 2048; LAS float* Vl = Ql + 2048;
    LAS float* PO = Vl + 2048;
    const int e = tid & 127, qd = tid >> 7;
    for (int it = vcu; it < 96; it += G) {
        const bool ctx = it < 64; const int bi = ctx ? it : it - 64, b = bi >> 2, h = bi & 3;
        const int L = ctx ? CSEQ : LSEQ, row0 = ctx ? b * CSEQ : NCTX + b * LSEQ;
        for (int dir = 0; dir < 2; ++dir) {
            const float* GT = (const float*)(ws + (dir ? WS_GB : WS_GF));
            float S[32];
            if (ctx) {
#pragma unroll
                for (int i = 0; i < 32; ++i) S[i] = 0.f;
            } else { const float* s0 = a.in[4] + ((size_t)(b * 2 + dir) * 4 + h) * 16384;
#pragma unroll
                for (int i = 0; i < 32; ++i) S[i] = s0[(size_t)(32 * qd + i) * 128 + e]; }
            for (int tb = 0; tb < L / 16; ++tb) {
#pragma unroll
                for (int j = 0; j < 4; ++j) { const int idx = tid + NTHR * j, i = idx >> 7, d = idx & 127; const int s = tb * 16 + i, t = dir ? L - 1 - s : s;
                    const size_t o = (size_t)(row0 + t) * AW + h * 128 + d;
                    const float f = __expf(GT[o]); Fl[idx] = f; Kl[idx] = 1.0f - f; Ql[idx] = __uint_as_float((unsigned)RQ[o] << 16); Vl[idx] = __uint_as_float((unsigned)RI[o] << 16); }
                __syncthreads();
#pragma unroll 1
                for (int i = 0; i < 16; ++i) { const float v = Vl[i * 128 + e]; float po = 0.f;
#pragma unroll
                    for (int dd = 0; dd < 32; ++dd) { const int d = 32 * qd + dd; S[dd] = Fl[i * 128 + d] * S[dd] + Kl[i * 128 + d] * v; po += S[dd] * Ql[i * 128 + d]; }
                    PO[(i * 4 + qd) * 128 + e] = po; }
                __syncthreads();
                { const int i = tid >> 5, e4 = (tid & 31) * 4; const int s = tb * 16 + i, t = dir ? L - 1 - s : s; const size_t o = (size_t)(row0 + t) * AW + h * 128 + e4;
                    f32x4 ov = *(const LAS f32x4*)(PO + (i * 4 + 0) * 128 + e4) + *(const LAS f32x4*)(PO + (i * 4 + 1) * 128 + e4) + *(const LAS f32x4*)(PO + (i * 4 + 2) * 128 + e4) + *(const LAS f32x4*)(PO + (i * 4 + 3) * 128 + e4);
                    if (dir == 0) *(f32x4*)(OF + o) = ov;
                    else { ov += *(const f32x4*)(OF + o);
                        float ss = (ov[0] * ov[0] + ov[1] * ov[1]) + (ov[2] * ov[2] + ov[3] * ov[3]);
                        ss += __shfl_xor(ss, 1); ss += __shfl_xor(ss, 2); ss += __shfl_xor(ss, 4); ss += __shfl_xor(ss, 8); ss += __shfl_xor(ss, 16);
                        const float r = 1.0f / sqrtf(ss * (1.0f / 128.0f) + LN_EPS); const f32x4 g = *(const f32x4*)(rnng + h * 128 + e4); const v2u gw = *(const v2u*)(RG + o);
                        f32x4 res; res[0] = ov[0] * r * g[0] * bflo(gw.x); res[1] = ov[1] * r * g[1] * bfhi(gw.x); res[2] = ov[2] * r * g[2] * bflo(gw.y); res[3] = ov[3] * r * g[3] * bfhi(gw.y);
                        *(v2u*)(MIX + (size_t)(row0 + t) * DM + AW + h * 128 + e4) = pk4(res); } }
            }
            if (ctx) { float* so = a.out + OUT_S + ((size_t)(b * 2 + dir) * 4 + h) * 16384;
#pragma unroll
                for (int i = 0; i < 32; ++i) so[(size_t)(32 * qd + i) * 128 + e] = S[i]; }
            __threadfence(); __syncthreads();
        }
    }
}
constexpr int RN_QE = 0, RN_KD = 4352, RN_KET = 8704, RN_VT = 8704 + 5120, RN_DEC = 8704 + 10240, RN_BUF = 8704 + 10240 + 512;
struct RnnRaw { float lg[4]; unsigned short q[4], v[4]; };
__device__ __forceinline__ void rnn_load_raw(RnnRaw& R, const float* GT, const bf16* RQ, const bf16* RI, int row0, int L, int dir, int c, int h, int d, int sg) {
#pragma unroll
    for (int i = 0; i < 4; ++i) { const int s = c * 16 + 4 * sg + i, t = dir ? L - 1 - s : s; const size_t o = (size_t)(row0 + t) * AW + h * 128 + d;
        R.lg[i] = GT[o]; R.q[i] = RQ[o]; R.v[i] = RI[o]; }
}
__device__ __forceinline__ void rnn_prep(const RnnRaw& R, LAS unsigned char* buf, int d, int sg, int lane) {
    float cum[4]; cum[0] = R.lg[0]; cum[1] = cum[0] + R.lg[1]; cum[2] = cum[1] + R.lg[2]; cum[3] = cum[2] + R.lg[3];
    const float T = cum[3];
    const float t1 = __shfl_up(T, 16), t2 = __shfl_up(T, 32), t3 = __shfl_up(T, 48);
    const float off = (sg >= 1 ? t1 : 0.f) + (sg >= 2 ? t2 : 0.f) + (sg >= 3 ? t3 : 0.f);
    const float last = __shfl(off + T, 48 + (lane & 15));
    const int pos = 32 * (d >> 5) + 8 * ((d & 15) >> 2) + 4 * ((d >> 4) & 1) + (d & 3);
    unsigned ke[4], vv[4];
#pragma unroll
    for (int i = 0; i < 4; ++i) { const float cm = cum[i] + off; const float k = 1.0f - __expf(R.lg[i]);
        const float qe = __uint_as_float((unsigned)R.q[i] << 16) * __expf(cm), kd = k * __expf(-cm); ke[i] = f2bf(k * __expf(last - cm)); vv[i] = R.v[i];
        const int s = 4 * sg + i;
        *(LAS unsigned short*)(buf + RN_QE + s * 272 + pos * 2) = (unsigned short)f2bf(qe);
        *(LAS unsigned short*)(buf + RN_KD + s * 272 + pos * 2) = (unsigned short)f2bf(kd); }
    *(LAS v2u*)(buf + RN_KET + d * 40 + sg * 8) = (v2u){ke[0] | (ke[1] << 16), ke[2] | (ke[3] << 16)};
    *(LAS v2u*)(buf + RN_VT + d * 40 + sg * 8) = (v2u){vv[0] | (vv[1] << 16), vv[2] | (vv[3] << 16)};
    if (sg == 3) *(LAS float*)(buf + RN_DEC + d * 4) = __expf(last);
}
__device__ __forceinline__ void rnn_mfma(const Args& a, LAS unsigned char* lds, int vcu, int G, int tid, int lane, int wave) {
    unsigned char* ws = a.ws;
    const bf16* RQ = (const bf16*)(ws + WS_RQ); const bf16* RI = (const bf16*)(ws + WS_RI); const bf16* RG = (const bf16*)(ws + WS_RG);
    float* OF = (float*)(ws + WS_OF); bf16* MIX = (bf16*)(ws + WS_MIX); const float* rnng = a.in[17];
    const int dl = lane & 15, sg = lane >> 4, d = 16 * wave + dl;
    const int fr = lane & 15, g = lane >> 4, e = 16 * wave + fr;
    for (int it = vcu; it < 96; it += G) {
        const int item = it < 32 ? it + 64 : it - 32;
        const bool ctx = item < 64; const int bi = ctx ? item : item - 64, b = bi >> 2, h = bi & 3;
        const int L = ctx ? CSEQ : LSEQ, row0 = ctx ? b * CSEQ : NCTX + b * LSEQ, NC = L / 16;
        for (int dir = 0; dir < 2; ++dir) {
            const float* GT = (const float*)(ws + (dir ? WS_GB : WS_GF));
            f32x4 acc[8];
            if (ctx) {
#pragma unroll
                for (int i = 0; i < 8; ++i) acc[i] = (f32x4){0.f, 0.f, 0.f, 0.f};
            } else { const float* s0 = a.in[4] + ((size_t)(b * 2 + dir) * 4 + h) * 16384;
#pragma unroll
                for (int i = 0; i < 8; ++i)
#pragma unroll
                    for (int r = 0; r < 4; ++r) acc[i][r] = s0[(size_t)(16 * i + 4 * g + r) * 128 + e]; }
            RnnRaw R; rnn_load_raw(R, GT, RQ, RI, row0, L, dir, 0, h, d, sg);
            for (int c = 0; c < NC; ++c) {
                LAS unsigned char* buf = lds + (c & 1) * RN_BUF;
                rnn_prep(R, buf, d, sg, lane);
                if (c + 1 < NC) rnn_load_raw(R, GT, RQ, RI, row0, L, dir, c + 1, h, d, sg);
                __syncthreads();
                bf16x8 qf[4], kf[4];
#pragma unroll
                for (int kk = 0; kk < 4; ++kk) { qf[kk] = *(const LAS bf16x8*)(buf + RN_QE + fr * 272 + kk * 64 + g * 16); kf[kk] = *(const LAS bf16x8*)(buf + RN_KD + fr * 272 + kk * 64 + g * 16); }
                const v2u vw = *(const LAS v2u*)(buf + RN_VT + e * 40 + g * 8);
                const bf16x8 vb = __builtin_bit_cast(bf16x8, (v4u){vw.x, vw.y, 0u, 0u});
                f32x4 pT = (f32x4){0.f, 0.f, 0.f, 0.f};
#pragma unroll
                for (int kk = 0; kk < 4; ++kk) pT = __builtin_amdgcn_mfma_f32_16x16x32_bf16(kf[kk], qf[kk], pT, 0, 0, 0);
#pragma unroll
                for (int r = 0; r < 4; ++r) pT[r] = (4 * g + r <= fr) ? pT[r] : 0.f;
                const bf16x8 pa = __builtin_bit_cast(bf16x8, (v4u){pk2(pT[0], pT[1]), pk2(pT[2], pT[3]), 0u, 0u});
                f32x4 o = __builtin_amdgcn_mfma_f32_16x16x32_bf16(pa, vb, (f32x4){0.f, 0.f, 0.f, 0.f}, 0, 0, 0);
#pragma unroll
                for (int kk = 0; kk < 4; ++kk) {
                    const bf16x8 sb = __builtin_bit_cast(bf16x8, (v4u){pk2(acc[2 * kk][0], acc[2 * kk][1]), pk2(acc[2 * kk][2], acc[2 * kk][3]), pk2(acc[2 * kk + 1][0], acc[2 * kk + 1][1]), pk2(acc[2 * kk + 1][2], acc[2 * kk + 1][3])});
                    o = __builtin_amdgcn_mfma_f32_16x16x32_bf16(qf[kk], sb, o, 0, 0, 0); }
#pragma unroll
                for (int i = 0; i < 8; ++i) { const f32x4 dc = *(const LAS f32x4*)(buf + RN_DEC + (16 * i + 4 * g) * 4);
                    const v2u kw = *(const LAS v2u*)(buf + RN_KET + (16 * i + fr) * 40 + g * 8); const bf16x8 ka = __builtin_bit_cast(bf16x8, (v4u){kw.x, kw.y, 0u, 0u});
                    acc[i] = __builtin_amdgcn_mfma_f32_16x16x32_bf16(ka, vb, acc[i] * dc, 0, 0, 0); }
#pragma unroll
                for (int r = 0; r < 4; ++r) { const int s = c * 16 + 4 * g + r, t = dir ? L - 1 - s : s; float* op = OF + (size_t)(row0 + t) * AW + h * 128 + e;
                    if (dir == 0) *op = o[r]; else *op += o[r]; }
            }
            if (ctx) { float* so = a.out + OUT_S + ((size_t)(b * 2 + dir) * 4 + h) * 16384;
#pragma unroll
                for (int i = 0; i < 8; ++i)
#pragma unroll
                    for (int r = 0; r < 4; ++r) so[(size_t)(16 * i + 4 * g + r) * 128 + e] = acc[i][r]; }
            __threadfence(); __syncthreads();
        }
        for (int t = wave; t < L; t += NWAVES) { const size_t o = (size_t)(row0 + t) * AW + h * 128 + 2 * lane;
            const float2 ov = *(const float2*)(OF + o); const float ss = wave_sum(ov.x * ov.x + ov.y * ov.y); const float r = 1.0f / sqrtf(ss * (1.0f / 128.0f) + LN_EPS);
            const unsigned gw = *(const unsigned*)(RG + o); const float2 gn = *(const float2*)(rnng + h * 128 + 2 * lane);
            *(unsigned*)(MIX + (size_t)(row0 + t) * DM + AW + h * 128 + 2 * lane) = pk2(ov.x * r * gn.x * bflo(gw), ov.y * r * gn.y * bfhi(gw)); }
        __syncthreads();
    }
}
#ifndef MK_N_LAUNCHES
#define MK_N_LAUNCHES 1
#endif
constexpr int NPH = 10;
__global__ void __launch_bounds__(NTHR, 2) fwd(Args args) {
    extern __shared__ __attribute__((aligned(16))) unsigned char lds_[];
    LAS unsigned char* lds = (LAS unsigned char*)lds_;
    const int tid = threadIdx.x, lane = tid & 63, wave = __builtin_amdgcn_readfirstlane(tid >> 6);
    const int G = gridDim.x, bx = blockIdx.x, vcu = (G % 8 == 0) ? (bx % 8) * (G / 8) + bx / 8 : bx;
    unsigned char* ws = args.ws;
    for (int u = tid; u < (LDS_BYTES - RING_BYTES) / 4; u += NTHR) ((LAS unsigned*)(lds + RING_BYTES))[u] = 0u;
    __syncthreads();
    const int lo = args.ph_lo, hi = args.ph_hi;
    XcdBarrier bar; bar.bar = (unsigned*)(ws + WS_CTL) + CW_BAR; bar.x = 0; bar.st = nullptr;
    if (hi - lo > 1) bar = xcd_barrier_post((unsigned*)(ws + WS_CTL) + CW_BAR, (volatile LAS unsigned*)(lds + MISC_OFF) + 8);
#define IN(k) (lo <= (k) && (k) < hi)
#define SEAM(k) do { if (IN(k) && IN((k) + 1)) xcd_barrier(bar); } while (0)
    float* mod = (float*)(ws + WS_MOD);
    if (IN(0)) { p0_prologue(args, lds, vcu, G, tid, lane, wave); SEAM(0); }
    if (IN(1)) { p1_modulate(args, vcu, G, lane, wave); SEAM(1); }
    if (IN(2)) {
        pg8::Gemm g{(const bf16*)(ws + WS_XM), (const bf16*)(ws + WS_WIN), MROWS, INC, DM}; pg8::StaticOrder S; S.init(MROWS, INC, G, bx);
        Epi1 E{(bf16*)(ws + WS_Q), (bf16*)(ws + WS_KC), (bf16*)(ws + WS_VC), (bf16*)(ws + WS_KL), (bf16*)(ws + WS_VL), (bf16*)(ws + WS_RQ), (bf16*)(ws + WS_RI), (bf16*)(ws + WS_RG),
               (float*)(ws + WS_GF), (float*)(ws + WS_GB), args.out + OUT_K, args.out + OUT_V, (const float*)(ws + WS_ROPE), args.in[14], args.in[15]};
        pg8::gemm_phase<Epi1, pg8::StaticOrder, true, true>(lds, g, S, E);
        SEAM(2);
    }
    if (IN(3)) {
        if (G >= 192) { if (vcu < 96) rnn_mfma(args, lds, vcu, 96, tid, lane, wave); else attn_naive(args, lds, vcu - 96, G - 96, lane, wave); }
        else { rnn_mfma(args, lds, vcu, G, tid, lane, wave); __syncthreads(); attn_naive(args, lds, vcu, G, lane, wave); }
        SEAM(3);
    }
    if (IN(4)) {
        pg8::Gemm g{(const bf16*)(ws + WS_MIX), (const bf16*)(ws + WS_WOUT), MROWS, DM, DM}; pg8::StaticOrder S; S.init(MROWS, DM, G, bx);
        EpiRes E{args.in[0], args.in[1], nullptr, args.out + OUT_Y, mod + 2048};
        pg8::gemm_phase<EpiRes, pg8::StaticOrder, true, true>(lds, g, S, E);
        SEAM(4);
    }
    if (IN(5)) { ln_rows(args, args.in[19], args.in[20], true, vcu, G, lane, wave); SEAM(5); }
    if (IN(6)) {
        pg8::Gemm g{(const bf16*)(ws + WS_XM), (const bf16*)(ws + WS_WUP), MROWS, FF2, DM}; pg8::StaticOrder S; S.init(MROWS, FF2, G, bx);
        EpiH E{(bf16*)(ws + WS_H)};
        pg8::gemm_phase<EpiH, pg8::StaticOrder, true, true>(lds, g, S, E);
        SEAM(6);
    }
    if (IN(7)) { conv_gate(args, vcu, G, tid); SEAM(7); }
    if (IN(8)) {
        pg8::Gemm g{(const bf16*)(ws + WS_G), (const bf16*)(ws + WS_WDN), MROWS, DM, FF}; pg8::StaticOrder S; S.init(MROWS, DM, G, bx);
        EpiRes E{args.in[0], args.in[1], args.out + OUT_Y, args.out + OUT_Y, mod + 5120};
        pg8::gemm_phase<EpiRes, pg8::StaticOrder, true, true>(lds, g, S, E);
        SEAM(8);
    }
    if (IN(9)) { ln_rows(args, args.in[25], args.in[26], false, vcu, G, lane, wave); }
#undef IN
#undef SEAM
}

extern "C" void kernel_launch(void* const* d_in, const int* in_sizes, int n_in, void* d_out, int out_size, void* d_ws, size_t ws_size, hipStream_t stream) {
    static int grid = 0;
    if (grid == 0) {
        if (n_in != 27 || out_size != 18874368 || ws_size < WS_END) { fprintf(stderr, "kernel_launch: unexpected shapes (n_in %d, out %d, ws %zu)\n", n_in, out_size, ws_size); grid = -1; return; }
        int dev = 0, cus = 0, per_cu = 0;
        if (hipGetDevice(&dev) != hipSuccess || hipDeviceGetAttribute(&cus, hipDeviceAttributeMultiprocessorCount, dev) != hipSuccess) { grid = -1; return; }
        if (hipFuncSetAttribute((const void*)fwd, hipFuncAttributeMaxDynamicSharedMemorySize, LDS_BYTES) != hipSuccess) { fprintf(stderr, "kernel_launch: hipFuncSetAttribute failed\n"); grid = -1; return; }
        if (hipOccupancyMaxActiveBlocksPerMultiprocessor(&per_cu, (const void*)fwd, NTHR, LDS_BYTES) != hipSuccess || per_cu < 1) { fprintf(stderr, "kernel_launch: occupancy query reports %d\n", per_cu); per_cu = 1; }
        (void)hipGetLastError();
        grid = cus;
    }
    if (grid < 0) return;
    (void)hipMemsetAsync((char*)d_ws + WS_CTL, 0, CTL_ZERO_BYTES, stream);
    Args a{};
    for (int i = 0; i < 27; ++i) a.in[i] = (const float*)d_in[i];
    a.out = (float*)d_out; a.ws = (unsigned char*)d_ws;
    if (MK_N_LAUNCHES == 1) { a.ph_lo = 0; a.ph_hi = NPH; hipLaunchKernelGGL(fwd, dim3(grid), dim3(NTHR), LDS_BYTES, stream, a); }
    else for (int li = 0; li < NPH; ++li) { a.ph_lo = li; a.ph_hi = li + 1; hipLaunchKernelGGL(fwd, dim3(grid), dim3(NTHR), LDS_BYTES, stream, a); }
}
```

```cpp
#include <hip/hip_runtime.h>
#include <cstdio>
#include <cstdint>
#define MK_N_LAUNCHES 1
namespace pg8 {
#define PG8_LAS __attribute__((address_space(3)))
typedef unsigned short bf16_t;
typedef short bf16x8 __attribute__((ext_vector_type(8)));
typedef float f32x4 __attribute__((ext_vector_type(4)));
typedef unsigned u32x4 __attribute__((ext_vector_type(4)));
constexpr int BM = 256, BK = 64, HALF = 128, HTB = HALF * BK * 2  , STAGE_BYTES = 8 * HTB, NXCD = 8, WGM = 8;

__host__ __device__ __forceinline__ int lds_byte(int r, int c) { const int st = (r >> 4) * 2 + (c >> 5), rr = r & 15, cc = c & 31, ob = rr * 64 + cc * 2; return st * 1024 + (ob ^ (((ob >> 9) & 1) << 5)); }
__host__ __device__ __forceinline__ void stage_rc(int b, int& R, int& C) { const int st = b / 1024, sb = b % 1024, swz = sb ^ (((sb >> 9) & 1) << 5); R = (st >> 1) * 16 + swz / 64; C = (st & 1) * 32 + (swz % 64) / 2; }
__host__ __device__ __forceinline__ int perm32(int rho) { const int n = rho >> 4, i = rho & 15; return 8 * (i >> 2) + 4 * n + (i & 3); }

struct Unit { int pm, pn; };
struct Gemm { const bf16_t* A; const bf16_t* Bt; int M, N, K; };

struct StaticOrder {
    int nM, nN, nwg, G, c;
    __host__ __device__ void init(int M, int N, int G_, int c_) { nM = M / BM; nN = N / BM; nwg = nM * nN; G = G_; c = c_; }
    __host__ __device__ bool next(int i, Unit& u) const {
        const long L = (long)i * G + c; if (L >= nwg) return false;
        int wgid = (int)L; { const int q = nwg / NXCD, r = nwg % NXCD, xcd = wgid % NXCD, off = wgid / NXCD; wgid = (xcd < r ? xcd * (q + 1) : r * (q + 1) + (xcd - r) * q) + off; }
        const int nig = WGM * nN, gid = wgid / nig, fm = gid * WGM, gsz = (nM - fm) < WGM ? (nM - fm) : WGM;
        u.pm = fm + ((wgid % nig) % gsz); u.pn = (wgid % nig) / gsz; return true;
    }
    __device__ __forceinline__ void a_ready(const Unit&) const {}
    __device__ __forceinline__ void done(const Unit&) const {}
};

__device__ __forceinline__ unsigned cvt_pk_bf16(float lo, float hi) { unsigned r; asm volatile("v_cvt_pk_bf16_f32 %0, %1, %2" : "=v"(r) : "v"(lo), "v"(hi)); return r; }
typedef float f32x2 __attribute__((ext_vector_type(2)));
template <class Epi, class Sched, bool ALIGN_EPI = false, bool SP2 = false>
__device__ __forceinline__ void gemm_phase(PG8_LAS unsigned char* lds, const Gemm g, const Sched& S, const Epi& E) {
    const int tid = threadIdx.x, wid = __builtin_amdgcn_readfirstlane(tid >> 6), lane = tid & 63, wr = wid >> 2, wc = wid & 3, fr = lane & 15, fq = lane >> 4;
    const int K = g.K, nt = K / BK;
    unsigned voffA[2], voffB[2];
#pragma unroll
    for (int i = 0; i < 2; ++i) { int R, C; stage_rc(tid * 16 + i * 8192, R, C); const int Rb = Epi::PERM ? ((R & ~31) + perm32(R & 31)) : R;
        voffA[i] = (unsigned)(R * K + C) * 2u; voffB[i] = (unsigned)(Rb * K + C) * 2u; }
    const size_t kstep = (size_t)(BK * 2);
    const size_t hstep = (size_t)HALF * K * 2;
    const size_t tstep = 2 * hstep;
    const unsigned ldsw = (unsigned)wid * 1024u;
    const int aoff = lds_byte(wr * 64 + fr, fq * 8), boff = lds_byte(wc * 32 + fr, fq * 8);
#define PG8_SA(b, h) (((b) * 2 + (h)) * HTB)
#define PG8_SB(b, h) ((4 + (b) * 2 + (h)) * HTB)
#define PG8_STAGE(bufoff, gbase, voff) do { _Pragma("unroll") for (int _i = 0; _i < 2; ++_i) \
        __builtin_amdgcn_global_load_lds((const unsigned*)((const char*)(gbase) + (voff)[_i]), (PG8_LAS unsigned*)(lds + (bufoff) + ldsw + _i * 8192), 16, 0, 0); } while (0)
#define PG8_LDA(dst, b, h) do { _Pragma("unroll") for (int m = 0; m < 4; ++m) _Pragma("unroll") for (int k = 0; k < 2; ++k) dst[m][k] = *(const PG8_LAS bf16x8*)(lds + PG8_SA(b, h) + aoff + m * 2048 + k * 1024); } while (0)
#define PG8_LDB(dst, b, h) do { _Pragma("unroll") for (int n = 0; n < 2; ++n) _Pragma("unroll") for (int k = 0; k < 2; ++k) dst[n][k] = *(const PG8_LAS bf16x8*)(lds + PG8_SB(b, h) + boff + n * 2048 + k * 1024); } while (0)
#define PG8_MMA(ai, bj, At, Bt) do { __builtin_amdgcn_s_setprio(1); _Pragma("unroll") for (int m = 0; m < 4; ++m) _Pragma("unroll") for (int n = 0; n < 2; ++n) _Pragma("unroll") for (int k = 0; k < 2; ++k) \
        acc[ai][bj][m][n] = __builtin_amdgcn_mfma_f32_16x16x32_bf16(Bt[n][k], At[m][k], acc[ai][bj][m][n], 0, 0, 0); __builtin_amdgcn_s_setprio(0); } while (0)
#define PG8_WAIT_V(n) asm volatile("s_waitcnt vmcnt(" #n ")" ::: "memory")
#define PG8_WAIT_L(n) asm volatile("s_waitcnt lgkmcnt(" #n ")" ::: "memory")
#define PG8_BAR __builtin_amdgcn_s_barrier()
#define PG8_SCHED __builtin_amdgcn_sched_barrier(0)
    Unit cur, nxt; int ui = 0;
    if (!S.next(0, cur)) return;
    f32x4 acc[2][2][4][2];
#pragma unroll
    for (int a = 0; a < 2; ++a)
#pragma unroll
        for (int b = 0; b < 2; ++b)
#pragma unroll
            for (int m = 0; m < 4; ++m)
#pragma unroll
                for (int n = 0; n < 2; ++n) acc[a][b][m][n] = (f32x4){0.f, 0.f, 0.f, 0.f};
    bf16x8 At[4][2], B0[2][2], B1[2][2];
    const char* cA = (const char*)g.A + (size_t)cur.pm * tstep; const char* cB = (const char*)g.Bt + (size_t)cur.pn * tstep;
    S.a_ready(cur);
    if constexpr (SP2) {
        PG8_STAGE(PG8_SB(0, 0), cB, voffB); PG8_STAGE(PG8_SB(0, 1), cB + hstep, voffB); PG8_STAGE(PG8_SA(0, 0), cA, voffA); PG8_STAGE(PG8_SA(0, 1), cA + hstep, voffA);
        if (wr == 1) PG8_BAR;
        PG8_WAIT_V(2); PG8_BAR;
        PG8_STAGE(PG8_SB(1, 0), cB + kstep, voffB); PG8_STAGE(PG8_SA(1, 0), cA + kstep, voffA); PG8_STAGE(PG8_SB(1, 1), cB + hstep + kstep, voffB);
        PG8_WAIT_V(6); PG8_BAR;
    } else {
        PG8_STAGE(PG8_SB(0, 0), cB, voffB); PG8_STAGE(PG8_SA(0, 0), cA, voffA); PG8_STAGE(PG8_SB(0, 1), cB + hstep, voffB); PG8_STAGE(PG8_SA(0, 1), cA + hstep, voffA);
        if (wr == 1) PG8_BAR;
        PG8_WAIT_V(4); PG8_BAR;
        PG8_STAGE(PG8_SB(1, 0), cB + kstep, voffB); PG8_STAGE(PG8_SA(1, 0), cA + kstep, voffA); PG8_STAGE(PG8_SB(1, 1), cB + hstep + kstep, voffB);
        PG8_WAIT_V(6); PG8_BAR;
    }
    for (;;) {
        const bool has_next = S.next(ui + 1, nxt);
        const char* nA = has_next ? (const char*)g.A + (size_t)nxt.pm * tstep : cA; const char* nB = has_next ? (const char*)g.Bt + (size_t)nxt.pn * tstep : cB;
        for (int t = 0; t < nt; t += 2) {
            const bool last = (t == nt - 2);
            const char* a1 = cA + (size_t)(t + 1) * kstep;
            const char* a2 = last ? nA : cA + (size_t)(t + 2) * kstep; const char* b2 = last ? nB : cB + (size_t)(t + 2) * kstep;
            const char* a3 = a2 + kstep; const char* b3 = b2 + kstep;
            if (last && has_next) S.a_ready(nxt);
            if constexpr (SP2) {
            PG8_LDB(B0, 0, 0); PG8_LDB(B1, 0, 1); PG8_SCHED; PG8_LDA(At, 0, 0); PG8_STAGE(PG8_SA(1, 1), a1 + hstep, voffA);
            PG8_WAIT_V(8); PG8_WAIT_L(0); PG8_BAR; PG8_MMA(0, 0, At, B0); PG8_MMA(0, 1, At, B1); PG8_BAR; PG8_SCHED;
            PG8_LDA(At, 0, 1); PG8_STAGE(PG8_SB(0, 0), b2, voffB); PG8_STAGE(PG8_SB(0, 1), b2 + hstep, voffB); PG8_STAGE(PG8_SA(0, 0), a2, voffA);
            PG8_WAIT_V(8); PG8_WAIT_L(0); PG8_BAR; PG8_MMA(1, 0, At, B0); PG8_MMA(1, 1, At, B1); PG8_BAR; PG8_SCHED;
            PG8_LDB(B0, 1, 0); PG8_LDB(B1, 1, 1); PG8_SCHED; PG8_LDA(At, 1, 0); PG8_STAGE(PG8_SA(0, 1), a2 + hstep, voffA);
            PG8_WAIT_V(8); PG8_WAIT_L(0); PG8_BAR; PG8_MMA(0, 0, At, B0); PG8_MMA(0, 1, At, B1); PG8_BAR; PG8_SCHED;
            PG8_LDA(At, 1, 1); PG8_STAGE(PG8_SB(1, 0), b3, voffB); PG8_STAGE(PG8_SB(1, 1), b3 + hstep, voffB); PG8_STAGE(PG8_SA(1, 0), a3, voffA);
            PG8_WAIT_V(8); PG8_WAIT_L(0); PG8_BAR; PG8_MMA(1, 0, At, B0); PG8_MMA(1, 1, At, B1); PG8_BAR; PG8_SCHED;
            } else {
            PG8_LDB(B0, 0, 0); PG8_SCHED; PG8_LDA(At, 0, 0); PG8_STAGE(PG8_SA(1, 1), a1 + hstep, voffA);
            PG8_WAIT_L(8); PG8_BAR; PG8_WAIT_L(0); PG8_MMA(0, 0, At, B0); PG8_BAR; PG8_SCHED;
            PG8_LDB(B1, 0, 1); PG8_STAGE(PG8_SB(0, 0), b2, voffB);
            PG8_BAR; PG8_WAIT_L(0); PG8_MMA(0, 1, At, B1); PG8_BAR;
            PG8_LDA(At, 0, 1); PG8_STAGE(PG8_SA(0, 0), a2, voffA);
            PG8_BAR; PG8_WAIT_L(0); PG8_MMA(1, 0, At, B0); PG8_BAR; PG8_SCHED;
            PG8_STAGE(PG8_SB(0, 1), b2 + hstep, voffB);
            PG8_WAIT_V(6); PG8_BAR; PG8_MMA(1, 1, At, B1); PG8_BAR;
            PG8_LDB(B0, 1, 0); PG8_SCHED; PG8_LDA(At, 1, 0); PG8_STAGE(PG8_SA(0, 1), a2 + hstep, voffA);
            PG8_WAIT_L(8); PG8_BAR; PG8_WAIT_L(0); PG8_MMA(0, 0, At, B0); PG8_BAR; PG8_SCHED;
            PG8_LDB(B1, 1, 1); PG8_STAGE(PG8_SB(1, 0), b3, voffB);
            PG8_BAR; PG8_WAIT_L(0); PG8_MMA(0, 1, At, B1); PG8_BAR;
            PG8_LDA(At, 1, 1); PG8_STAGE(PG8_SA(1, 0), a3, voffA);
            PG8_BAR; PG8_WAIT_L(0); PG8_MMA(1, 0, At, B0); PG8_BAR; PG8_SCHED;
            PG8_STAGE(PG8_SB(1, 1), b3 + hstep, voffB);
            PG8_WAIT_V(6); PG8_BAR; PG8_MMA(1, 1, At, B1); PG8_BAR;
            }
        }
        if constexpr (ALIGN_EPI) { if (wr == 0) PG8_BAR; }
        if constexpr (!Epi::AFTER_DRAIN) { E(acc, cur, wr, wc, fr, fq); S.done(cur); }
        if (!has_next) break;
#pragma unroll
        for (int a = 0; a < 2; ++a)
#pragma unroll
            for (int b = 0; b < 2; ++b)
#pragma unroll
                for (int m = 0; m < 4; ++m)
#pragma unroll
                    for (int n = 0; n < 2; ++n) acc[a][b][m][n] = (f32x4){0.f, 0.f, 0.f, 0.f};
        cur = nxt; cA = nA; cB = nB; ++ui;
        if constexpr (ALIGN_EPI) { if (wr == 1) PG8_BAR; }
    }
    PG8_WAIT_V(0);
    if constexpr (!ALIGN_EPI) { if (wr == 0) PG8_BAR; }
    PG8_BAR;
    if constexpr (Epi::AFTER_DRAIN) { E.fused(acc, cur, wr, wc, fr, fq, lds, wid, lane); S.done(cur); }
#undef PG8_SA
#undef PG8_SB
#undef PG8_STAGE
#undef PG8_LDA
#undef PG8_LDB
#undef PG8_MMA
#undef PG8_WAIT_V
#undef PG8_WAIT_L
#undef PG8_BAR
#undef PG8_SCHED
}
}
constexpr int DM = 1024, NCTX = 4096, NLAT = 8192, MROWS = 12288;
constexpr int CSEQ = 256, LSEQ = 1024, PAST = 512, LKEYS = 1536;
constexpr int INC = 4096, FF = 2816, FF2 = 5632, AW = 512;
constexpr float ALPHA = 1.189207115002721f, LN_EPS = 1e-5f;
constexpr float QSCALE = 0.125f * 1.4426950408889634f;
constexpr int NWAVES = 8, NTHR = 512;
constexpr int LDS_BYTES = 147456;
constexpr int RING_BYTES = 131072, MISC_OFF = RING_BYTES + 320;

constexpr size_t MiB = 1u << 20;
constexpr size_t WS_CTL = 0, CTL_ZERO_BYTES = 65536;
constexpr size_t WS_MOD = 1 * MiB;
constexpr size_t WS_ROPE = 1 * MiB + 512 * 1024;
constexpr size_t WS_WIN = 2 * MiB, WS_WOUT = 10 * MiB, WS_WUP = 12 * MiB, WS_WDN = 23 * MiB;
constexpr size_t WS_XM = 29 * MiB;
constexpr size_t WS_Q = 53 * MiB, WS_KC = 65 * MiB, WS_VC = 69 * MiB, WS_KL = 73 * MiB, WS_VL = 85 * MiB;
constexpr size_t WS_RQ = 97 * MiB, WS_RI = 109 * MiB, WS_RG = 121 * MiB, WS_GF = 133 * MiB, WS_GB = 157 * MiB, WS_OF = 181 * MiB, WS_MIX = 205 * MiB;
constexpr size_t WS_H = 53 * MiB;
constexpr size_t WS_G = 185 * MiB;
constexpr size_t WS_END = 251 * MiB;
constexpr size_t OUT_Y = 0, OUT_K = 12582912, OUT_V = OUT_K + 2097152, OUT_S = OUT_V + 2097152;
constexpr int CW_BAR = 4096;

#define GAS __attribute__((address_space(1)))
#define LAS __attribute__((address_space(3)))
typedef unsigned short bf16;
typedef unsigned v4u __attribute__((ext_vector_type(4)));
typedef unsigned v2u __attribute__((ext_vector_type(2)));
typedef float f32x4 __attribute__((ext_vector_type(4)));
typedef short bf16x8 __attribute__((ext_vector_type(8)));
typedef GAS unsigned gu32;
#define RLX_AGENT __ATOMIC_RELAXED, __HIP_MEMORY_SCOPE_AGENT
#define LDS_WAIT() asm volatile("s_waitcnt lgkmcnt(0)" ::: "memory")
#define VM_WAIT() asm volatile("s_waitcnt vmcnt(0)" ::: "memory")
__device__ __forceinline__ unsigned f2bf(float f) { unsigned u = __builtin_bit_cast(unsigned, f); return (u + 0x7fffu + ((u >> 16) & 1u)) >> 16; }
__device__ __forceinline__ unsigned pk2(float lo, float hi) { return f2bf(lo) | (f2bf(hi) << 16); }
__device__ __forceinline__ float bflo(unsigned w) { return __uint_as_float(w << 16); }
__device__ __forceinline__ float bfhi(unsigned w) { return __uint_as_float(w & 0xffff0000u); }
__device__ __forceinline__ float wave_sum(float v) {
#pragma unroll
    for (int o = 1; o < 64; o <<= 1) v += __shfl_xor(v, o);
    return v;
}
__device__ __forceinline__ float wave_max(float v) {
#pragma unroll
    for (int o = 1; o < 64; o <<= 1) v = fmaxf(v, __shfl_xor(v, o));
    return v;
}
__device__ __forceinline__ float sigmoidf_(float z) { return 1.0f / (1.0f + __expf(-z)); }
__device__ __forceinline__ float siluf_(float z) { return z / (1.0f + __expf(-z)); }

struct Args { const float* in[27]; float* out; unsigned char* ws; int ph_lo, ph_hi; };
#define XB_TMO      128
#define XB_XCNT(j)  (256  + 64 * (j))
#define XB_XSUB(j)  (1280 + 64 * (j))
#define XB_XGEN(j)  (2304 + 64 * (j))
#define XB_TOP      3328
#define XB_TOPGEN   3392
#define XCD_BAR_WORDS 3456
#define XB_SPIN_CAP (1u << 18)

__device__ __forceinline__ unsigned xb_ld(unsigned* p)              { return __hip_atomic_load(p, __ATOMIC_RELAXED, __HIP_MEMORY_SCOPE_AGENT); }
__device__ __forceinline__ unsigned xb_add(unsigned* p, unsigned v) { return __hip_atomic_fetch_add(p, v, __ATOMIC_RELAXED, __HIP_MEMORY_SCOPE_AGENT); }
__device__ __forceinline__ unsigned xb_xcc_id() { return (unsigned)__builtin_amdgcn_s_getreg((3 << 11) | 20) & 0xFu; }
#define XB_SPIN(cond, bar) do { unsigned _sp = 0; while (cond) { __builtin_amdgcn_s_sleep(1); \
    if ((++_sp & 255u) == 0u) { if (xb_ld(&(bar)[XB_TMO])) break; if (_sp > XB_SPIN_CAP) { atomicAdd(&(bar)[XB_TMO], 1u); break; } } } } while (0)

struct XcdBarrier {
    unsigned* bar; unsigned x;
    volatile LAS unsigned* st;
};

__device__ __forceinline__ XcdBarrier xcd_barrier_post(unsigned* bar, volatile LAS unsigned* st) {
    XcdBarrier b; b.bar = bar; b.x = xb_xcc_id(); b.st = st;
    if (threadIdx.x == 0) (void)xb_add(&bar[XB_XCNT(b.x)], 1u);
    return b;
}
__device__ __forceinline__ void xcd_barrier_complete(unsigned* bar, unsigned x, unsigned& nloc, unsigned& nx) {
    const unsigned G = gridDim.x * gridDim.y * gridDim.z;
    unsigned sum, cnt, mine, sp = 0u;
    for (;;) {
        sum = 0u; cnt = 0u; mine = 0u;
#pragma unroll
        for (unsigned j = 0; j < 16; ++j) { const unsigned c = xb_ld(&bar[XB_XCNT(j)]); sum += c; cnt += (c > 0u) ? 1u : 0u; mine = (j == x) ? c : mine; }
        if (sum == G) break;
        __builtin_amdgcn_s_sleep(1);
        if ((++sp & 255u) == 0u) { if (xb_ld(&bar[XB_TMO])) break; if (sp > XB_SPIN_CAP) { atomicAdd(&bar[XB_TMO], 1u); break; } }
    }
    nloc = mine > 0u ? mine : 1u; nx = cnt > 0u ? cnt : 1u;
}

__device__ __forceinline__ void xcd_barrier(const XcdBarrier& b) {
    asm volatile("s_waitcnt vmcnt(0)" ::: "memory");
    __syncthreads();
    if (threadIdx.x == 0) {
        unsigned* bar = b.bar;
        __builtin_amdgcn_s_waitcnt(0);
        unsigned nloc = b.st[0], nx = b.st[1];
        if (nloc == 0u) { xcd_barrier_complete(bar, b.x, nloc, nx); b.st[0] = nloc; b.st[1] = nx; }
        const unsigned old = xb_add(&bar[XB_XSUB(b.x)], 1u);
        const unsigned gen = old / nloc;
        if (old + 1u == (gen + 1u) * nloc) {
            __builtin_amdgcn_fence(__ATOMIC_RELEASE, "agent");
            asm volatile("s_waitcnt vmcnt(0)" ::: "memory");
            const unsigned og = xb_add(&bar[XB_TOP], 1u);
            const unsigned tg = og / nx;
            if (og + 1u == (tg + 1u) * nx) xb_add(&bar[XB_TOPGEN], 1u);
            else XB_SPIN(xb_ld(&bar[XB_TOPGEN]) == tg, bar);
            __builtin_amdgcn_fence(__ATOMIC_ACQUIRE, "agent");
            xb_add(&bar[XB_XGEN(b.x)], 1u);
            asm volatile("s_waitcnt vmcnt(0)" ::: "memory");
        } else {
            XB_SPIN(xb_ld(&bar[XB_XGEN(b.x)]) == gen, bar);
            __builtin_amdgcn_fence(__ATOMIC_ACQUIRE, "agent");
            asm volatile("s_waitcnt vmcnt(0)" ::: "memory");
        }
    }
    __syncthreads();
}

__device__ __forceinline__ int mod_index(int row) { return row < NCTX ? 0 : 1 + ((row - NCTX) >> 10); }
__device__ __forceinline__ const float* xrow_ptr(const float* xp, const float* xs, int row) { return row < NCTX ? xp + (size_t)row * DM : xs + (size_t)(row - NCTX) * DM; }
__device__ __forceinline__ v2u pk4(f32x4 v) { v2u w; w.x = pk2(v[0], v[1]); w.y = pk2(v[2], v[3]); return w; }

struct Epi1 {
    static constexpr bool PERM = false, AFTER_DRAIN = false;
    bf16 *Q, *KC, *VC, *KL, *VL, *RQ, *RI, *RG; float *GF, *GB; float *outK, *outV; const float* rope; const float *lbf, *lbb;
    __device__ __forceinline__ void operator()(const f32x4 (&acc)[2][2][4][2], const pg8::Unit& u, int wr, int wc, int fr, int fq) const {
        const int grp = u.pn >> 1, cbase = (u.pn & 1) * 256; const bool ctx = u.pm < 16;
        if (grp <= 1) {
            const int half = wc & 1;
#pragma unroll
            for (int ai = 0; ai < 2; ++ai)
#pragma unroll
                for (int m = 0; m < 4; ++m) {
                    const int row = u.pm * 256 + ai * 128 + wr * 64 + m * 16 + fr;
                    f32x4 cs0 = (f32x4){1.f, 0.f, 1.f, 0.f}, cs1 = cs0;
                    if (!ctx) { const int t = (row - NCTX) & 1023; const int pos = half ? (t & 63) : (t >> 6);
                        const float* tp = rope + (size_t)pos * 32 + 8 * fq; cs0 = *(const f32x4*)tp; cs1 = *(const f32x4*)(tp + 4); }
#pragma unroll
                    for (int bj = 0; bj < 2; ++bj) {
                        const f32x4 x1 = acc[ai][bj][m][0], x2 = acc[ai][bj][m][1]; f32x4 o1, o2;
                        o1[0] = x1[0] * cs0[0] - x2[0] * cs0[1]; o2[0] = x1[0] * cs0[1] + x2[0] * cs0[0];
                        o1[1] = x1[1] * cs0[2] - x2[1] * cs0[3]; o2[1] = x1[1] * cs0[3] + x2[1] * cs0[2];
                        o1[2] = x1[2] * cs1[0] - x2[2] * cs1[1]; o2[2] = x1[2] * cs1[1] + x2[2] * cs1[0];
                        o1[3] = x1[3] * cs1[2] - x2[3] * cs1[3]; o2[3] = x1[3] * cs1[3] + x2[3] * cs1[2];
                        const int cg = cbase + bj * 128 + wc * 32 + 4 * fq;
                        if (grp == 0) { *(v2u*)(Q + (size_t)row * AW + cg) = pk4(o1 * QSCALE); *(v2u*)(Q + (size_t)row * AW + cg + 16) = pk4(o2 * QSCALE); }
                        else if (ctx) { *(f32x4*)(outK + (size_t)row * AW + cg) = x1; *(f32x4*)(outK + (size_t)row * AW + cg + 16) = x2;
                                        *(v2u*)(KC + (size_t)row * AW + cg) = pk4(x1); *(v2u*)(KC + (size_t)row * AW + cg + 16) = pk4(x2); }
                        else { const int b = (row - NCTX) >> 10, t = (row - NCTX) & 1023; bf16* kp = KL + ((size_t)b * LKEYS + PAST + t) * AW + cg;
                               *(v2u*)kp = pk4(o1); *(v2u*)(kp + 16) = pk4(o2); }
                    }
                }
            return;
        }
        f32x4 lb[2][2];
        if (grp == 4 || grp == 5) { const float* lg = grp == 4 ? lbf : lbb;
#pragma unroll
            for (int bj = 0; bj < 2; ++bj)
#pragma unroll
                for (int n = 0; n < 2; ++n) { const int cg = cbase + bj * 128 + wc * 32 + n * 16 + 4 * fq; const f32x4 l0 = *(const f32x4*)(lg + cg), l1 = *(const f32x4*)(lg + AW + cg);
#pragma unroll
                    for (int i = 0; i < 4; ++i) lb[bj][n][i] = sigmoidf_(l0[i] - l1[i]); } }
#pragma unroll
        for (int ai = 0; ai < 2; ++ai)
#pragma unroll
            for (int m = 0; m < 4; ++m) {
                const int row = u.pm * 256 + ai * 128 + wr * 64 + m * 16 + fr;
#pragma unroll
                for (int bj = 0; bj < 2; ++bj)
#pragma unroll
                    for (int n = 0; n < 2; ++n) {
                        const int cg = cbase + bj * 128 + wc * 32 + n * 16 + 4 * fq; const f32x4 v = acc[ai][bj][m][n]; const size_t o = (size_t)row * AW + cg;
                        if (grp == 2) { const int head = (cbase >> 7) + bj, e0 = wc * 32 + n * 16 + 4 * fq;
                                        if (ctx) { *(f32x4*)(outV + o) = v; const int b = row >> 8, l = row & 255; bf16* vp = VC + ((size_t)(b * 4 + head) * 128 + e0) * CSEQ + l;
#pragma unroll
                                            for (int i = 0; i < 4; ++i) vp[(size_t)i * CSEQ] = (bf16)f2bf(v[i]); }
                                        else { const int b = (row - NCTX) >> 10, t = (row - NCTX) & 1023; bf16* vp = VL + ((size_t)(b * 4 + head) * 128 + e0) * LKEYS + PAST + t;
#pragma unroll
                                            for (int i = 0; i < 4; ++i) vp[(size_t)i * LKEYS] = (bf16)f2bf(v[i]); } }
                        else if (grp == 3) *(v2u*)(RQ + o) = pk4(v);
                        else if (grp == 4 || grp == 5) { f32x4 w;
#pragma unroll
                            for (int i = 0; i < 4; ++i) { const float l = lb[bj][n][i]; w[i] = __logf(l + (1.0f - l) * sigmoidf_(v[i])); }
                            *(f32x4*)((grp == 4 ? GF : GB) + o) = w; }
                        else if (grp == 6) *(v2u*)(RI + o) = pk4(v);
                        else { f32x4 w;
#pragma unroll
                            for (int i = 0; i < 4; ++i) w[i] = siluf_(v[i]);
                            *(v2u*)(RG + o) = pk4(w); }
                    }
            }
    }
};
struct EpiRes {
    static constexpr bool PERM = false, AFTER_DRAIN = false;
    const float *xp, *xs; const float* ybase; float* out; const float* gate;
    __device__ __forceinline__ void operator()(const f32x4 (&acc)[2][2][4][2], const pg8::Unit& u, int wr, int wc, int fr, int fq) const {
        const int mi = u.pm < 16 ? 0 : 1 + ((u.pm - 16) >> 2); const float* gp = gate + (size_t)mi * 6144;
        f32x4 gv[2][2];
#pragma unroll
        for (int bj = 0; bj < 2; ++bj)
#pragma unroll
            for (int n = 0; n < 2; ++n) gv[bj][n] = *(const f32x4*)(gp + u.pn * 256 + bj * 128 + wc * 32 + n * 16 + 4 * fq);
#pragma unroll
        for (int ai = 0; ai < 2; ++ai)
#pragma unroll
            for (int m = 0; m < 4; ++m) {
                const int row = u.pm * 256 + ai * 128 + wr * 64 + m * 16 + fr;
                const float* bp = ybase ? ybase + (size_t)row * DM : xrow_ptr(xp, xs, row);
#pragma unroll
                for (int bj = 0; bj < 2; ++bj)
#pragma unroll
                    for (int n = 0; n < 2; ++n) { const int col = u.pn * 256 + bj * 128 + wc * 32 + n * 16 + 4 * fq;
                        const f32x4 b = *(const f32x4*)(bp + col); *(f32x4*)(out + (size_t)row * DM + col) = b * ALPHA + gv[bj][n] * acc[ai][bj][m][n]; }
            }
    }
};
struct EpiH {
    static constexpr bool PERM = false, AFTER_DRAIN = false;
    bf16* H;
    __device__ __forceinline__ void operator()(const f32x4 (&acc)[2][2][4][2], const pg8::Unit& u, int wr, int wc, int fr, int fq) const {
#pragma unroll
        for (int ai = 0; ai < 2; ++ai)
#pragma unroll
            for (int m = 0; m < 4; ++m) {
                const int row = u.pm * 256 + ai * 128 + wr * 64 + m * 16 + fr;
#pragma unroll
                for (int bj = 0; bj < 2; ++bj)
#pragma unroll
                    for (int n = 0; n < 2; ++n) { const int col = u.pn * 256 + bj * 128 + wc * 32 + n * 16 + 4 * fq; *(v2u*)(H + (size_t)row * FF2 + col) = pk4(acc[ai][bj][m][n]); }
            }
    }
};
__device__ __forceinline__ void p0_transpose_item(const float* W, int K, int N, bf16* WT, int k0, int n0, int orow0, LAS float* scr, int lane) {
#pragma unroll 8
    for (int i = 0; i < 32; ++i) { const int kk = 2 * i + (lane >> 5); scr[kk * 33 + (lane & 31)] = W[(size_t)(k0 + kk) * N + n0 + (lane & 31)]; }
    LDS_WAIT(); asm volatile("" ::: "memory");
    const int c = lane & 7;
#pragma unroll
    for (int j = 0; j < 4; ++j) { const int n = (lane >> 3) + 8 * j; const LAS float* s = scr + (8 * c) * 33 + n;
        v4u o; o.x = pk2(s[0 * 33], s[1 * 33]); o.y = pk2(s[2 * 33], s[3 * 33]); o.z = pk2(s[4 * 33], s[5 * 33]); o.w = pk2(s[6 * 33], s[7 * 33]);
        *(GAS v4u*)(WT + (size_t)(orow0 + n) * K + k0 + 8 * c) = o; }
    LDS_WAIT(); asm volatile("" ::: "memory");
}
__device__ __forceinline__ void p0_prologue(const Args& a, LAS unsigned char* lds, int vcu, int G, int tid, int lane, int wave) {
    unsigned char* ws = a.ws;
    {
        LAS float* cl = (LAS float*)lds;
        LAS float* red = (LAS float*)(lds + 40960);
        float* mod = (float*)(ws + WS_MOD);
        const float* wada = a.in[7]; const float* bada = a.in[8];
        bool filled = false;
        for (int cb = vcu; cb < 192; cb += G) {
            if (!filled) {
                for (int i = tid; i < 9 * 1024; i += NTHR) { const int m = i >> 10, k = i & 1023; const float v = (m == 0) ? a.in[6][k] : a.in[5][(m - 1) * 1024 + k]; cl[i] = siluf_(v); }
                filled = true; __syncthreads();
            }
            const int n0 = cb * 32, kr = lane >> 3, c4 = lane & 7;
            f32x4 acc[9];
#pragma unroll
            for (int m = 0; m < 9; ++m) acc[m] = (f32x4){0.f, 0.f, 0.f, 0.f};
            for (int it = 0; it < 16; ++it) { const int k = wave * 128 + it * 8 + kr; const f32x4 wv = *(const f32x4*)(wada + (size_t)k * 6144 + n0 + 4 * c4);
#pragma unroll
                for (int m = 0; m < 9; ++m) acc[m] += wv * cl[m * 1024 + k]; }
#pragma unroll
            for (int m = 0; m < 9; ++m)
#pragma unroll
                for (int i = 0; i < 4; ++i) { float v = acc[m][i]; v += __shfl_xor(v, 8); v += __shfl_xor(v, 16); v += __shfl_xor(v, 32); acc[m][i] = v; }
            if (kr == 0) {
#pragma unroll
                for (int m = 0; m < 9; ++m) *(LAS f32x4*)(red + (wave * 9 + m) * 32 + 4 * c4) = acc[m]; }
            __syncthreads();
            if (tid < 288) { const int m = tid >> 5, cc = tid & 31; float s = bada[n0 + cc];
#pragma unroll
                for (int w = 0; w < 8; ++w) s += red[(w * 9 + m) * 32 + cc];
                mod[(size_t)m * 6144 + n0 + cc] = s; }
            __syncthreads();
        }
        __syncthreads();
    }
    if (vcu == (G > 200 ? 200 : 0)) {
        float* rope = (float*)(ws + WS_ROPE);
        for (int i = tid; i < 1024; i += NTHR) { const int pos = i >> 4, j = i & 15;
            const float freq = 1.0f / powf(10000.0f, (float)j * (1.0f / 16.0f)); const float angf = (float)pos * freq; const double ang = (double)angf;
            const double nq = __builtin_rint(ang * 0.63661977236758134308); const double r = __builtin_fma(-nq, 1.5707963267948966192, ang) - nq * 6.123233995736766e-17; const double r2 = r * r;
            double sn = r * (1.0 + r2 * (-1.0 / 6 + r2 * (1.0 / 120 + r2 * (-1.0 / 5040 + r2 * (1.0 / 362880 + r2 * (-1.0 / 39916800 + r2 * (1.0 / 6227020800.0)))))));
            double cn = 1.0 + r2 * (-0.5 + r2 * (1.0 / 24 + r2 * (-1.0 / 720 + r2 * (1.0 / 40320 + r2 * (-1.0 / 3628800 + r2 * (1.0 / 479001600 + r2 * (-1.0 / 87178291200.0)))))));
            const int q = ((int)nq) & 3; double cc, ss;
            if (q == 0) { cc = cn; ss = sn; } else if (q == 1) { cc = -sn; ss = cn; } else if (q == 2) { cc = -cn; ss = -sn; } else { cc = sn; ss = -cn; }
            rope[2 * i] = (float)cc; rope[2 * i + 1] = (float)ss; }
    }
    {
        bf16* KL = (bf16*)(ws + WS_KL); bf16* VL = (bf16*)(ws + WS_VL);
        const int gt = vcu * NTHR + tid, NGT = G * NTHR;
        for (int i = gt; i < 524288; i += NGT) { const int rowi = i >> 7, c4 = i & 127, b = rowi >> 9, j = rowi & 511;
            const f32x4 v = *(const f32x4*)(a.in[2] + (size_t)i * 4);
            *(v2u*)(KL + ((size_t)b * LKEYS + j) * AW + 4 * c4) = pk4(v); }
        for (int i = gt; i < 524288; i += NGT) { const int j = i & 511, c4 = (i >> 9) & 127, b = i >> 16;
            const f32x4 v = *(const f32x4*)(a.in[3] + ((size_t)(b * 512 + j) * 512 + 4 * c4));
            bf16* vp = VL + ((size_t)b * 512 + 4 * c4) * LKEYS + j;
#pragma unroll
            for (int k = 0; k < 4; ++k) vp[(size_t)k * LKEYS] = (bf16)f2bf(v[k]); }
    }
    {
        LAS float* scr = (LAS float*)(lds + wave * 16384);
        const int gw = vcu * NWAVES + wave, NGW = G * NWAVES;
        constexpr int I_IN = 16 * 128, I_OUT = 16 * 32, I_UP = 16 * 176, I_DN = 44 * 32, NITEMS = I_IN + I_OUT + I_UP + I_DN;
        for (int it = gw; it < NITEMS; it += NGW) {
            int r = it;
            if (r < I_IN) { const int kb = r / 128, nb = r % 128; p0_transpose_item(a.in[9], DM, INC, (bf16*)(ws + WS_WIN), 64 * kb, 32 * nb, 32 * nb, scr, lane); continue; } r -= I_IN;
            if (r < I_OUT) { const int kb = r / 32, nb = r % 32; p0_transpose_item(a.in[18], DM, DM, (bf16*)(ws + WS_WOUT), 64 * kb, 32 * nb, 32 * nb, scr, lane); continue; } r -= I_OUT;
            if (r < I_UP) { const int kb = r / 176, nb = r % 176, n0 = 32 * nb; const int n1 = n0 < FF ? n0 : n0 - FF; const int orow = 256 * (n1 >> 7) + (n0 < FF ? 0 : 128) + (n1 & 127);
                p0_transpose_item(a.in[21], DM, FF2, (bf16*)(ws + WS_WUP), 64 * kb, n0, orow, scr, lane); continue; } r -= I_UP;
            { const int kb = r / 32, nb = r % 32; p0_transpose_item(a.in[24], FF, DM, (bf16*)(ws + WS_WDN), 64 * kb, 32 * nb, 32 * nb, scr, lane); }
        }
    }
}
__device__ __forceinline__ void p1_modulate(const Args& a, int vcu, int G, int lane, int wave) {
    const float* mod = (const float*)(a.ws + WS_MOD); bf16* XM = (bf16*)(a.ws + WS_XM);
    const int gw = vcu * NWAVES + wave, NGW = G * NWAVES;
    for (int row = gw; row < MROWS; row += NGW) {
        const float* xr = xrow_ptr(a.in[0], a.in[1], row); const float* mp = mod + (size_t)mod_index(row) * 6144;
#pragma unroll
        for (int j = 0; j < 4; ++j) { const int c = 4 * (lane + 64 * j); const f32x4 x = *(const f32x4*)(xr + c), sh = *(const f32x4*)(mp + c), sc = *(const f32x4*)(mp + 1024 + c);
            *(v2u*)(XM + (size_t)row * DM + c) = pk4(x * (sc + 1.0f) + sh); }
    }
}
__device__ __forceinline__ void ln_rows(const Args& a, const float* g, const float* bta, bool write_xm, int vcu, int G, int lane, int wave) {
    float* Y = a.out + OUT_Y; const float* mod = (const float*)(a.ws + WS_MOD); bf16* XM = (bf16*)(a.ws + WS_XM);
    const int gw = vcu * NWAVES + wave, NGW = G * NWAVES;
    for (int row = gw; row < MROWS; row += NGW) {
        float* yr = Y + (size_t)row * DM; f32x4 v[4]; float s = 0.f;
#pragma unroll
        for (int j = 0; j < 4; ++j) { v[j] = *(const f32x4*)(yr + 4 * (lane + 64 * j)); s += (v[j][0] + v[j][1]) + (v[j][2] + v[j][3]); }
        const float mean = wave_sum(s) * (1.0f / DM); float s2 = 0.f;
#pragma unroll
        for (int j = 0; j < 4; ++j) { v[j] = v[j] - mean; s2 += (v[j][0] * v[j][0] + v[j][1] * v[j][1]) + (v[j][2] * v[j][2] + v[j][3] * v[j][3]); }
        const float rstd = 1.0f / sqrtf(wave_sum(s2) * (1.0f / DM) + LN_EPS);
        const float* mp = mod + (size_t)mod_index(row) * 6144;
#pragma unroll
        for (int j = 0; j < 4; ++j) { const int c = 4 * (lane + 64 * j); const f32x4 x1 = v[j] * rstd * *(const f32x4*)(g + c) + *(const f32x4*)(bta + c);
            *(f32x4*)(yr + c) = x1;
            if (write_xm) { const f32x4 sh = *(const f32x4*)(mp + 3072 + c), sc = *(const f32x4*)(mp + 4096 + c); *(v2u*)(XM + (size_t)row * DM + c) = pk4(x1 * (sc + 1.0f) + sh); } }
    }
}
__device__ __forceinline__ void conv_gate(const Args& a, int vcu, int G, int tid) {
    const bf16* H = (const bf16*)(a.ws + WS_H); bf16* Gt = (bf16*)(a.ws + WS_G); const float* cw = a.in[22]; const float* cb = a.in[23];
    const int gt = vcu * NTHR + tid, NGT = G * NTHR; constexpr int PER_ROW = 22 * 32;
    for (int i = gt; i < MROWS * PER_ROW; i += NGT) {
        const int row = i / PER_ROW, r2 = i % PER_ROW, pn = r2 >> 5, jj = (r2 & 31) * 4;
        const int t = row < NCTX ? (row & 255) : ((row - NCTX) & 1023), L = row < NCTX ? CSEQ : LSEQ;
        const bool hp = t > 0, hn = t < L - 1;
        const int ca = 128 * pn + jj, cu = FF + ca;
        const bf16* hp0 = H + (size_t)row * FF2 + 256 * pn + jj;
        const v2u z = (v2u){0u, 0u};
        const v2u a0 = hp ? *(const v2u*)(hp0 - FF2) : z, a1 = *(const v2u*)hp0, a2 = hn ? *(const v2u*)(hp0 + FF2) : z;
        const v2u u0 = hp ? *(const v2u*)(hp0 - FF2 + 128) : z, u1 = *(const v2u*)(hp0 + 128), u2 = hn ? *(const v2u*)(hp0 + FF2 + 128) : z;
        const f32x4 wa0 = *(const f32x4*)(cw + ca), wa1 = *(const f32x4*)(cw + FF2 + ca), wa2 = *(const f32x4*)(cw + 2 * FF2 + ca), ba = *(const f32x4*)(cb + ca);
        const f32x4 wu0 = *(const f32x4*)(cw + cu), wu1 = *(const f32x4*)(cw + FF2 + cu), wu2 = *(const f32x4*)(cw + 2 * FF2 + cu), bu = *(const f32x4*)(cb + cu);
        const f32x4 A0 = (f32x4){bflo(a0.x), bfhi(a0.x), bflo(a0.y), bfhi(a0.y)}, A1 = (f32x4){bflo(a1.x), bfhi(a1.x), bflo(a1.y), bfhi(a1.y)}, A2 = (f32x4){bflo(a2.x), bfhi(a2.x), bflo(a2.y), bfhi(a2.y)};
        const f32x4 U0 = (f32x4){bflo(u0.x), bfhi(u0.x), bflo(u0.y), bfhi(u0.y)}, U1 = (f32x4){bflo(u1.x), bfhi(u1.x), bflo(u1.y), bfhi(u1.y)}, U2 = (f32x4){bflo(u2.x), bfhi(u2.x), bflo(u2.y), bfhi(u2.y)};
        const f32x4 av = A0 * wa0 + A1 * wa1 + A2 * wa2 + ba, uv = U0 * wu0 + U1 * wu1 + U2 * wu2 + bu; f32x4 gv;
#pragma unroll
        for (int k = 0; k < 4; ++k) gv[k] = siluf_(av[k]) * uv[k];
        *(v2u*)(Gt + (size_t)row * FF + ca) = pk4(gv);
    }
}
__device__ __forceinline__ float calc_lam(const Args& a, int lane) {
    const float s1 = wave_sum(a.in[10][lane] * a.in[11][lane]), s2 = wave_sum(a.in[12][lane] * a.in[13][lane]);
    return expf(s1) - expf(s2) + 0.2f;
}
__device__ __forceinline__ void attn_naive(const Args& a, LAS unsigned char* lds, int vcu, int G, int lane, int wave) {
    unsigned char* ws = a.ws;
    const bf16* Q = (const bf16*)(ws + WS_Q); bf16* MIX = (bf16*)(ws + WS_MIX); const float* attg = a.in[16];
    LAS float* qf = (LAS float*)(lds + wave * 12800);
    LAS float* sc = qf + 128;
    const float lam = calc_lam(a, lane);
    for (int it = vcu; it < 6144; it += G) {
        const int h = it & 3, row = (it >> 2) * 8 + wave; const bool ctx = row < NCTX;
        const int nk = ctx ? CSEQ : LKEYS;
        const bf16 *Kp, *Vp;
        if (ctx) { const int b = row >> 8; Kp = (const bf16*)(ws + WS_KC) + (size_t)b * CSEQ * AW + h * 128; Vp = (const bf16*)(ws + WS_VC) + (size_t)b * CSEQ * AW + h * 128; }
        else { const int b = (row - NCTX) >> 10; Kp = (const bf16*)(ws + WS_KL) + (size_t)b * LKEYS * AW + h * 128; Vp = (const bf16*)(ws + WS_VL) + (size_t)b * LKEYS * AW + h * 128; }
        { const unsigned w = *(const unsigned*)(Q + (size_t)row * AW + h * 128 + 2 * lane); qf[2 * lane] = bflo(w); qf[2 * lane + 1] = bfhi(w); }
        LDS_WAIT(); asm volatile("" ::: "memory");
        float m1 = -3.0e38f, m2 = -3.0e38f;
        for (int j = lane; j < nk; j += 64) {
            const bf16* kp = Kp + (size_t)j * AW; float s1 = 0.f, s2 = 0.f;
#pragma unroll
            for (int c = 0; c < 8; ++c) { const v4u k1 = *(const v4u*)(kp + 8 * c), k2 = *(const v4u*)(kp + 64 + 8 * c);
                const LAS float* q1 = qf + 8 * c; const LAS float* q2 = qf + 64 + 8 * c;
                s1 += bflo(k1.x) * q1[0] + bfhi(k1.x) * q1[1] + bflo(k1.y) * q1[2] + bfhi(k1.y) * q1[3] + bflo(k1.z) * q1[4] + bfhi(k1.z) * q1[5] + bflo(k1.w) * q1[6] + bfhi(k1.w) * q1[7];
                s2 += bflo(k2.x) * q2[0] + bfhi(k2.x) * q2[1] + bflo(k2.y) * q2[2] + bfhi(k2.y) * q2[3] + bflo(k2.z) * q2[4] + bfhi(k2.z) * q2[5] + bflo(k2.w) * q2[6] + bfhi(k2.w) * q2[7]; }
            sc[j] = s1; sc[1536 + j] = s2; m1 = fmaxf(m1, s1); m2 = fmaxf(m2, s2);
        }
        m1 = wave_max(m1); m2 = wave_max(m2);
        float l1 = 0.f, l2 = 0.f;
        for (int j = lane; j < nk; j += 64) { const float p1 = exp2f(sc[j] - m1), p2 = exp2f(sc[1536 + j] - m2); sc[j] = p1; sc[1536 + j] = p2; l1 += p1; l2 += p2; }
        l1 = wave_sum(l1); l2 = wave_sum(l2);
        const float i1 = 1.0f / l1, i2 = lam / l2;
        for (int j = lane; j < nk; j += 64) sc[j] = sc[j] * i1 - sc[1536 + j] * i2;
        LDS_WAIT(); asm volatile("" ::: "memory");
        float o0 = 0.f, o1 = 0.f;
#pragma unroll 8
        for (int j = 0; j < nk; ++j) { const unsigned w = *(const unsigned*)(Vp + (size_t)j * AW + 2 * lane); const float p = sc[j]; o0 += p * bflo(w); o1 += p * bfhi(w); }
        const float ss = wave_sum(o0 * o0 + o1 * o1); const float r = 1.0f / sqrtf(ss * (1.0f / 128.0f) + LN_EPS) * 0.8f;
        *(unsigned*)(MIX + (size_t)row * DM + h * 128 + 2 * lane) = pk2(o0 * r * attg[h * 128 + 2 * lane], o1 * r * attg[h * 128 + 2 * lane + 1]);
        LDS_WAIT(); asm volatile("" ::: "memory");
    }
}
__device__ __forceinline__ void rnn_naive(const Args& a, LAS unsigned char* lds, int vcu, int G, int tid) {
    unsigned char* ws = a.ws;
    const bf16* RQ = (const bf16*)(ws + WS_RQ); const bf16* RI = (const bf16*)(ws + WS_RI); const bf16* RG = (const bf16*)(ws + WS_RG);
    float* OF = (float*)(ws + WS_OF); bf16* MIX = (bf16*)(ws + WS_MIX); const float* rnng = a.in[17];
    LAS float* Fl = (LAS float*)lds;
    LAS float* Kl = Fl + 2048; LAS float* Ql = Kl + 2048; LAS float* Vl = Ql + 2048;
    LAS float* PO = Vl + 2048;
    const int e = tid & 127, qd = tid >> 7;
    for (int it = vcu; it < 96; it += G) {
        const bool ctx = it < 64; const int bi = ctx ? it : it - 64, b = bi >> 2, h = bi & 3;
        const int L = ctx ? CSEQ : LSEQ, row0 = ctx ? b * CSEQ : NCTX + b * LSEQ;
        for (int dir = 0; dir < 2; ++dir) {
            const float* GT = (const float*)(ws + (dir ? WS_GB : WS_GF));
            float S[32];
            if (ctx) {
#pragma unroll
                for (int i = 0; i < 32; ++i) S[i] = 0.f;
            } else { const float* s0 = a.in[4] + ((size_t)(b * 2 + dir) * 4 + h) * 16384;
#pragma unroll
                for (int i = 0; i < 32; ++i) S[i] = s0[(size_t)(32 * qd + i) * 128 + e]; }
            for (int tb = 0; tb < L / 16; ++tb) {
#pragma unroll
                for (int j = 0; j < 4; ++j) { const int idx = tid + NTHR * j, i = idx >> 7, d = idx & 127; const int s = tb * 16 + i, t = dir ? L - 1 - s : s;
                    const size_t o = (size_t)(row0 + t) * AW + h * 128 + d;
                    const float f = __expf(GT[o]); Fl[idx] = f; Kl[idx] = 1.0f - f; Ql[idx] = __uint_as_float((unsigned)RQ[o] << 16); Vl[idx] = __uint_as_float((unsigned)RI[o] << 16); }
                __syncthreads();
#pragma unroll 1
                for (int i = 0; i < 16; ++i) { const float v = Vl[i * 128 + e]; float po = 0.f;
#pragma unroll
                    for (int dd = 0; dd < 32; ++dd) { const int d = 32 * qd + dd; S[dd] = Fl[i * 128 + d] * S[dd] + Kl[i * 128 + d] * v; po += S[dd] * Ql[i * 128 + d]; }
                    PO[(i * 4 + qd) * 128 + e] = po; }
                __syncthreads();
                { const int i = tid >> 5, e4 = (tid & 31) * 4; const int s = tb * 16 + i, t = dir ? L - 1 - s : s; const size_t o = (size_t)(row0 + t) * AW + h * 128 + e4;
                    f32x4 ov = *(const LAS f32x4*)(PO + (i * 4 + 0) * 128 + e4) + *(const LAS f32x4*)(PO + (i * 4 + 1) * 128 + e4) + *(const LAS f32x4*)(PO + (i * 4 + 2) * 128 + e4) + *(const LAS f32x4*)(PO + (i * 4 + 3) * 128 + e4);
                    if (dir == 0) *(f32x4*)(OF + o) = ov;
                    else { ov += *(const f32x4*)(OF + o);
                        float ss = (ov[0] * ov[0] + ov[1] * ov[1]) + (ov[2] * ov[2] + ov[3] * ov[3]);
                        ss += __shfl_xor(ss, 1); ss += __shfl_xor(ss, 2); ss += __shfl_xor(ss, 4); ss += __shfl_xor(ss, 8); ss += __shfl_xor(ss, 16);
                        const float r = 1.0f / sqrtf(ss * (1.0f / 128.0f) + LN_EPS); const f32x4 g = *(const f32x4*)(rnng + h * 128 + e4); const v2u gw = *(const v2u*)(RG + o);
                        f32x4 res; res[0] = ov[0] * r * g[0] * bflo(gw.x); res[1] = ov[1] * r * g[1] * bfhi(gw.x); res[2] = ov[2] * r * g[2] * bflo(gw.y); res[3] = ov[3] * r * g[3] * bfhi(gw.y);
                        *(v2u*)(MIX + (size_t)(row0 + t) * DM + AW + h * 128 + e4) = pk4(res); } }
            }
            if (ctx) { float* so = a.out + OUT_S + ((size_t)(b * 2 + dir) * 4 + h) * 16384;
#pragma unroll
                for (int i = 0; i < 32; ++i) so[(size_t)(32 * qd + i) * 128 + e] = S[i]; }
            __threadfence(); __syncthreads();
        }
    }
}
constexpr int RN_QE = 0, RN_KD = 4352, RN_KET = 8704, RN_VT = 8704 + 5120, RN_DEC = 8704 + 10240, RN_BUF = 8704 + 10240 + 512;
struct RnnRaw { float lg[4]; unsigned short q[4], v[4]; };
__device__ __forceinline__ void rnn_load_raw(RnnRaw& R, const float* GT, const bf16* RQ, const bf16* RI, int row0, int L, int dir, int c, int h, int d, int sg) {
#pragma unroll
    for (int i = 0; i < 4; ++i) { const int s = c * 16 + 4 * sg + i, t = dir ? L - 1 - s : s; const size_t o = (size_t)(row0 + t) * AW + h * 128 + d;
        R.lg[i] = GT[o]; R.q[i] = RQ[o]; R.v[i] = RI[o]; }
}
__device__ __forceinline__ void rnn_prep(const RnnRaw& R, LAS unsigned char* buf, int d, int sg, int lane) {
    float cum[4]; cum[0] = R.lg[0]; cum[1] = cum[0] + R.lg[1]; cum[2] = cum[1] + R.lg[2]; cum[3] = cum[2] + R.lg[3];
    const float T = cum[3];
    const float t1 = __shfl_up(T, 16), t2 = __shfl_up(T, 32), t3 = __shfl_up(T, 48);
    const float off = (sg >= 1 ? t1 : 0.f) + (sg >= 2 ? t2 : 0.f) + (sg >= 3 ? t3 : 0.f);
    const float last = __shfl(off + T, 48 + (lane & 15));
    const int pos = 32 * (d >> 5) + 8 * ((d & 15) >> 2) + 4 * ((d >> 4) & 1) + (d & 3);
    unsigned ke[4], vv[4];
#pragma unroll
    for (int i = 0; i < 4; ++i) { const float cm = cum[i] + off; const float k = 1.0f - __expf(R.lg[i]);
        const float qe = __uint_as_float((unsigned)R.q[i] << 16) * __expf(cm), kd = k * __expf(-cm); ke[i] = f2bf(k * __expf(last - cm)); vv[i] = R.v[i];
        const int s = 4 * sg + i;
        *(LAS unsigned short*)(buf + RN_QE + s * 272 + pos * 2) = (unsigned short)f2bf(qe);
        *(LAS unsigned short*)(buf + RN_KD + s * 272 + pos * 2) = (unsigned short)f2bf(kd); }
    *(LAS v2u*)(buf + RN_KET + d * 40 + sg * 8) = (v2u){ke[0] | (ke[1] << 16), ke[2] | (ke[3] << 16)};
    *(LAS v2u*)(buf + RN_VT + d * 40 + sg * 8) = (v2u){vv[0] | (vv[1] << 16), vv[2] | (vv[3] << 16)};
    if (sg == 3) *(LAS float*)(buf + RN_DEC + d * 4) = __expf(last);
}
__device__ __forceinline__ void rnn_item(const Args& a, LAS unsigned char* lds, int item, int tid, int lane, int wave) {
    unsigned char* ws = a.ws;
    const bf16* RQ = (const bf16*)(ws + WS_RQ); const bf16* RI = (const bf16*)(ws + WS_RI); const bf16* RG = (const bf16*)(ws + WS_RG);
    float* OF = (float*)(ws + WS_OF); bf16* MIX = (bf16*)(ws + WS_MIX); const float* rnng = a.in[17];
    const int dl = lane & 15, sg = lane >> 4, d = 16 * wave + dl;
    const int fr = lane & 15, g = lane >> 4, e = 16 * wave + fr;
    {
        const bool ctx = item < 64; const int bi = ctx ? item : item - 64, b = bi >> 2, h = bi & 3;
        const int L = ctx ? CSEQ : LSEQ, row0 = ctx ? b * CSEQ : NCTX + b * LSEQ, NC = L / 16;
        for (int dir = 0; dir < 2; ++dir) {
            const float* GT = (const float*)(ws + (dir ? WS_GB : WS_GF));
            f32x4 acc[8];
            if (ctx) {
#pragma unroll
                for (int i = 0; i < 8; ++i) acc[i] = (f32x4){0.f, 0.f, 0.f, 0.f};
            } else { const float* s0 = a.in[4] + ((size_t)(b * 2 + dir) * 4 + h) * 16384;
#pragma unroll
                for (int i = 0; i < 8; ++i)
#pragma unroll
                    for (int r = 0; r < 4; ++r) acc[i][r] = s0[(size_t)(16 * i + 4 * g + r) * 128 + e]; }
            RnnRaw R; rnn_load_raw(R, GT, RQ, RI, row0, L, dir, 0, h, d, sg);
            for (int c = 0; c < NC; ++c) {
                LAS unsigned char* buf = lds + (c & 1) * RN_BUF;
                rnn_prep(R, buf, d, sg, lane);
                if (c + 1 < NC) rnn_load_raw(R, GT, RQ, RI, row0, L, dir, c + 1, h, d, sg);
                __syncthreads();
                bf16x8 qf[4], kf[4];
#pragma unroll
                for (int kk = 0; kk < 4; ++kk) { qf[kk] = *(const LAS bf16x8*)(buf + RN_QE + fr * 272 + kk * 64 + g * 16); kf[kk] = *(const LAS bf16x8*)(buf + RN_KD + fr * 272 + kk * 64 + g * 16); }
                const v2u vw = *(const LAS v2u*)(buf + RN_VT + e * 40 + g * 8);
                const bf16x8 vb = __builtin_bit_cast(bf16x8, (v4u){vw.x, vw.y, 0u, 0u});
                f32x4 pT = (f32x4){0.f, 0.f, 0.f, 0.f};
#pragma unroll
                for (int kk = 0; kk < 4; ++kk) pT = __builtin_amdgcn_mfma_f32_16x16x32_bf16(kf[kk], qf[kk], pT, 0, 0, 0);
#pragma unroll
                for (int r = 0; r < 4; ++r) pT[r] = (4 * g + r <= fr) ? pT[r] : 0.f;
                const bf16x8 pa = __builtin_bit_cast(bf16x8, (v4u){pk2(pT[0], pT[1]), pk2(pT[2], pT[3]), 0u, 0u});
                f32x4 o = __builtin_amdgcn_mfma_f32_16x16x32_bf16(pa, vb, (f32x4){0.f, 0.f, 0.f, 0.f}, 0, 0, 0);
#pragma unroll
                for (int kk = 0; kk < 4; ++kk) {
                    const bf16x8 sb = __builtin_bit_cast(bf16x8, (v4u){pk2(acc[2 * kk][0], acc[2 * kk][1]), pk2(acc[2 * kk][2], acc[2 * kk][3]), pk2(acc[2 * kk + 1][0], acc[2 * kk + 1][1]), pk2(acc[2 * kk + 1][2], acc[2 * kk + 1][3])});
                    o = __builtin_amdgcn_mfma_f32_16x16x32_bf16(qf[kk], sb, o, 0, 0, 0); }
#pragma unroll
                for (int i = 0; i < 8; ++i) { const f32x4 dc = *(const LAS f32x4*)(buf + RN_DEC + (16 * i + 4 * g) * 4);
                    const v2u kw = *(const LAS v2u*)(buf + RN_KET + (16 * i + fr) * 40 + g * 8); const bf16x8 ka = __builtin_bit_cast(bf16x8, (v4u){kw.x, kw.y, 0u, 0u});
                    acc[i] = __builtin_amdgcn_mfma_f32_16x16x32_bf16(ka, vb, acc[i] * dc, 0, 0, 0); }
#pragma unroll
                for (int r = 0; r < 4; ++r) { const int s = c * 16 + 4 * g + r, t = dir ? L - 1 - s : s; float* op = OF + (size_t)(row0 + t) * AW + h * 128 + e;
                    if (dir == 0) *op = o[r]; else *op += o[r]; }
            }
            if (ctx) { float* so = a.out + OUT_S + ((size_t)(b * 2 + dir) * 4 + h) * 16384;
#pragma unroll
                for (int i = 0; i < 8; ++i)
#pragma unroll
                    for (int r = 0; r < 4; ++r) so[(size_t)(16 * i + 4 * g + r) * 128 + e] = acc[i][r]; }
            __threadfence(); __syncthreads();
        }
        for (int t = wave; t < L; t += NWAVES) { const size_t o = (size_t)(row0 + t) * AW + h * 128 + 2 * lane;
            const float2 ov = *(const float2*)(OF + o); const float ss = wave_sum(ov.x * ov.x + ov.y * ov.y); const float r = 1.0f / sqrtf(ss * (1.0f / 128.0f) + LN_EPS);
            const unsigned gw = *(const unsigned*)(RG + o); const float2 gn = *(const float2*)(rnng + h * 128 + 2 * lane);
            *(unsigned*)(MIX + (size_t)(row0 + t) * DM + AW + h * 128 + 2 * lane) = pk2(ov.x * r * gn.x * bflo(gw), ov.y * r * gn.y * bfhi(gw)); }
        __syncthreads();
    }
}
typedef float f32x16 __attribute__((ext_vector_type(16)));
constexpr int AT_K = 0, AT_V = 32768, AT_TILE = 16384;
__device__ __forceinline__ int crow16(int r, int hi) { return (r & 3) + 8 * (r >> 2) + 4 * hi; }
__device__ __forceinline__ void attn_unit(const Args& a, LAS unsigned char* lds, int unit, float lam, int tid, int lane, int wave) {
    unsigned char* ws = a.ws;
    const bool ctx = unit >= 256; const int ui = ctx ? unit - 256 : unit;
    const int qb = ctx ? (ui & 1) : (ui & 7), bh = ctx ? (ui >> 1) : (ui >> 3), b = bh >> 2, h = bh & 3;
    const int nk = ctx ? CSEQ : LKEYS, NT = nk / 64, row0 = (ctx ? b * CSEQ : NCTX + b * LSEQ) + qb * 128;
    const bf16* Kp = (const bf16*)(ws + (ctx ? WS_KC : WS_KL)) + (size_t)b * nk * AW + h * 128;
    const bf16* Vp = (const bf16*)(ws + (ctx ? WS_VC : WS_VL)) + (size_t)bh * 128 * nk;
    const int rg = wave & 3, map = wave >> 2, r32 = lane & 31, hi = lane >> 5;
    const int qrow = row0 + rg * 32 + r32;
    bf16x8 qf[4];
    { const bf16* qp = (const bf16*)(ws + WS_Q) + (size_t)qrow * AW + h * 128 + map * 64 + 8 * hi;
#pragma unroll
      for (int ks = 0; ks < 4; ++ks) qf[ks] = *(const bf16x8*)(qp + 16 * ks); }
    const int krow = tid >> 4, kch = tid & 15, ve = tid >> 3, vch = tid & 7, vxx = (ve >> 1) & 15;
    const unsigned ksrc = (unsigned)(krow * AW + kch * 8), vsrc = (unsigned)(ve * nk + vch * 8);
    const int kdst = AT_K + 256 * krow + 16 * (kch ^ (((krow & 3) << 2) | ((krow >> 2) & 3))), vdst = AT_V + 128 * ve + 16 * (vch ^ (vxx >> 1)); const bool vswap = vxx & 1;
    v4u kr[2], vr[2];
#define AT_LOAD(t) do { _Pragma("unroll") for (int i_ = 0; i_ < 2; ++i_) { kr[i_] = *(const v4u*)(Kp + ksrc + (size_t)((t) * 64 + 32 * i_) * AW); vr[i_] = *(const v4u*)(Vp + vsrc + (size_t)(64 * i_) * nk + (t) * 64); } } while (0)
#define AT_STORE(bufo) do { _Pragma("unroll") for (int i_ = 0; i_ < 2; ++i_) { *(LAS v4u*)(lds + (bufo) + kdst + 8192 * i_) = kr[i_]; \
        const v4u vv_ = vswap ? (v4u){vr[i_].z, vr[i_].w, vr[i_].x, vr[i_].y} : vr[i_]; *(LAS v4u*)(lds + (bufo) + vdst + 8192 * i_) = vv_; } } while (0)
    int koff[4];
    { const int x = ((r32 & 3) << 2) | ((r32 >> 2) & 3);
#pragma unroll
      for (int ks = 0; ks < 4; ++ks) koff[ks] = AT_K + 256 * r32 + 16 * ((8 * map + 2 * ks + hi) ^ x); }
    const int vbase = AT_V + 128 * r32, vx = 8 * ((r32 >> 1) & 15);
    f32x16 O[4];
#pragma unroll
    for (int eb = 0; eb < 4; ++eb)
#pragma unroll
        for (int r = 0; r < 16; ++r) O[eb][r] = 0.f;
    float m_run = -1.0e30f, l_run = 0.f;
    AT_LOAD(0); AT_STORE(0);
    if (NT > 1) AT_LOAD(1);
    __syncthreads();
    for (int t = 0; t < NT; ++t) {
        const int cur = (t & 1) * AT_TILE;
        f32x16 st[2];
#pragma unroll
        for (int mb = 0; mb < 2; ++mb) {
#pragma unroll
            for (int r = 0; r < 16; ++r) st[mb][r] = 0.f;
#pragma unroll
            for (int ks = 0; ks < 4; ++ks) { const bf16x8 kf = *(const LAS bf16x8*)(lds + cur + koff[ks] + 8192 * mb); st[mb] = __builtin_amdgcn_mfma_f32_32x32x16_bf16(kf, qf[ks], st[mb], 0, 0, 0); } }
        if (t + 1 < NT) { AT_STORE(AT_TILE - cur); if (t + 2 < NT) AT_LOAD(t + 2); }
        float mx = st[0][0];
#pragma unroll
        for (int r = 1; r < 16; ++r) mx = fmaxf(mx, st[0][r]);
#pragma unroll
        for (int r = 0; r < 16; ++r) mx = fmaxf(mx, st[1][r]);
        mx = fmaxf(mx, __shfl_xor(mx, 32));
        if (__any(mx > m_run)) { const float mn = fmaxf(m_run, mx), f = __builtin_amdgcn_exp2f(m_run - mn); m_run = mn; l_run *= f;
#pragma unroll
            for (int eb = 0; eb < 4; ++eb)
#pragma unroll
                for (int r = 0; r < 16; ++r) O[eb][r] *= f; }
        bf16x8 pf[2][2]; float ls = 0.f;
#pragma unroll
        for (int mb = 0; mb < 2; ++mb) {
#pragma unroll
            for (int r = 0; r < 16; ++r) { st[mb][r] = __builtin_amdgcn_exp2f(st[mb][r] - m_run); ls += st[mb][r]; }
#pragma unroll
            for (int sp = 0; sp < 2; ++sp) pf[mb][sp] = __builtin_bit_cast(bf16x8, (v4u){pk2(st[mb][8 * sp], st[mb][8 * sp + 1]), pk2(st[mb][8 * sp + 2], st[mb][8 * sp + 3]), pk2(st[mb][8 * sp + 4], st[mb][8 * sp + 5]), pk2(st[mb][8 * sp + 6], st[mb][8 * sp + 7])}); }
        l_run += ls;
#pragma unroll
        for (int eb = 0; eb < 4; ++eb) { __builtin_amdgcn_sched_barrier(0);
#pragma unroll
            for (int mb = 0; mb < 2; ++mb)
#pragma unroll
                for (int sp = 0; sp < 2; ++sp) { const int u1 = 8 * mb + 4 * sp + hi;
                    const v2u lo = *(const LAS v2u*)(lds + cur + vbase + 4096 * eb + ((8 * u1) ^ vx)), hv = *(const LAS v2u*)(lds + cur + vbase + 4096 * eb + ((8 * (u1 + 2)) ^ vx));
                    O[eb] = __builtin_amdgcn_mfma_f32_32x32x16_bf16(__builtin_bit_cast(bf16x8, (v4u){lo.x, lo.y, hv.x, hv.y}), pf[mb][sp], O[eb], 0, 0, 0); } }
        __syncthreads();
    }
#undef AT_LOAD
#undef AT_STORE
    l_run += __shfl_xor(l_run, 32);
    LAS float* ex = (LAS float*)lds + (size_t)rg * 4096 + lane;
    if (map == 1) { const float sc = lam / l_run;
#pragma unroll
        for (int eb = 0; eb < 4; ++eb)
#pragma unroll
            for (int r = 0; r < 16; ++r) ex[(eb * 16 + r) * 64] = O[eb][r] * sc; }
    __syncthreads();
    if (map == 0) { const float il = 1.0f / l_run; float ss = 0.f;
#pragma unroll
        for (int eb = 0; eb < 4; ++eb)
#pragma unroll
            for (int r = 0; r < 16; ++r) { const float v = O[eb][r] * il - ex[(eb * 16 + r) * 64]; O[eb][r] = v; ss += v * v; }
        ss += __shfl_xor(ss, 32);
        const float rn = 0.8f / sqrtf(ss * (1.0f / 128.0f) + LN_EPS); const float* ag = a.in[16] + h * 128;
        bf16* mp = (bf16*)(ws + WS_MIX) + (size_t)qrow * DM + h * 128;
#pragma unroll
        for (int eb = 0; eb < 4; ++eb)
#pragma unroll
            for (int rq = 0; rq < 4; ++rq) { const int e0 = 32 * eb + 8 * rq + 4 * hi; const f32x4 gn = *(const f32x4*)(ag + e0);
                f32x4 o4; o4[0] = O[eb][4 * rq] * rn * gn[0]; o4[1] = O[eb][4 * rq + 1] * rn * gn[1]; o4[2] = O[eb][4 * rq + 2] * rn * gn[2]; o4[3] = O[eb][4 * rq + 3] * rn * gn[3];
                *(v2u*)(mp + e0) = pk4(o4); } }
    __syncthreads();
}
__device__ __forceinline__ void mixer_phase(const Args& a, LAS unsigned char* lds, int tid, int lane, int wave) {
    unsigned* ctr = (unsigned*)(a.ws + WS_CTL) + 256;
    volatile LAS unsigned* slot = (volatile LAS unsigned*)(lds + MISC_OFF + 64);
    const float lam = calc_lam(a, lane);
    for (;;) {
        if (tid == 0) slot[0] = __hip_atomic_fetch_add(ctr, 1u, __ATOMIC_RELAXED, __HIP_MEMORY_SCOPE_AGENT);
        __syncthreads();
        const int it = (int)slot[0];
        __syncthreads();
        if (it >= 480) break;
        if (it < 32) rnn_item(a, lds, 64 + it, tid, lane, wave);
        else if (it < 288) attn_unit(a, lds, it - 32, lam, tid, lane, wave);
        else if (it < 352) rnn_item(a, lds, it - 288, tid, lane, wave);
        else attn_unit(a, lds, 256 + (it - 352), lam, tid, lane, wave);
    }
}
#ifndef MK_N_LAUNCHES
#define MK_N_LAUNCHES 1
#endif
constexpr int NPH = 10;
__global__ void __launch_bounds__(NTHR, 2) fwd(Args args) {
    extern __shared__ __attribute__((aligned(16))) unsigned char lds_[];
    LAS unsigned char* lds = (LAS unsigned char*)lds_;
    const int tid = threadIdx.x, lane = tid & 63, wave = __builtin_amdgcn_readfirstlane(tid >> 6);
    const int G = gridDim.x, bx = blockIdx.x, vcu = (G % 8 == 0) ? (bx % 8) * (G / 8) + bx / 8 : bx;
    unsigned char* ws = args.ws;
    for (int u = tid; u < (LDS_BYTES - RING_BYTES) / 4; u += NTHR) ((LAS unsigned*)(lds + RING_BYTES))[u] = 0u;
    __syncthreads();
    const int lo = args.ph_lo, hi = args.ph_hi;
    XcdBarrier bar; bar.bar = (unsigned*)(ws + WS_CTL) + CW_BAR; bar.x = 0; bar.st = nullptr;
    if (hi - lo > 1) bar = xcd_barrier_post((unsigned*)(ws + WS_CTL) + CW_BAR, (volatile LAS unsigned*)(lds + MISC_OFF) + 8);
#define IN(k) (lo <= (k) && (k) < hi)
#define SEAM(k) do { if (IN(k) && IN((k) + 1)) xcd_barrier(bar); } while (0)
    float* mod = (float*)(ws + WS_MOD);
    if (IN(0)) { p0_prologue(args, lds, vcu, G, tid, lane, wave); SEAM(0); }
    if (IN(1)) { p1_modulate(args, vcu, G, lane, wave); SEAM(1); }
    if (IN(2)) {
        pg8::Gemm g{(const bf16*)(ws + WS_XM), (const bf16*)(ws + WS_WIN), MROWS, INC, DM}; pg8::StaticOrder S; S.init(MROWS, INC, G, bx);
        Epi1 E{(bf16*)(ws + WS_Q), (bf16*)(ws + WS_KC), (bf16*)(ws + WS_VC), (bf16*)(ws + WS_KL), (bf16*)(ws + WS_VL), (bf16*)(ws + WS_RQ), (bf16*)(ws + WS_RI), (bf16*)(ws + WS_RG),
               (float*)(ws + WS_GF), (float*)(ws + WS_GB), args.out + OUT_K, args.out + OUT_V, (const float*)(ws + WS_ROPE), args.in[14], args.in[15]};
        pg8::gemm_phase<Epi1, pg8::StaticOrder, true, true>(lds, g, S, E);
        SEAM(2);
    }
    if (IN(3)) {
        mixer_phase(args, lds, tid, lane, wave);
        SEAM(3);
    }
    if (IN(4)) {
        pg8::Gemm g{(const bf16*)(ws + WS_MIX), (const bf16*)(ws + WS_WOUT), MROWS, DM, DM}; pg8::StaticOrder S; S.init(MROWS, DM, G, bx);
        EpiRes E{args.in[0], args.in[1], nullptr, args.out + OUT_Y, mod + 2048};
        pg8::gemm_phase<EpiRes, pg8::StaticOrder, true, true>(lds, g, S, E);
        SEAM(4);
    }
    if (IN(5)) { ln_rows(args, args.in[19], args.in[20], true, vcu, G, lane, wave); SEAM(5); }
    if (IN(6)) {
        pg8::Gemm g{(const bf16*)(ws + WS_XM), (const bf16*)(ws + WS_WUP), MROWS, FF2, DM}; pg8::StaticOrder S; S.init(MROWS, FF2, G, bx);
        EpiH E{(bf16*)(ws + WS_H)};
        pg8::gemm_phase<EpiH, pg8::StaticOrder, true, true>(lds, g, S, E);
        SEAM(6);
    }
    if (IN(7)) { conv_gate(args, vcu, G, tid); SEAM(7); }
    if (IN(8)) {
        pg8::Gemm g{(const bf16*)(ws + WS_G), (const bf16*)(ws + WS_WDN), MROWS, DM, FF}; pg8::StaticOrder S; S.init(MROWS, DM, G, bx);
        EpiRes E{args.in[0], args.in[1], args.out + OUT_Y, args.out + OUT_Y, mod + 5120};
        pg8::gemm_phase<EpiRes, pg8::StaticOrder, true, true>(lds, g, S, E);
        SEAM(8);
    }
    if (IN(9)) { ln_rows(args, args.in[25], args.in[26], false, vcu, G, lane, wave); }
#undef IN
#undef SEAM
}

extern "C" void kernel_launch(void* const* d_in, const int* in_sizes, int n_in, void* d_out, int out_size, void* d_ws, size_t ws_size, hipStream_t stream) {
    static int grid = 0;
    if (grid == 0) {
        if (n_in != 27 || out_size != 18874368 || ws_size < WS_END) { fprintf(stderr, "kernel_launch: unexpected shapes (n_in %d, out %d, ws %zu)\n", n_in, out_size, ws_size); grid = -1; return; }
        int dev = 0, cus = 0, per_cu = 0;
        if (hipGetDevice(&dev) != hipSuccess || hipDeviceGetAttribute(&cus, hipDeviceAttributeMultiprocessorCount, dev) != hipSuccess) { grid = -1; return; }
        if (hipFuncSetAttribute((const void*)fwd, hipFuncAttributeMaxDynamicSharedMemorySize, LDS_BYTES) != hipSuccess) { fprintf(stderr, "kernel_launch: hipFuncSetAttribute failed\n"); grid = -1; return; }
        if (hipOccupancyMaxActiveBlocksPerMultiprocessor(&per_cu, (const void*)fwd, NTHR, LDS_BYTES) != hipSuccess || per_cu < 1) { fprintf(stderr, "kernel_launch: occupancy query reports %d\n", per_cu); per_cu = 1; }
        (void)hipGetLastError();
        grid = cus;
    }
    if (grid < 0) return;
    (void)hipMemsetAsync((char*)d_ws + WS_CTL, 0, CTL_ZERO_BYTES, stream);
    Args a{};
    for (int i = 0; i < 27; ++i) a.in[i] = (const float*)d_in[i];
    a.out = (float*)d_out; a.ws = (unsigned char*)d_ws;
    if (MK_N_LAUNCHES == 1) { a.ph_lo = 0; a.ph_hi = NPH; hipLaunchKernelGGL(fwd, dim3(grid), dim3(NTHR), LDS_BYTES, stream, a); }
    else for (int li = 0; li < NPH; ++li) { a.ph_lo = li; a.ph_hi = li + 1; hipLaunchKernelGGL(fwd, dim3(grid), dim3(NTHR), LDS_BYTES, stream, a); }
}
```

```cpp
#include <hip/hip_runtime.h>
#include <cstdio>
#include <cstdint>
#define MK_N_LAUNCHES 1
namespace pg8 {
#define PG8_LAS __attribute__((address_space(3)))
typedef unsigned short bf16_t;
typedef short bf16x8 __attribute__((ext_vector_type(8)));
typedef float f32x4 __attribute__((ext_vector_type(4)));
typedef unsigned u32x4 __attribute__((ext_vector_type(4)));
constexpr int BM = 256, BK = 64, HALF = 128, HTB = HALF * BK * 2  , STAGE_BYTES = 8 * HTB, NXCD = 8, WGM = 8;

__host__ __device__ __forceinline__ int lds_byte(int r, int c) { const int st = (r >> 4) * 2 + (c >> 5), rr = r & 15, cc = c & 31, ob = rr * 64 + cc * 2; return st * 1024 + (ob ^ (((ob >> 9) & 1) << 5)); }
__host__ __device__ __forceinline__ void stage_rc(int b, int& R, int& C) { const int st = b / 1024, sb = b % 1024, swz = sb ^ (((sb >> 9) & 1) << 5); R = (st >> 1) * 16 + swz / 64; C = (st & 1) * 32 + (swz % 64) / 2; }
__host__ __device__ __forceinline__ int perm32(int rho) { const int n = rho >> 4, i = rho & 15; return 8 * (i >> 2) + 4 * n + (i & 3); }

struct Unit { int pm, pn; };
struct Gemm { const bf16_t* A; const bf16_t* Bt; int M, N, K; };

struct StaticOrder {
    int nM, nN, nwg, G, c;
    __host__ __device__ void init(int M, int N, int G_, int c_) { nM = M / BM; nN = N / BM; nwg = nM * nN; G = G_; c = c_; }
    __host__ __device__ bool next(int i, Unit& u) const {
        const long L = (long)i * G + c; if (L >= nwg) return false;
        int wgid = (int)L; { const int q = nwg / NXCD, r = nwg % NXCD, xcd = wgid % NXCD, off = wgid / NXCD; wgid = (xcd < r ? xcd * (q + 1) : r * (q + 1) + (xcd - r) * q) + off; }
        const int nig = WGM * nN, gid = wgid / nig, fm = gid * WGM, gsz = (nM - fm) < WGM ? (nM - fm) : WGM;
        u.pm = fm + ((wgid % nig) % gsz); u.pn = (wgid % nig) / gsz; return true;
    }
    __device__ __forceinline__ void a_ready(const Unit&) const {}
    __device__ __forceinline__ void done(const Unit&) const {}
};

__device__ __forceinline__ unsigned cvt_pk_bf16(float lo, float hi) { unsigned r; asm volatile("v_cvt_pk_bf16_f32 %0, %1, %2" : "=v"(r) : "v"(lo), "v"(hi)); return r; }
typedef float f32x2 __attribute__((ext_vector_type(2)));
template <class Epi, class Sched, bool ALIGN_EPI = false, bool SP2 = false>
__device__ __forceinline__ void gemm_phase(PG8_LAS unsigned char* lds, const Gemm g, const Sched& S, const Epi& E) {
    const int tid = threadIdx.x, wid = __builtin_amdgcn_readfirstlane(tid >> 6), lane = tid & 63, wr = wid >> 2, wc = wid & 3, fr = lane & 15, fq = lane >> 4;
    const int K = g.K, nt = K / BK;
    unsigned voffA[2], voffB[2];
#pragma unroll
    for (int i = 0; i < 2; ++i) { int R, C; stage_rc(tid * 16 + i * 8192, R, C); const int Rb = Epi::PERM ? ((R & ~31) + perm32(R & 31)) : R;
        voffA[i] = (unsigned)(R * K + C) * 2u; voffB[i] = (unsigned)(Rb * K + C) * 2u; }
    const size_t kstep = (size_t)(BK * 2);
    const size_t hstep = (size_t)HALF * K * 2;
    const size_t tstep = 2 * hstep;
    const unsigned ldsw = (unsigned)wid * 1024u;
    const int aoff = lds_byte(wr * 64 + fr, fq * 8), boff = lds_byte(wc * 32 + fr, fq * 8);
#define PG8_SA(b, h) (((b) * 2 + (h)) * HTB)
#define PG8_SB(b, h) ((4 + (b) * 2 + (h)) * HTB)
#define PG8_STAGE(bufoff, gbase, voff) do { _Pragma("unroll") for (int _i = 0; _i < 2; ++_i) \
        __builtin_amdgcn_global_load_lds((const unsigned*)((const char*)(gbase) + (voff)[_i]), (PG8_LAS unsigned*)(lds + (bufoff) + ldsw + _i * 8192), 16, 0, 0); } while (0)
#define PG8_LDA(dst, b, h) do { _Pragma("unroll") for (int m = 0; m < 4; ++m) _Pragma("unroll") for (int k = 0; k < 2; ++k) dst[m][k] = *(const PG8_LAS bf16x8*)(lds + PG8_SA(b, h) + aoff + m * 2048 + k * 1024); } while (0)
#define PG8_LDB(dst, b, h) do { _Pragma("unroll") for (int n = 0; n < 2; ++n) _Pragma("unroll") for (int k = 0; k < 2; ++k) dst[n][k] = *(const PG8_LAS bf16x8*)(lds + PG8_SB(b, h) + boff + n * 2048 + k * 1024); } while (0)
#define PG8_MMA(ai, bj, At, Bt) do { __builtin_amdgcn_s_setprio(1); _Pragma("unroll") for (int m = 0; m < 4; ++m) _Pragma("unroll") for (int n = 0; n < 2; ++n) _Pragma("unroll") for (int k = 0; k < 2; ++k) \
        acc[ai][bj][m][n] = __builtin_amdgcn_mfma_f32_16x16x32_bf16(Bt[n][k], At[m][k], acc[ai][bj][m][n], 0, 0, 0); __builtin_amdgcn_s_setprio(0); } while (0)
#define PG8_WAIT_V(n) asm volatile("s_waitcnt vmcnt(" #n ")" ::: "memory")
#define PG8_WAIT_L(n) asm volatile("s_waitcnt lgkmcnt(" #n ")" ::: "memory")
#define PG8_BAR __builtin_amdgcn_s_barrier()
#define PG8_SCHED __builtin_amdgcn_sched_barrier(0)
    Unit cur, nxt; int ui = 0;
    if (!S.next(0, cur)) return;
    f32x4 acc[2][2][4][2];
#pragma unroll
    for (int a = 0; a < 2; ++a)
#pragma unroll
        for (int b = 0; b < 2; ++b)
#pragma unroll
            for (int m = 0; m < 4; ++m)
#pragma unroll
                for (int n = 0; n < 2; ++n) acc[a][b][m][n] = (f32x4){0.f, 0.f, 0.f, 0.f};
    bf16x8 At[4][2], B0[2][2], B1[2][2];
    const char* cA = (const char*)g.A + (size_t)cur.pm * tstep; const char* cB = (const char*)g.Bt + (size_t)cur.pn * tstep;
    S.a_ready(cur);
    if constexpr (SP2) {
        PG8_STAGE(PG8_SB(0, 0), cB, voffB); PG8_STAGE(PG8_SB(0, 1), cB + hstep, voffB); PG8_STAGE(PG8_SA(0, 0), cA, voffA); PG8_STAGE(PG8_SA(0, 1), cA + hstep, voffA);
        if (wr == 1) PG8_BAR;
        PG8_WAIT_V(2); PG8_BAR;
        PG8_STAGE(PG8_SB(1, 0), cB + kstep, voffB); PG8_STAGE(PG8_SA(1, 0), cA + kstep, voffA); PG8_STAGE(PG8_SB(1, 1), cB + hstep + kstep, voffB);
        PG8_WAIT_V(6); PG8_BAR;
    } else {
        PG8_STAGE(PG8_SB(0, 0), cB, voffB); PG8_STAGE(PG8_SA(0, 0), cA, voffA); PG8_STAGE(PG8_SB(0, 1), cB + hstep, voffB); PG8_STAGE(PG8_SA(0, 1), cA + hstep, voffA);
        if (wr == 1) PG8_BAR;
        PG8_WAIT_V(4); PG8_BAR;
        PG8_STAGE(PG8_SB(1, 0), cB + kstep, voffB); PG8_STAGE(PG8_SA(1, 0), cA + kstep, voffA); PG8_STAGE(PG8_SB(1, 1), cB + hstep + kstep, voffB);
        PG8_WAIT_V(6); PG8_BAR;
    }
    for (;;) {
        const bool has_next = S.next(ui + 1, nxt);
        const char* nA = has_next ? (const char*)g.A + (size_t)nxt.pm * tstep : cA; const char* nB = has_next ? (const char*)g.Bt + (size_t)nxt.pn * tstep : cB;
        for (int t = 0; t < nt; t += 2) {
            const bool last = (t == nt - 2);
            const char* a1 = cA + (size_t)(t + 1) * kstep;
            const char* a2 = last ? nA : cA + (size_t)(t + 2) * kstep; const char* b2 = last ? nB : cB + (size_t)(t + 2) * kstep;
            const char* a3 = a2 + kstep; const char* b3 = b2 + kstep;
            if (last && has_next) S.a_ready(nxt);
            if constexpr (SP2) {
            PG8_LDB(B0, 0, 0); PG8_LDB(B1, 0, 1); PG8_SCHED; PG8_LDA(At, 0, 0); PG8_STAGE(PG8_SA(1, 1), a1 + hstep, voffA);
            PG8_WAIT_V(8); PG8_WAIT_L(0); PG8_BAR; PG8_MMA(0, 0, At, B0); PG8_MMA(0, 1, At, B1); PG8_BAR; PG8_SCHED;
            PG8_LDA(At, 0, 1); PG8_STAGE(PG8_SB(0, 0), b2, voffB); PG8_STAGE(PG8_SB(0, 1), b2 + hstep, voffB); PG8_STAGE(PG8_SA(0, 0), a2, voffA);
            PG8_WAIT_V(8); PG8_WAIT_L(0); PG8_BAR; PG8_MMA(1, 0, At, B0); PG8_MMA(1, 1, At, B1); PG8_BAR; PG8_SCHED;
            PG8_LDB(B0, 1, 0); PG8_LDB(B1, 1, 1); PG8_SCHED; PG8_LDA(At, 1, 0); PG8_STAGE(PG8_SA(0, 1), a2 + hstep, voffA);
            PG8_WAIT_V(8); PG8_WAIT_L(0); PG8_BAR; PG8_MMA(0, 0, At, B0); PG8_MMA(0, 1, At, B1); PG8_BAR; PG8_SCHED;
            PG8_LDA(At, 1, 1); PG8_STAGE(PG8_SB(1, 0), b3, voffB); PG8_STAGE(PG8_SB(1, 1), b3 + hstep, voffB); PG8_STAGE(PG8_SA(1, 0), a3, voffA);
            PG8_WAIT_V(8); PG8_WAIT_L(0); PG8_BAR; PG8_MMA(1, 0, At, B0); PG8_MMA(1, 1, At, B1); PG8_BAR; PG8_SCHED;
            } else {
            PG8_LDB(B0, 0, 0); PG8_SCHED; PG8_LDA(At, 0, 0); PG8_STAGE(PG8_SA(1, 1), a1 + hstep, voffA);
            PG8_WAIT_L(8); PG8_BAR; PG8_WAIT_L(0); PG8_MMA(0, 0, At, B0); PG8_BAR; PG8_SCHED;
            PG8_LDB(B1, 0, 1); PG8_STAGE(PG8_SB(0, 0), b2, voffB);
            PG8_BAR; PG8_WAIT_L(0); PG8_MMA(0, 1, At, B1); PG8_BAR;
            PG8_LDA(At, 0, 1); PG8_STAGE(PG8_SA(0, 0), a2, voffA);
            PG8_BAR; PG8_WAIT_L(0); PG8_MMA(1, 0, At, B0); PG8_BAR; PG8_SCHED;
            PG8_STAGE(PG8_SB(0, 1), b2 + hstep, voffB);
            PG8_WAIT_V(6); PG8_BAR; PG8_MMA(1, 1, At, B1); PG8_BAR;
            PG8_LDB(B0, 1, 0); PG8_SCHED; PG8_LDA(At, 1, 0); PG8_STAGE(PG8_SA(0, 1), a2 + hstep, voffA);
            PG8_WAIT_L(8); PG8_BAR; PG8_WAIT_L(0); PG8_MMA(0, 0, At, B0); PG8_BAR; PG8_SCHED;
            PG8_LDB(B1, 1, 1); PG8_STAGE(PG8_SB(1, 0), b3, voffB);
            PG8_BAR; PG8_WAIT_L(0); PG8_MMA(0, 1, At, B1); PG8_BAR;
            PG8_LDA(At, 1, 1); PG8_STAGE(PG8_SA(1, 0), a3, voffA);
            PG8_BAR; PG8_WAIT_L(0); PG8_MMA(1, 0, At, B0); PG8_BAR; PG8_SCHED;
            PG8_STAGE(PG8_SB(1, 1), b3 + hstep, voffB);
            PG8_WAIT_V(6); PG8_BAR; PG8_MMA(1, 1, At, B1); PG8_BAR;
            }
        }
        if constexpr (ALIGN_EPI) { if (wr == 0) PG8_BAR; }
        if constexpr (!Epi::AFTER_DRAIN) { E(acc, cur, wr, wc, fr, fq); S.done(cur); }
        if (!has_next) break;
#pragma unroll
        for (int a = 0; a < 2; ++a)
#pragma unroll
            for (int b = 0; b < 2; ++b)
#pragma unroll
                for (int m = 0; m < 4; ++m)
#pragma unroll
                    for (int n = 0; n < 2; ++n) acc[a][b][m][n] = (f32x4){0.f, 0.f, 0.f, 0.f};
        cur = nxt; cA = nA; cB = nB; ++ui;
        if constexpr (ALIGN_EPI) { if (wr == 1) PG8_BAR; }
    }
    PG8_WAIT_V(0);
    if constexpr (!ALIGN_EPI) { if (wr == 0) PG8_BAR; }
    PG8_BAR;
    if constexpr (Epi::AFTER_DRAIN) { E.fused(acc, cur, wr, wc, fr, fq, lds, wid, lane); S.done(cur); }
#undef PG8_SA
#undef PG8_SB
#undef PG8_STAGE
#undef PG8_LDA
#undef PG8_LDB
#undef PG8_MMA
#undef PG8_WAIT_V
#undef PG8_WAIT_L
#undef PG8_BAR
#undef PG8_SCHED
}
}
constexpr int DM = 1024, NCTX = 4096, NLAT = 8192, MROWS = 12288;
constexpr int CSEQ = 256, LSEQ = 1024, PAST = 512, LKEYS = 1536;
constexpr int INC = 4096, FF = 2816, FF2 = 5632, AW = 512;
constexpr float ALPHA = 1.189207115002721f, LN_EPS = 1e-5f;
constexpr float QSCALE = 0.125f * 1.4426950408889634f;
constexpr int NWAVES = 8, NTHR = 512;
constexpr int LDS_BYTES = 147456;
constexpr int RING_BYTES = 131072, MISC_OFF = RING_BYTES + 320;

constexpr size_t MiB = 1u << 20;
constexpr size_t WS_CTL = 0, CTL_ZERO_BYTES = 65536;
constexpr size_t WS_MOD = 1 * MiB;
constexpr size_t WS_ROPE = 1 * MiB + 512 * 1024;
constexpr size_t WS_WIN = 2 * MiB, WS_WOUT = 10 * MiB, WS_WUP = 12 * MiB, WS_WDN = 23 * MiB;
constexpr size_t WS_XM = 29 * MiB;
constexpr size_t WS_Q = 53 * MiB, WS_KC = 65 * MiB, WS_VC = 69 * MiB, WS_KL = 73 * MiB, WS_VL = 85 * MiB;
constexpr size_t WS_RQ = 97 * MiB, WS_RI = 109 * MiB, WS_RG = 121 * MiB, WS_GF = 133 * MiB, WS_GB = 157 * MiB, WS_OF = 181 * MiB, WS_MIX = 205 * MiB;
constexpr size_t WS_H = 53 * MiB;
constexpr size_t WS_G = 185 * MiB;
constexpr size_t WS_OB = 229 * MiB;
constexpr size_t WS_END = 253 * MiB;
constexpr size_t OUT_Y = 0, OUT_K = 12582912, OUT_V = OUT_K + 2097152, OUT_S = OUT_V + 2097152;
constexpr int CW_BAR = 4096;

#define GAS __attribute__((address_space(1)))
#define LAS __attribute__((address_space(3)))
typedef unsigned short bf16;
typedef unsigned v4u __attribute__((ext_vector_type(4)));
typedef unsigned v2u __attribute__((ext_vector_type(2)));
typedef float f32x4 __attribute__((ext_vector_type(4)));
typedef short bf16x8 __attribute__((ext_vector_type(8)));
typedef GAS unsigned gu32;
#define RLX_AGENT __ATOMIC_RELAXED, __HIP_MEMORY_SCOPE_AGENT
#define LDS_WAIT() asm volatile("s_waitcnt lgkmcnt(0)" ::: "memory")
#define VM_WAIT() asm volatile("s_waitcnt vmcnt(0)" ::: "memory")
__device__ __forceinline__ unsigned f2bf(float f) { unsigned u = __builtin_bit_cast(unsigned, f); return (u + 0x7fffu + ((u >> 16) & 1u)) >> 16; }
typedef float f32x2_t __attribute__((ext_vector_type(2))); typedef __bf16 bf16x2_t __attribute__((ext_vector_type(2)));
__device__ __forceinline__ unsigned pk2(float lo, float hi) { f32x2_t v = {lo, hi}; bf16x2_t b = __builtin_convertvector(v, bf16x2_t); return __builtin_bit_cast(unsigned, b); }
__device__ __forceinline__ float bflo(unsigned w) { return __uint_as_float(w << 16); }
__device__ __forceinline__ float bfhi(unsigned w) { return __uint_as_float(w & 0xffff0000u); }
__device__ __forceinline__ float wave_sum(float v) {
#pragma unroll
    for (int o = 1; o < 64; o <<= 1) v += __shfl_xor(v, o);
    return v;
}
__device__ __forceinline__ float wave_max(float v) {
#pragma unroll
    for (int o = 1; o < 64; o <<= 1) v = fmaxf(v, __shfl_xor(v, o));
    return v;
}
__device__ __forceinline__ float sigmoidf_(float z) { return 1.0f / (1.0f + __expf(-z)); }
__device__ __forceinline__ float siluf_(float z) { return z / (1.0f + __expf(-z)); }

struct Args { const float* in[27]; float* out; unsigned char* ws; int ph_lo, ph_hi; };
#define XB_TMO      128
#define XB_XCNT(j)  (256  + 64 * (j))
#define XB_XSUB(j)  (1280 + 64 * (j))
#define XB_XGEN(j)  (2304 + 64 * (j))
#define XB_TOP      3328
#define XB_TOPGEN   3392
#define XCD_BAR_WORDS 3456
#define XB_SPIN_CAP (1u << 18)

__device__ __forceinline__ unsigned xb_ld(unsigned* p)              { return __hip_atomic_load(p, __ATOMIC_RELAXED, __HIP_MEMORY_SCOPE_AGENT); }
__device__ __forceinline__ unsigned xb_add(unsigned* p, unsigned v) { return __hip_atomic_fetch_add(p, v, __ATOMIC_RELAXED, __HIP_MEMORY_SCOPE_AGENT); }
__device__ __forceinline__ unsigned xb_xcc_id() { return (unsigned)__builtin_amdgcn_s_getreg((3 << 11) | 20) & 0xFu; }
#define XB_SPIN(cond, bar) do { unsigned _sp = 0; while (cond) { __builtin_amdgcn_s_sleep(1); \
    if ((++_sp & 255u) == 0u) { if (xb_ld(&(bar)[XB_TMO])) break; if (_sp > XB_SPIN_CAP) { atomicAdd(&(bar)[XB_TMO], 1u); break; } } } } while (0)

struct XcdBarrier {
    unsigned* bar; unsigned x;
    volatile LAS unsigned* st;
};

__device__ __forceinline__ XcdBarrier xcd_barrier_post(unsigned* bar, volatile LAS unsigned* st) {
    XcdBarrier b; b.bar = bar; b.x = xb_xcc_id(); b.st = st;
    if (threadIdx.x == 0) (void)xb_add(&bar[XB_XCNT(b.x)], 1u);
    return b;
}
__device__ __forceinline__ void xcd_barrier_complete(unsigned* bar, unsigned x, unsigned& nloc, unsigned& nx) {
    const unsigned G = gridDim.x * gridDim.y * gridDim.z;
    unsigned sum, cnt, mine, sp = 0u;
    for (;;) {
        sum = 0u; cnt = 0u; mine = 0u;
#pragma unroll
        for (unsigned j = 0; j < 16; ++j) { const unsigned c = xb_ld(&bar[XB_XCNT(j)]); sum += c; cnt += (c > 0u) ? 1u : 0u; mine = (j == x) ? c : mine; }
        if (sum == G) break;
        __builtin_amdgcn_s_sleep(1);
        if ((++sp & 255u) == 0u) { if (xb_ld(&bar[XB_TMO])) break; if (sp > XB_SPIN_CAP) { atomicAdd(&bar[XB_TMO], 1u); break; } }
    }
    nloc = mine > 0u ? mine : 1u; nx = cnt > 0u ? cnt : 1u;
}

__device__ __forceinline__ void xcd_barrier(const XcdBarrier& b) {
    asm volatile("s_waitcnt vmcnt(0)" ::: "memory");
    __syncthreads();
    if (threadIdx.x == 0) {
        unsigned* bar = b.bar;
        __builtin_amdgcn_s_waitcnt(0);
        unsigned nloc = b.st[0], nx = b.st[1];
        if (nloc == 0u) { xcd_barrier_complete(bar, b.x, nloc, nx); b.st[0] = nloc; b.st[1] = nx; }
        const unsigned old = xb_add(&bar[XB_XSUB(b.x)], 1u);
        const unsigned gen = old / nloc;
        if (old + 1u == (gen + 1u) * nloc) {
            __builtin_amdgcn_fence(__ATOMIC_RELEASE, "agent");
            asm volatile("s_waitcnt vmcnt(0)" ::: "memory");
            const unsigned og = xb_add(&bar[XB_TOP], 1u);
            const unsigned tg = og / nx;
            if (og + 1u == (tg + 1u) * nx) xb_add(&bar[XB_TOPGEN], 1u);
            else XB_SPIN(xb_ld(&bar[XB_TOPGEN]) == tg, bar);
            __builtin_amdgcn_fence(__ATOMIC_ACQUIRE, "agent");
            xb_add(&bar[XB_XGEN(b.x)], 1u);
            asm volatile("s_waitcnt vmcnt(0)" ::: "memory");
        } else {
            XB_SPIN(xb_ld(&bar[XB_XGEN(b.x)]) == gen, bar);
            __builtin_amdgcn_fence(__ATOMIC_ACQUIRE, "agent");
            asm volatile("s_waitcnt vmcnt(0)" ::: "memory");
        }
    }
    __syncthreads();
}

__device__ __forceinline__ int mod_index(int row) { return row < NCTX ? 0 : 1 + ((row - NCTX) >> 10); }
__device__ __forceinline__ const float* xrow_ptr(const float* xp, const float* xs, int row) { return row < NCTX ? xp + (size_t)row * DM : xs + (size_t)(row - NCTX) * DM; }
__device__ __forceinline__ v2u pk4(f32x4 v) { v2u w; w.x = pk2(v[0], v[1]); w.y = pk2(v[2], v[3]); return w; }

struct Epi1 {
    static constexpr bool PERM = false, AFTER_DRAIN = false;
    bf16 *Q, *KC, *VC, *KL, *VL, *RQ, *RI, *RG; float *GF, *GB; float *outK, *outV; const float* rope; const float *lbf, *lbb;
    __device__ __forceinline__ void operator()(const f32x4 (&acc)[2][2][4][2], const pg8::Unit& u, int wr, int wc, int fr, int fq) const {
        const int grp = u.pn >> 1, cbase = (u.pn & 1) * 256; const bool ctx = u.pm < 16;
        if (grp <= 1) {
            const int half = wc & 1;
#pragma unroll
            for (int ai = 0; ai < 2; ++ai)
#pragma unroll
                for (int m = 0; m < 4; ++m) {
                    const int row = u.pm * 256 + ai * 128 + wr * 64 + m * 16 + fr;
                    f32x4 cs0 = (f32x4){1.f, 0.f, 1.f, 0.f}, cs1 = cs0;
                    if (!ctx) { const int t = (row - NCTX) & 1023; const int pos = half ? (t & 63) : (t >> 6);
                        const float* tp = rope + (size_t)pos * 32 + 8 * fq; cs0 = *(const f32x4*)tp; cs1 = *(const f32x4*)(tp + 4); }
#pragma unroll
                    for (int bj = 0; bj < 2; ++bj) {
                        const f32x4 x1 = acc[ai][bj][m][0], x2 = acc[ai][bj][m][1]; f32x4 o1, o2;
                        o1[0] = x1[0] * cs0[0] - x2[0] * cs0[1]; o2[0] = x1[0] * cs0[1] + x2[0] * cs0[0];
                        o1[1] = x1[1] * cs0[2] - x2[1] * cs0[3]; o2[1] = x1[1] * cs0[3] + x2[1] * cs0[2];
                        o1[2] = x1[2] * cs1[0] - x2[2] * cs1[1]; o2[2] = x1[2] * cs1[1] + x2[2] * cs1[0];
                        o1[3] = x1[3] * cs1[2] - x2[3] * cs1[3]; o2[3] = x1[3] * cs1[3] + x2[3] * cs1[2];
                        const int cg = cbase + bj * 128 + wc * 32 + 4 * fq;
                        if (grp == 0) { *(v2u*)(Q + (size_t)row * AW + cg) = pk4(o1 * QSCALE); *(v2u*)(Q + (size_t)row * AW + cg + 16) = pk4(o2 * QSCALE); }
                        else if (ctx) { *(f32x4*)(outK + (size_t)row * AW + cg) = x1; *(f32x4*)(outK + (size_t)row * AW + cg + 16) = x2;
                                        *(v2u*)(KC + (size_t)row * AW + cg) = pk4(x1); *(v2u*)(KC + (size_t)row * AW + cg + 16) = pk4(x2); }
                        else { const int b = (row - NCTX) >> 10, t = (row - NCTX) & 1023; bf16* kp = KL + ((size_t)b * LKEYS + PAST + t) * AW + cg;
                               *(v2u*)kp = pk4(o1); *(v2u*)(kp + 16) = pk4(o2); }
                    }
                }
            return;
        }
        f32x4 lb[2][2];
        if (grp == 4 || grp == 5) { const float* lg = grp == 4 ? lbf : lbb;
#pragma unroll
            for (int bj = 0; bj < 2; ++bj)
#pragma unroll
                for (int n = 0; n < 2; ++n) { const int cg = cbase + bj * 128 + wc * 32 + n * 16 + 4 * fq; const f32x4 l0 = *(const f32x4*)(lg + cg), l1 = *(const f32x4*)(lg + AW + cg);
#pragma unroll
                    for (int i = 0; i < 4; ++i) lb[bj][n][i] = sigmoidf_(l0[i] - l1[i]); } }
#pragma unroll
        for (int ai = 0; ai < 2; ++ai)
#pragma unroll
            for (int m = 0; m < 4; ++m) {
                const int row = u.pm * 256 + ai * 128 + wr * 64 + m * 16 + fr;
#pragma unroll
                for (int bj = 0; bj < 2; ++bj)
#pragma unroll
                    for (int n = 0; n < 2; ++n) {
                        const int cg = cbase + bj * 128 + wc * 32 + n * 16 + 4 * fq; const f32x4 v = acc[ai][bj][m][n]; const size_t o = (size_t)row * AW + cg;
                        if (grp == 2) { const int head = (cbase >> 7) + bj, e0 = wc * 32 + n * 16 + 4 * fq;
                                        if (ctx) { *(f32x4*)(outV + o) = v; const int b = row >> 8, l = row & 255; bf16* vp = VC + ((size_t)(b * 4 + head) * 128 + e0) * CSEQ + l;
#pragma unroll
                                            for (int i = 0; i < 4; ++i) vp[(size_t)i * CSEQ] = (bf16)f2bf(v[i]); }
                                        else { const int b = (row - NCTX) >> 10, t = (row - NCTX) & 1023; bf16* vp = VL + ((size_t)(b * 4 + head) * 128 + e0) * LKEYS + PAST + t;
#pragma unroll
                                            for (int i = 0; i < 4; ++i) vp[(size_t)i * LKEYS] = (bf16)f2bf(v[i]); } }
                        else if (grp == 3) *(v2u*)(RQ + o) = pk4(v);
                        else if (grp == 4 || grp == 5) { f32x4 w;
#pragma unroll
                            for (int i = 0; i < 4; ++i) { const float l = lb[bj][n][i]; w[i] = __logf(l + (1.0f - l) * sigmoidf_(v[i])); }
                            *(f32x4*)((grp == 4 ? GF : GB) + o) = w; }
                        else if (grp == 6) *(v2u*)(RI + o) = pk4(v);
                        else { f32x4 w;
#pragma unroll
                            for (int i = 0; i < 4; ++i) w[i] = siluf_(v[i]);
                            *(v2u*)(RG + o) = pk4(w); }
                    }
            }
    }
};
struct EpiRes {
    static constexpr bool PERM = false, AFTER_DRAIN = false;
    const float *xp, *xs; const float* ybase; float* out; const float* gate;
    __device__ __forceinline__ void operator()(const f32x4 (&acc)[2][2][4][2], const pg8::Unit& u, int wr, int wc, int fr, int fq) const {
        const int mi = u.pm < 16 ? 0 : 1 + ((u.pm - 16) >> 2); const float* gp = gate + (size_t)mi * 6144;
        f32x4 gv[2][2];
#pragma unroll
        for (int bj = 0; bj < 2; ++bj)
#pragma unroll
            for (int n = 0; n < 2; ++n) gv[bj][n] = *(const f32x4*)(gp + u.pn * 256 + bj * 128 + wc * 32 + n * 16 + 4 * fq);
#pragma unroll
        for (int ai = 0; ai < 2; ++ai)
#pragma unroll
            for (int m = 0; m < 4; ++m) {
                const int row = u.pm * 256 + ai * 128 + wr * 64 + m * 16 + fr;
                const float* bp = ybase ? ybase + (size_t)row * DM : xrow_ptr(xp, xs, row);
#pragma unroll
                for (int bj = 0; bj < 2; ++bj)
#pragma unroll
                    for (int n = 0; n < 2; ++n) { const int col = u.pn * 256 + bj * 128 + wc * 32 + n * 16 + 4 * fq;
                        const f32x4 b = *(const f32x4*)(bp + col); *(f32x4*)(out + (size_t)row * DM + col) = b * ALPHA + gv[bj][n] * acc[ai][bj][m][n]; }
            }
    }
};
struct EpiH {
    static constexpr bool PERM = false, AFTER_DRAIN = false;
    bf16* H;
    __device__ __forceinline__ void operator()(const f32x4 (&acc)[2][2][4][2], const pg8::Unit& u, int wr, int wc, int fr, int fq) const {
#pragma unroll
        for (int ai = 0; ai < 2; ++ai)
#pragma unroll
            for (int m = 0; m < 4; ++m) {
                const int row = u.pm * 256 + ai * 128 + wr * 64 + m * 16 + fr;
#pragma unroll
                for (int bj = 0; bj < 2; ++bj)
#pragma unroll
                    for (int n = 0; n < 2; ++n) { const int col = u.pn * 256 + bj * 128 + wc * 32 + n * 16 + 4 * fq; *(v2u*)(H + (size_t)row * FF2 + col) = pk4(acc[ai][bj][m][n]); }
            }
    }
};
__device__ __forceinline__ void p0_transpose_item(const float* W, int K, int N, bf16* WT, int k0, int n0, int orow0, LAS float* scr, int lane) {
#pragma unroll 8
    for (int i = 0; i < 32; ++i) { const int kk = 2 * i + (lane >> 5); scr[kk * 33 + (lane & 31)] = W[(size_t)(k0 + kk) * N + n0 + (lane & 31)]; }
    LDS_WAIT(); asm volatile("" ::: "memory");
    const int c = lane & 7;
#pragma unroll
    for (int j = 0; j < 4; ++j) { const int n = (lane >> 3) + 8 * j; const LAS float* s = scr + (8 * c) * 33 + n;
        v4u o; o.x = pk2(s[0 * 33], s[1 * 33]); o.y = pk2(s[2 * 33], s[3 * 33]); o.z = pk2(s[4 * 33], s[5 * 33]); o.w = pk2(s[6 * 33], s[7 * 33]);
        *(GAS v4u*)(WT + (size_t)(orow0 + n) * K + k0 + 8 * c) = o; }
    LDS_WAIT(); asm volatile("" ::: "memory");
}
__device__ __forceinline__ void p0_prologue(const Args& a, LAS unsigned char* lds, int vcu, int G, int tid, int lane, int wave) {
    unsigned char* ws = a.ws;
    {
        LAS float* cl = (LAS float*)lds;
        LAS float* red = (LAS float*)(lds + 40960);
        float* mod = (float*)(ws + WS_MOD);
        const float* wada = a.in[7]; const float* bada = a.in[8];
        bool filled = false;
        for (int cb = vcu; cb < 192; cb += G) {
            if (!filled) {
                for (int i = tid; i < 9 * 1024; i += NTHR) { const int m = i >> 10, k = i & 1023; const float v = (m == 0) ? a.in[6][k] : a.in[5][(m - 1) * 1024 + k]; cl[i] = siluf_(v); }
                filled = true; __syncthreads();
            }
            const int n0 = cb * 32, kr = lane >> 3, c4 = lane & 7;
            f32x4 acc[9];
#pragma unroll
            for (int m = 0; m < 9; ++m) acc[m] = (f32x4){0.f, 0.f, 0.f, 0.f};
            for (int it = 0; it < 16; ++it) { const int k = wave * 128 + it * 8 + kr; const f32x4 wv = *(const f32x4*)(wada + (size_t)k * 6144 + n0 + 4 * c4);
#pragma unroll
                for (int m = 0; m < 9; ++m) acc[m] += wv * cl[m * 1024 + k]; }
#pragma unroll
            for (int m = 0; m < 9; ++m)
#pragma unroll
                for (int i = 0; i < 4; ++i) { float v = acc[m][i]; v += __shfl_xor(v, 8); v += __shfl_xor(v, 16); v += __shfl_xor(v, 32); acc[m][i] = v; }
            if (kr == 0) {
#pragma unroll
                for (int m = 0; m < 9; ++m) *(LAS f32x4*)(red + (wave * 9 + m) * 32 + 4 * c4) = acc[m]; }
            __syncthreads();
            if (tid < 288) { const int m = tid >> 5, cc = tid & 31; float s = bada[n0 + cc];
#pragma unroll
                for (int w = 0; w < 8; ++w) s += red[(w * 9 + m) * 32 + cc];
                mod[(size_t)m * 6144 + n0 + cc] = s; }
            __syncthreads();
        }
        __syncthreads();
    }
    if (vcu == (G > 200 ? 200 : 0)) {
        float* rope = (float*)(ws + WS_ROPE);
        for (int i = tid; i < 1024; i += NTHR) { const int pos = i >> 4, j = i & 15;
            const float freq = 1.0f / powf(10000.0f, (float)j * (1.0f / 16.0f)); const float angf = (float)pos * freq; const double ang = (double)angf;
            const double nq = __builtin_rint(ang * 0.63661977236758134308); const double r = __builtin_fma(-nq, 1.5707963267948966192, ang) - nq * 6.123233995736766e-17; const double r2 = r * r;
            double sn = r * (1.0 + r2 * (-1.0 / 6 + r2 * (1.0 / 120 + r2 * (-1.0 / 5040 + r2 * (1.0 / 362880 + r2 * (-1.0 / 39916800 + r2 * (1.0 / 6227020800.0)))))));
            double cn = 1.0 + r2 * (-0.5 + r2 * (1.0 / 24 + r2 * (-1.0 / 720 + r2 * (1.0 / 40320 + r2 * (-1.0 / 3628800 + r2 * (1.0 / 479001600 + r2 * (-1.0 / 87178291200.0)))))));
            const int q = ((int)nq) & 3; double cc, ss;
            if (q == 0) { cc = cn; ss = sn; } else if (q == 1) { cc = -sn; ss = cn; } else if (q == 2) { cc = -cn; ss = -sn; } else { cc = sn; ss = -cn; }
            rope[2 * i] = (float)cc; rope[2 * i + 1] = (float)ss; }
    }
    {
        bf16* KL = (bf16*)(ws + WS_KL); bf16* VL = (bf16*)(ws + WS_VL);
        const int gt = vcu * NTHR + tid, NGT = G * NTHR;
        for (int i = gt; i < 524288; i += NGT) { const int rowi = i >> 7, c4 = i & 127, b = rowi >> 9, j = rowi & 511;
            const f32x4 v = *(const f32x4*)(a.in[2] + (size_t)i * 4);
            *(v2u*)(KL + ((size_t)b * LKEYS + j) * AW + 4 * c4) = pk4(v); }
        for (int i = gt; i < 524288; i += NGT) { const int j = i & 511, c4 = (i >> 9) & 127, b = i >> 16;
            const f32x4 v = *(const f32x4*)(a.in[3] + ((size_t)(b * 512 + j) * 512 + 4 * c4));
            bf16* vp = VL + ((size_t)b * 512 + 4 * c4) * LKEYS + j;
#pragma unroll
            for (int k = 0; k < 4; ++k) vp[(size_t)k * LKEYS] = (bf16)f2bf(v[k]); }
    }
    {
        LAS float* scr = (LAS float*)(lds + wave * 16384);
        const int gw = vcu * NWAVES + wave, NGW = G * NWAVES;
        constexpr int I_IN = 16 * 128, I_OUT = 16 * 32, I_UP = 16 * 176, I_DN = 44 * 32, NITEMS = I_IN + I_OUT + I_UP + I_DN;
        for (int it = gw; it < NITEMS; it += NGW) {
            int r = it;
            if (r < I_IN) { const int kb = r / 128, nb = r % 128; p0_transpose_item(a.in[9], DM, INC, (bf16*)(ws + WS_WIN), 64 * kb, 32 * nb, 32 * nb, scr, lane); continue; } r -= I_IN;
            if (r < I_OUT) { const int kb = r / 32, nb = r % 32; p0_transpose_item(a.in[18], DM, DM, (bf16*)(ws + WS_WOUT), 64 * kb, 32 * nb, 32 * nb, scr, lane); continue; } r -= I_OUT;
            if (r < I_UP) { const int kb = r / 176, nb = r % 176, n0 = 32 * nb; const int n1 = n0 < FF ? n0 : n0 - FF; const int orow = 256 * (n1 >> 7) + (n0 < FF ? 0 : 128) + (n1 & 127);
                p0_transpose_item(a.in[21], DM, FF2, (bf16*)(ws + WS_WUP), 64 * kb, n0, orow, scr, lane); continue; } r -= I_UP;
            { const int kb = r / 32, nb = r % 32; p0_transpose_item(a.in[24], FF, DM, (bf16*)(ws + WS_WDN), 64 * kb, 32 * nb, 32 * nb, scr, lane); }
        }
    }
}
__device__ __forceinline__ void p1_modulate(const Args& a, int vcu, int G, int lane, int wave) {
    const float* mod = (const float*)(a.ws + WS_MOD); bf16* XM = (bf16*)(a.ws + WS_XM);
    const int gw = vcu * NWAVES + wave, NGW = G * NWAVES;
    for (int row = gw; row < MROWS; row += NGW) {
        const float* xr = xrow_ptr(a.in[0], a.in[1], row); const float* mp = mod + (size_t)mod_index(row) * 6144;
#pragma unroll
        for (int j = 0; j < 4; ++j) { const int c = 4 * (lane + 64 * j); const f32x4 x = *(const f32x4*)(xr + c), sh = *(const f32x4*)(mp + c), sc = *(const f32x4*)(mp + 1024 + c);
            *(v2u*)(XM + (size_t)row * DM + c) = pk4(x * (sc + 1.0f) + sh); }
    }
}
__device__ __forceinline__ void ln_rows(const Args& a, const float* g, const float* bta, bool write_xm, int vcu, int G, int lane, int wave) {
    float* Y = a.out + OUT_Y; const float* mod = (const float*)(a.ws + WS_MOD); bf16* XM = (bf16*)(a.ws + WS_XM);
    const int gw = vcu * NWAVES + wave, NGW = G * NWAVES;
    for (int row = gw; row < MROWS; row += NGW) {
        float* yr = Y + (size_t)row * DM; f32x4 v[4]; float s = 0.f;
#pragma unroll
        for (int j = 0; j < 4; ++j) { v[j] = *(const f32x4*)(yr + 4 * (lane + 64 * j)); s += (v[j][0] + v[j][1]) + (v[j][2] + v[j][3]); }
        const float mean = wave_sum(s) * (1.0f / DM); float s2 = 0.f;
#pragma unroll
        for (int j = 0; j < 4; ++j) { v[j] = v[j] - mean; s2 += (v[j][0] * v[j][0] + v[j][1] * v[j][1]) + (v[j][2] * v[j][2] + v[j][3] * v[j][3]); }
        const float rstd = 1.0f / sqrtf(wave_sum(s2) * (1.0f / DM) + LN_EPS);
        const float* mp = mod + (size_t)mod_index(row) * 6144;
#pragma unroll
        for (int j = 0; j < 4; ++j) { const int c = 4 * (lane + 64 * j); const f32x4 x1 = v[j] * rstd * *(const f32x4*)(g + c) + *(const f32x4*)(bta + c);
            *(f32x4*)(yr + c) = x1;
            if (write_xm) { const f32x4 sh = *(const f32x4*)(mp + 3072 + c), sc = *(const f32x4*)(mp + 4096 + c); *(v2u*)(XM + (size_t)row * DM + c) = pk4(x1 * (sc + 1.0f) + sh); } }
    }
}
__device__ __forceinline__ void conv_gate(const Args& a, int vcu, int G, int tid) {
    const bf16* H = (const bf16*)(a.ws + WS_H); bf16* Gt = (bf16*)(a.ws + WS_G); const float* cw = a.in[22]; const float* cb = a.in[23];
    const int gt = vcu * NTHR + tid, NGT = G * NTHR; constexpr int PER_ROW = 22 * 32;
    for (int i = gt; i < MROWS * PER_ROW; i += NGT) {
        const int row = i / PER_ROW, r2 = i % PER_ROW, pn = r2 >> 5, jj = (r2 & 31) * 4;
        const int t = row < NCTX ? (row & 255) : ((row - NCTX) & 1023), L = row < NCTX ? CSEQ : LSEQ;
        const bool hp = t > 0, hn = t < L - 1;
        const int ca = 128 * pn + jj, cu = FF + ca;
        const bf16* hp0 = H + (size_t)row * FF2 + 256 * pn + jj;
        const v2u z = (v2u){0u, 0u};
        const v2u a0 = hp ? *(const v2u*)(hp0 - FF2) : z, a1 = *(const v2u*)hp0, a2 = hn ? *(const v2u*)(hp0 + FF2) : z;
        const v2u u0 = hp ? *(const v2u*)(hp0 - FF2 + 128) : z, u1 = *(const v2u*)(hp0 + 128), u2 = hn ? *(const v2u*)(hp0 + FF2 + 128) : z;
        const f32x4 wa0 = *(const f32x4*)(cw + ca), wa1 = *(const f32x4*)(cw + FF2 + ca), wa2 = *(const f32x4*)(cw + 2 * FF2 + ca), ba = *(const f32x4*)(cb + ca);
        const f32x4 wu0 = *(const f32x4*)(cw + cu), wu1 = *(const f32x4*)(cw + FF2 + cu), wu2 = *(const f32x4*)(cw + 2 * FF2 + cu), bu = *(const f32x4*)(cb + cu);
        const f32x4 A0 = (f32x4){bflo(a0.x), bfhi(a0.x), bflo(a0.y), bfhi(a0.y)}, A1 = (f32x4){bflo(a1.x), bfhi(a1.x), bflo(a1.y), bfhi(a1.y)}, A2 = (f32x4){bflo(a2.x), bfhi(a2.x), bflo(a2.y), bfhi(a2.y)};
        const f32x4 U0 = (f32x4){bflo(u0.x), bfhi(u0.x), bflo(u0.y), bfhi(u0.y)}, U1 = (f32x4){bflo(u1.x), bfhi(u1.x), bflo(u1.y), bfhi(u1.y)}, U2 = (f32x4){bflo(u2.x), bfhi(u2.x), bflo(u2.y), bfhi(u2.y)};
        const f32x4 av = A0 * wa0 + A1 * wa1 + A2 * wa2 + ba, uv = U0 * wu0 + U1 * wu1 + U2 * wu2 + bu; f32x4 gv;
#pragma unroll
        for (int k = 0; k < 4; ++k) gv[k] = siluf_(av[k]) * uv[k];
        *(v2u*)(Gt + (size_t)row * FF + ca) = pk4(gv);
    }
}
__device__ __forceinline__ float calc_lam(const Args& a, int lane) {
    const float s1 = wave_sum(a.in[10][lane] * a.in[11][lane]), s2 = wave_sum(a.in[12][lane] * a.in[13][lane]);
    return expf(s1) - expf(s2) + 0.2f;
}
__device__ __forceinline__ void attn_naive(const Args& a, LAS unsigned char* lds, int vcu, int G, int lane, int wave) {
    unsigned char* ws = a.ws;
    const bf16* Q = (const bf16*)(ws + WS_Q); bf16* MIX = (bf16*)(ws + WS_MIX); const float* attg = a.in[16];
    LAS float* qf = (LAS float*)(lds + wave * 12800);
    LAS float* sc = qf + 128;
    const float lam = calc_lam(a, lane);
    for (int it = vcu; it < 6144; it += G) {
        const int h = it & 3, row = (it >> 2) * 8 + wave; const bool ctx = row < NCTX;
        const int nk = ctx ? CSEQ : LKEYS;
        const bf16 *Kp, *Vp;
        if (ctx) { const int b = row >> 8; Kp = (const bf16*)(ws + WS_KC) + (size_t)b * CSEQ * AW + h * 128; Vp = (const bf16*)(ws + WS_VC) + (size_t)b * CSEQ * AW + h * 128; }
        else { const int b = (row - NCTX) >> 10; Kp = (const bf16*)(ws + WS_KL) + (size_t)b * LKEYS * AW + h * 128; Vp = (const bf16*)(ws + WS_VL) + (size_t)b * LKEYS * AW + h * 128; }
        { const unsigned w = *(const unsigned*)(Q + (size_t)row * AW + h * 128 + 2 * lane); qf[2 * lane] = bflo(w); qf[2 * lane + 1] = bfhi(w); }
        LDS_WAIT(); asm volatile("" ::: "memory");
        float m1 = -3.0e38f, m2 = -3.0e38f;
        for (int j = lane; j < nk; j += 64) {
            const bf16* kp = Kp + (size_t)j * AW; float s1 = 0.f, s2 = 0.f;
#pragma unroll
            for (int c = 0; c < 8; ++c) { const v4u k1 = *(const v4u*)(kp + 8 * c), k2 = *(const v4u*)(kp + 64 + 8 * c);
                const LAS float* q1 = qf + 8 * c; const LAS float* q2 = qf + 64 + 8 * c;
                s1 += bflo(k1.x) * q1[0] + bfhi(k1.x) * q1[1] + bflo(k1.y) * q1[2] + bfhi(k1.y) * q1[3] + bflo(k1.z) * q1[4] + bfhi(k1.z) * q1[5] + bflo(k1.w) * q1[6] + bfhi(k1.w) * q1[7];
                s2 += bflo(k2.x) * q2[0] + bfhi(k2.x) * q2[1] + bflo(k2.y) * q2[2] + bfhi(k2.y) * q2[3] + bflo(k2.z) * q2[4] + bfhi(k2.z) * q2[5] + bflo(k2.w) * q2[6] + bfhi(k2.w) * q2[7]; }
            sc[j] = s1; sc[1536 + j] = s2; m1 = fmaxf(m1, s1); m2 = fmaxf(m2, s2);
        }
        m1 = wave_max(m1); m2 = wave_max(m2);
        float l1 = 0.f, l2 = 0.f;
        for (int j = lane; j < nk; j += 64) { const float p1 = exp2f(sc[j] - m1), p2 = exp2f(sc[1536 + j] - m2); sc[j] = p1; sc[1536 + j] = p2; l1 += p1; l2 += p2; }
        l1 = wave_sum(l1); l2 = wave_sum(l2);
        const float i1 = 1.0f / l1, i2 = lam / l2;
        for (int j = lane; j < nk; j += 64) sc[j] = sc[j] * i1 - sc[1536 + j] * i2;
        LDS_WAIT(); asm volatile("" ::: "memory");
        float o0 = 0.f, o1 = 0.f;
#pragma unroll 8
        for (int j = 0; j < nk; ++j) { const unsigned w = *(const unsigned*)(Vp + (size_t)j * AW + 2 * lane); const float p = sc[j]; o0 += p * bflo(w); o1 += p * bfhi(w); }
        const float ss = wave_sum(o0 * o0 + o1 * o1); const float r = 1.0f / sqrtf(ss * (1.0f / 128.0f) + LN_EPS) * 0.8f;
        *(unsigned*)(MIX + (size_t)row * DM + h * 128 + 2 * lane) = pk2(o0 * r * attg[h * 128 + 2 * lane], o1 * r * attg[h * 128 + 2 * lane + 1]);
        LDS_WAIT(); asm volatile("" ::: "memory");
    }
}
__device__ __forceinline__ void rnn_naive(const Args& a, LAS unsigned char* lds, int vcu, int G, int tid) {
    unsigned char* ws = a.ws;
    const bf16* RQ = (const bf16*)(ws + WS_RQ); const bf16* RI = (const bf16*)(ws + WS_RI); const bf16* RG = (const bf16*)(ws + WS_RG);
    float* OF = (float*)(ws + WS_OF); bf16* MIX = (bf16*)(ws + WS_MIX); const float* rnng = a.in[17];
    LAS float* Fl = (LAS float*)lds;
    LAS float* Kl = Fl + 2048; LAS float* Ql = Kl + 2048; LAS float* Vl = Ql + 2048;
    LAS float* PO = Vl + 2048;
    const int e = tid & 127, qd = tid >> 7;
    for (int it = vcu; it < 96; it += G) {
        const bool ctx = it < 64; const int bi = ctx ? it : it - 64, b = bi >> 2, h = bi & 3;
        const int L = ctx ? CSEQ : LSEQ, row0 = ctx ? b * CSEQ : NCTX + b * LSEQ;
        for (int dir = 0; dir < 2; ++dir) {
            const float* GT = (const float*)(ws + (dir ? WS_GB : WS_GF));
            float S[32];
            if (ctx) {
#pragma unroll
                for (int i = 0; i < 32; ++i) S[i] = 0.f;
            } else { const float* s0 = a.in[4] + ((size_t)(b * 2 + dir) * 4 + h) * 16384;
#pragma unroll
                for (int i = 0; i < 32; ++i) S[i] = s0[(size_t)(32 * qd + i) * 128 + e]; }
            for (int tb = 0; tb < L / 16; ++tb) {
#pragma unroll
                for (int j = 0; j < 4; ++j) { const int idx = tid + NTHR * j, i = idx >> 7, d = idx & 127; const int s = tb * 16 + i, t = dir ? L - 1 - s : s;
                    const size_t o = (size_t)(row0 + t) * AW + h * 128 + d;
                    const float f = __expf(GT[o]); Fl[idx] = f; Kl[idx] = 1.0f - f; Ql[idx] = __uint_as_float((unsigned)RQ[o] << 16); Vl[idx] = __uint_as_float((unsigned)RI[o] << 16); }
                __syncthreads();
#pragma unroll 1
                for (int i = 0; i < 16; ++i) { const float v = Vl[i * 128 + e]; float po = 0.f;
#pragma unroll
                    for (int dd = 0; dd < 32; ++dd) { const int d = 32 * qd + dd; S[dd] = Fl[i * 128 + d] * S[dd] + Kl[i * 128 + d] * v; po += S[dd] * Ql[i * 128 + d]; }
                    PO[(i * 4 + qd) * 128 + e] = po; }
                __syncthreads();
                { const int i = tid >> 5, e4 = (tid & 31) * 4; const int s = tb * 16 + i, t = dir ? L - 1 - s : s; const size_t o = (size_t)(row0 + t) * AW + h * 128 + e4;
                    f32x4 ov = *(const LAS f32x4*)(PO + (i * 4 + 0) * 128 + e4) + *(const LAS f32x4*)(PO + (i * 4 + 1) * 128 + e4) + *(const LAS f32x4*)(PO + (i * 4 + 2) * 128 + e4) + *(const LAS f32x4*)(PO + (i * 4 + 3) * 128 + e4);
                    if (dir == 0) *(f32x4*)(OF + o) = ov;
                    else { ov += *(const f32x4*)(OF + o);
                        float ss = (ov[0] * ov[0] + ov[1] * ov[1]) + (ov[2] * ov[2] + ov[3] * ov[3]);
                        ss += __shfl_xor(ss, 1); ss += __shfl_xor(ss, 2); ss += __shfl_xor(ss, 4); ss += __shfl_xor(ss, 8); ss += __shfl_xor(ss, 16);
                        const float r = 1.0f / sqrtf(ss * (1.0f / 128.0f) + LN_EPS); const f32x4 g = *(const f32x4*)(rnng + h * 128 + e4); const v2u gw = *(const v2u*)(RG + o);
                        f32x4 res; res[0] = ov[0] * r * g[0] * bflo(gw.x); res[1] = ov[1] * r * g[1] * bfhi(gw.x); res[2] = ov[2] * r * g[2] * bflo(gw.y); res[3] = ov[3] * r * g[3] * bfhi(gw.y);
                        *(v2u*)(MIX + (size_t)(row0 + t) * DM + AW + h * 128 + e4) = pk4(res); } }
            }
            if (ctx) { float* so = a.out + OUT_S + ((size_t)(b * 2 + dir) * 4 + h) * 16384;
#pragma unroll
                for (int i = 0; i < 32; ++i) so[(size_t)(32 * qd + i) * 128 + e] = S[i]; }
            __threadfence(); __syncthreads();
        }
    }
}
constexpr int RN_QE = 0, RN_KD = 4352, RN_KET = 8704, RN_VT = 8704 + 5120, RN_DEC = 8704 + 10240, RN_BUF = 8704 + 10240 + 512;
struct RnnRaw { float lg[4]; unsigned short q[4], v[4]; };
__device__ __forceinline__ void rnn_load_raw(RnnRaw& R, const float* GT, const bf16* RQ, const bf16* RI, int row0, int L, int dir, int c, int h, int d, int sg) {
#pragma unroll
    for (int i = 0; i < 4; ++i) { const int s = c * 16 + 4 * sg + i, t = dir ? L - 1 - s : s; const size_t o = (size_t)(row0 + t) * AW + h * 128 + d;
        R.lg[i] = GT[o]; R.q[i] = RQ[o]; R.v[i] = RI[o]; }
}
__device__ __forceinline__ void rnn_prep(const RnnRaw& R, LAS unsigned char* buf, int d, int sg, int lane) {
    float cum[4]; cum[0] = R.lg[0]; cum[1] = cum[0] + R.lg[1]; cum[2] = cum[1] + R.lg[2]; cum[3] = cum[2] + R.lg[3];
    const float T = cum[3];
    const float t1 = __shfl_up(T, 16), t2 = __shfl_up(T, 32), t3 = __shfl_up(T, 48);
    const float off = (sg >= 1 ? t1 : 0.f) + (sg >= 2 ? t2 : 0.f) + (sg >= 3 ? t3 : 0.f);
    const float last = __shfl(off + T, 48 + (lane & 15));
    const int pos = 32 * (d >> 5) + 8 * ((d & 15) >> 2) + 4 * ((d >> 4) & 1) + (d & 3);
    float kef[4]; unsigned vv[4];
#pragma unroll
    for (int i = 0; i < 4; ++i) { const float cm = cum[i] + off; const float k = 1.0f - __expf(R.lg[i]);
        const float qe = __uint_as_float((unsigned)R.q[i] << 16) * __expf(cm), kd = k * __expf(-cm); kef[i] = k * __expf(last - cm); vv[i] = R.v[i];
        const int s = 4 * sg + i; const unsigned w = pk2(qe, kd);
        *(LAS unsigned short*)(buf + RN_QE + s * 272 + pos * 2) = (unsigned short)w;
        *(LAS unsigned short*)(buf + RN_KD + s * 272 + pos * 2) = (unsigned short)(w >> 16); }
    *(LAS v2u*)(buf + RN_KET + d * 40 + sg * 8) = (v2u){pk2(kef[0], kef[1]), pk2(kef[2], kef[3])};
    *(LAS v2u*)(buf + RN_VT + d * 40 + sg * 8) = (v2u){vv[0] | (vv[1] << 16), vv[2] | (vv[3] << 16)};
    if (sg == 3) *(LAS float*)(buf + RN_DEC + d * 4) = __expf(last);
}
#define RN_MFMA_PART bf16x8 qf[4], kf[4]; \
    _Pragma("unroll") \
    for (int kk = 0; kk < 4; ++kk) { qf[kk] = *(const LAS bf16x8*)(buf + RN_QE + fr * 272 + kk * 64 + g * 16); kf[kk] = *(const LAS bf16x8*)(buf + RN_KD + fr * 272 + kk * 64 + g * 16); } \
    const v2u vw = *(const LAS v2u*)(buf + RN_VT + e * 40 + g * 8); \
    const bf16x8 vb = __builtin_bit_cast(bf16x8, (v4u){vw.x, vw.y, 0u, 0u}); \
    f32x4 pT = (f32x4){0.f, 0.f, 0.f, 0.f}; \
    _Pragma("unroll") \
    for (int kk = 0; kk < 4; ++kk) pT = __builtin_amdgcn_mfma_f32_16x16x32_bf16(kf[kk], qf[kk], pT, 0, 0, 0); \
    _Pragma("unroll") \
    for (int r = 0; r < 4; ++r) pT[r] = (4 * g + r <= fr) ? pT[r] : 0.f; \
    const bf16x8 pa = __builtin_bit_cast(bf16x8, (v4u){pk2(pT[0], pT[1]), pk2(pT[2], pT[3]), 0u, 0u}); \
    f32x4 o = __builtin_amdgcn_mfma_f32_16x16x32_bf16(pa, vb, (f32x4){0.f, 0.f, 0.f, 0.f}, 0, 0, 0); \
    _Pragma("unroll") \
    for (int kk = 0; kk < 4; ++kk) { \
    const bf16x8 sb = __builtin_bit_cast(bf16x8, (v4u){pk2(acc[2 * kk][0], acc[2 * kk][1]), pk2(acc[2 * kk][2], acc[2 * kk][3]), pk2(acc[2 * kk + 1][0], acc[2 * kk + 1][1]), pk2(acc[2 * kk + 1][2], acc[2 * kk + 1][3])}); \
    o = __builtin_amdgcn_mfma_f32_16x16x32_bf16(qf[kk], sb, o, 0, 0, 0); } \
    _Pragma("unroll") \
    for (int i = 0; i < 8; ++i) { const f32x4 dc = *(const LAS f32x4*)(buf + RN_DEC + (16 * i + 4 * g) * 4); \
    const v2u kw = *(const LAS v2u*)(buf + RN_KET + (16 * i + fr) * 40 + g * 8); const bf16x8 ka = __builtin_bit_cast(bf16x8, (v4u){kw.x, kw.y, 0u, 0u}); \
    acc[i] = __builtin_amdgcn_mfma_f32_16x16x32_bf16(ka, vb, acc[i] * dc, 0, 0, 0); } \
    _Pragma("unroll") \
    for (int r = 0; r < 4; ++r) { const int s = c * 16 + 4 * g + r, t = dir ? L - 1 - s : s; (dir ? OB : OF)[(size_t)(row0 + t) * AW + h * 128 + e] = o[r]; }
__device__ __forceinline__ void rnn_item(const Args& a, LAS unsigned char* lds, int item, int tid, int lane, int wave) {
    unsigned char* ws = a.ws;
    const bf16* RQ = (const bf16*)(ws + WS_RQ); const bf16* RI = (const bf16*)(ws + WS_RI); const bf16* RG = (const bf16*)(ws + WS_RG);
    float* OF = (float*)(ws + WS_OF); float* OB = (float*)(ws + WS_OB); bf16* MIX = (bf16*)(ws + WS_MIX); const float* rnng = a.in[17];
    const int dl = lane & 15, sg = lane >> 4, d = 16 * wave + dl;
    const int fr = lane & 15, g = lane >> 4, e = 16 * wave + fr;
    {
        const bool ctx = item < 64; const int bi = ctx ? item : item - 64, b = bi >> 2, h = bi & 3;
        const int L = ctx ? CSEQ : LSEQ, row0 = ctx ? b * CSEQ : NCTX + b * LSEQ, NC = L / 16;
        for (int dir = 0; dir < 2; ++dir) {
            const float* GT = (const float*)(ws + (dir ? WS_GB : WS_GF));
            f32x4 acc[8];
            if (ctx) {
#pragma unroll
                for (int i = 0; i < 8; ++i) acc[i] = (f32x4){0.f, 0.f, 0.f, 0.f};
            } else { const float* s0 = a.in[4] + ((size_t)(b * 2 + dir) * 4 + h) * 16384;
#pragma unroll
                for (int i = 0; i < 8; ++i)
#pragma unroll
                    for (int r = 0; r < 4; ++r) acc[i][r] = s0[(size_t)(16 * i + 4 * g + r) * 128 + e]; }
#define RN_STEP(R_, cc_, bsel_, nxt_) do { LAS unsigned char* buf = lds + (bsel_) * RN_BUF; const int c = (cc_); \
                rnn_prep(R_, buf, d, sg, lane); \
                rnn_load_raw(R_, GT, RQ, RI, row0, L, dir, (nxt_) < NC ? (nxt_) : NC - 1, h, d, sg); \
                __syncthreads(); \
                RN_MFMA_PART } while (0)
            RnnRaw R0, R1; rnn_load_raw(R0, GT, RQ, RI, row0, L, dir, 0, h, d, sg); rnn_load_raw(R1, GT, RQ, RI, row0, L, dir, 1, h, d, sg);
            for (int c2 = 0; c2 < NC; c2 += 2) { RN_STEP(R0, c2, 0, c2 + 2); RN_STEP(R1, c2 + 1, 1, c2 + 3); }
#undef RN_STEP
            if (ctx) { float* so = a.out + OUT_S + ((size_t)(b * 2 + dir) * 4 + h) * 16384;
#pragma unroll
                for (int i = 0; i < 8; ++i)
#pragma unroll
                    for (int r = 0; r < 4; ++r) so[(size_t)(16 * i + 4 * g + r) * 128 + e] = acc[i][r]; }
            __threadfence(); __syncthreads();
        }
        { const float2 gn = *(const float2*)(rnng + h * 128 + 2 * lane);
          for (int tb = 0; tb < L; tb += 64) {
            float2 o1[8], o2[8]; unsigned gw[8];
#pragma unroll
            for (int j = 0; j < 8; ++j) { const size_t o = (size_t)(row0 + tb + 8 * wave + j) * AW + h * 128 + 2 * lane; o1[j] = *(const float2*)(OF + o); o2[j] = *(const float2*)(OB + o); gw[j] = *(const unsigned*)(RG + o); }
#pragma unroll
            for (int j = 0; j < 8; ++j) { const float ox = o1[j].x + o2[j].x, oy = o1[j].y + o2[j].y; const float ss = wave_sum(ox * ox + oy * oy); const float r = __builtin_amdgcn_rsqf(ss * (1.0f / 128.0f) + LN_EPS);
                *(unsigned*)(MIX + (size_t)(row0 + tb + 8 * wave + j) * DM + AW + h * 128 + 2 * lane) = pk2(ox * r * gn.x * bflo(gw[j]), oy * r * gn.y * bfhi(gw[j])); }
          } }
        __syncthreads();
    }
}
typedef float f32x16 __attribute__((ext_vector_type(16)));
constexpr int AT_K = 0, AT_V = 32768, AT_TILE = 16384;
__device__ __forceinline__ int crow16(int r, int hi) { return (r & 3) + 8 * (r >> 2) + 4 * hi; }
__device__ __forceinline__ void attn_unit(const Args& a, LAS unsigned char* lds, int unit, float lam, int tid, int lane, int wave) {
    unsigned char* ws = a.ws;
    const bool ctx = unit >= 256; const int ui = ctx ? unit - 256 : unit;
    const int qb = ctx ? (ui & 1) : (ui & 7), bh = ctx ? (ui >> 1) : (ui >> 3), b = bh >> 2, h = bh & 3;
    const int nk = ctx ? CSEQ : LKEYS, NT = nk / 64, row0 = (ctx ? b * CSEQ : NCTX + b * LSEQ) + qb * 128;
    const bf16* Kp = (const bf16*)(ws + (ctx ? WS_KC : WS_KL)) + (size_t)b * nk * AW + h * 128;
    const bf16* Vp = (const bf16*)(ws + (ctx ? WS_VC : WS_VL)) + (size_t)bh * 128 * nk;
    const int rg = wave & 3, map = wave >> 2, r32 = lane & 31, hi = lane >> 5;
    const int qrow = row0 + rg * 32 + r32;
    bf16x8 qf[4];
    { const bf16* qp = (const bf16*)(ws + WS_Q) + (size_t)qrow * AW + h * 128 + map * 64 + 8 * hi;
#pragma unroll
      for (int ks = 0; ks < 4; ++ks) qf[ks] = *(const bf16x8*)(qp + 16 * ks); }
    const int krow = tid >> 4, kch = tid & 15, ve = tid >> 3, vch = tid & 7, vxx = (ve >> 1) & 15;
    const unsigned ksrc = (unsigned)(krow * AW + kch * 8), vsrc = (unsigned)(ve * nk + vch * 8);
    const int kdst = AT_K + 256 * krow + 16 * (kch ^ (((krow & 3) << 2) | ((krow >> 2) & 3))), vdst = AT_V + 128 * ve + 16 * (vch ^ (vxx >> 1)); const bool vswap = vxx & 1;
    v4u kr[2], vr[2];
#define AT_LOAD(t) do { _Pragma("unroll") for (int i_ = 0; i_ < 2; ++i_) { kr[i_] = *(const v4u*)(Kp + ksrc + (size_t)((t) * 64 + 32 * i_) * AW); vr[i_] = *(const v4u*)(Vp + vsrc + (size_t)(64 * i_) * nk + (t) * 64); } } while (0)
#define AT_STORE(bufo) do { _Pragma("unroll") for (int i_ = 0; i_ < 2; ++i_) { *(LAS v4u*)(lds + (bufo) + kdst + 8192 * i_) = kr[i_]; \
        const v4u vv_ = vswap ? (v4u){vr[i_].z, vr[i_].w, vr[i_].x, vr[i_].y} : vr[i_]; *(LAS v4u*)(lds + (bufo) + vdst + 8192 * i_) = vv_; } } while (0)
    int koff[4];
    { const int x = ((r32 & 3) << 2) | ((r32 >> 2) & 3);
#pragma unroll
      for (int ks = 0; ks < 4; ++ks) koff[ks] = AT_K + 256 * r32 + 16 * ((8 * map + 2 * ks + hi) ^ x); }
    const int vbase = AT_V + 128 * r32, vx = 8 * ((r32 >> 1) & 15);
    f32x16 O[4];
#pragma unroll
    for (int eb = 0; eb < 4; ++eb)
#pragma unroll
        for (int r = 0; r < 16; ++r) O[eb][r] = 0.f;
    float m_run = -1.0e30f, l_run = 0.f;
    AT_LOAD(0); AT_STORE(0);
    if (NT > 1) AT_LOAD(1);
    __syncthreads();
    for (int t = 0; t < NT; ++t) {
        const int cur = (t & 1) * AT_TILE;
        f32x16 st[2];
#pragma unroll
        for (int mb = 0; mb < 2; ++mb) {
#pragma unroll
            for (int r = 0; r < 16; ++r) st[mb][r] = 0.f;
#pragma unroll
            for (int ks = 0; ks < 4; ++ks) { const bf16x8 kf = *(const LAS bf16x8*)(lds + cur + koff[ks] + 8192 * mb); st[mb] = __builtin_amdgcn_mfma_f32_32x32x16_bf16(kf, qf[ks], st[mb], 0, 0, 0); } }
        if (t + 1 < NT) { AT_STORE(AT_TILE - cur); if (t + 2 < NT) AT_LOAD(t + 2); }
        float mx = st[0][0];
#pragma unroll
        for (int r = 1; r < 16; ++r) mx = fmaxf(mx, st[0][r]);
#pragma unroll
        for (int r = 0; r < 16; ++r) mx = fmaxf(mx, st[1][r]);
        mx = fmaxf(mx, __shfl_xor(mx, 32));
        if (__any(mx > m_run)) { const float mn = fmaxf(m_run, mx), f = __builtin_amdgcn_exp2f(m_run - mn); m_run = mn; l_run *= f;
#pragma unroll
            for (int eb = 0; eb < 4; ++eb)
#pragma unroll
                for (int r = 0; r < 16; ++r) O[eb][r] *= f; }
        bf16x8 pf[2][2]; float ls = 0.f;
#pragma unroll
        for (int mb = 0; mb < 2; ++mb) {
#pragma unroll
            for (int r = 0; r < 16; ++r) { st[mb][r] = __builtin_amdgcn_exp2f(st[mb][r] - m_run); ls += st[mb][r]; }
#pragma unroll
            for (int sp = 0; sp < 2; ++sp) pf[mb][sp] = __builtin_bit_cast(bf16x8, (v4u){pk2(st[mb][8 * sp], st[mb][8 * sp + 1]), pk2(st[mb][8 * sp + 2], st[mb][8 * sp + 3]), pk2(st[mb][8 * sp + 4], st[mb][8 * sp + 5]), pk2(st[mb][8 * sp + 6], st[mb][8 * sp + 7])}); }
        l_run += ls;
#pragma unroll
        for (int eb = 0; eb < 4; ++eb) { __builtin_amdgcn_sched_barrier(0);
#pragma unroll
            for (int mb = 0; mb < 2; ++mb)
#pragma unroll
                for (int sp = 0; sp < 2; ++sp) { const int u1 = 8 * mb + 4 * sp + hi;
                    const v2u lo = *(const LAS v2u*)(lds + cur + vbase + 4096 * eb + ((8 * u1) ^ vx)), hv = *(const LAS v2u*)(lds + cur + vbase + 4096 * eb + ((8 * (u1 + 2)) ^ vx));
                    O[eb] = __builtin_amdgcn_mfma_f32_32x32x16_bf16(__builtin_bit_cast(bf16x8, (v4u){lo.x, lo.y, hv.x, hv.y}), pf[mb][sp], O[eb], 0, 0, 0); } }
        __syncthreads();
    }
#undef AT_LOAD
#undef AT_STORE
    l_run += __shfl_xor(l_run, 32);
    LAS float* ex = (LAS float*)lds + (size_t)rg * 4096 + lane;
    if (map == 1) { const float sc = lam / l_run;
#pragma unroll
        for (int eb = 0; eb < 4; ++eb)
#pragma unroll
            for (int r = 0; r < 16; ++r) ex[(eb * 16 + r) * 64] = O[eb][r] * sc; }
    __syncthreads();
    if (map == 0) { const float il = 1.0f / l_run; float ss = 0.f;
#pragma unroll
        for (int eb = 0; eb < 4; ++eb)
#pragma unroll
            for (int r = 0; r < 16; ++r) { const float v = O[eb][r] * il - ex[(eb * 16 + r) * 64]; O[eb][r] = v; ss += v * v; }
        ss += __shfl_xor(ss, 32);
        const float rn = 0.8f / sqrtf(ss * (1.0f / 128.0f) + LN_EPS); const float* ag = a.in[16] + h * 128;
        bf16* mp = (bf16*)(ws + WS_MIX) + (size_t)qrow * DM + h * 128;
#pragma unroll
        for (int eb = 0; eb < 4; ++eb)
#pragma unroll
            for (int rq = 0; rq < 4; ++rq) { const int e0 = 32 * eb + 8 * rq + 4 * hi; const f32x4 gn = *(const f32x4*)(ag + e0);
                f32x4 o4; o4[0] = O[eb][4 * rq] * rn * gn[0]; o4[1] = O[eb][4 * rq + 1] * rn * gn[1]; o4[2] = O[eb][4 * rq + 2] * rn * gn[2]; o4[3] = O[eb][4 * rq + 3] * rn * gn[3];
                *(v2u*)(mp + e0) = pk4(o4); } }
    __syncthreads();
}
__device__ __forceinline__ void mixer_phase(const Args& a, LAS unsigned char* lds, int tid, int lane, int wave, int rep) {
    unsigned* ctr = (unsigned*)(a.ws + WS_CTL) + 256 + 64 * rep;
    volatile LAS unsigned* slot = (volatile LAS unsigned*)(lds + MISC_OFF + 64);
    const float lam = calc_lam(a, lane);
    for (;;) {
        if (tid == 0) slot[0] = __hip_atomic_fetch_add(ctr, 1u, __ATOMIC_RELAXED, __HIP_MEMORY_SCOPE_AGENT);
        __syncthreads();
        const int it = (int)slot[0];
        __syncthreads();
        if (it >= 480) break;
        int tid_ = tid; asm volatile("" : "+v"(tid_));
        const int lane_ = tid_ & 63;
#ifndef PROBE_SKIP
#define PROBE_SKIP 0
#endif
        const bool do_rnn = !(rep == 1 && PROBE_SKIP == 1), do_att = !(rep == 1 && PROBE_SKIP == 2);
        if (it < 32) { if (do_rnn) rnn_item(a, lds, 64 + it, tid_, lane_, wave); }
        else if (it < 288) { if (do_att) attn_unit(a, lds, it - 32, lam, tid_, lane_, wave); }
        else if (it < 352) { if (do_rnn) rnn_item(a, lds, it - 288, tid_, lane_, wave); }
        else if (do_att) attn_unit(a, lds, 256 + (it - 352), lam, tid_, lane_, wave);
    }
}
#ifndef MK_N_LAUNCHES
#define MK_N_LAUNCHES 1
#endif
constexpr int NPH = 10;
#ifndef PROBE_PH
#define PROBE_PH -1
#endif
#define REPS(k) for (int rep_ = 0; rep_ < (PROBE_PH == (k) ? 2 : 1); ++rep_, (PROBE_PH == (k) && rep_ == 1) ? xcd_barrier(bar) : (void)0)
__global__ void __launch_bounds__(NTHR, 2) fwd(Args args) {
    extern __shared__ __attribute__((aligned(16))) unsigned char lds_[];
    LAS unsigned char* lds = (LAS unsigned char*)lds_;
    const int tid = threadIdx.x, lane = tid & 63, wave = __builtin_amdgcn_readfirstlane(tid >> 6);
    const int G = gridDim.x, bx = blockIdx.x, vcu = (G % 8 == 0) ? (bx % 8) * (G / 8) + bx / 8 : bx;
    unsigned char* ws = args.ws;
    for (int u = tid; u < (LDS_BYTES - RING_BYTES) / 4; u += NTHR) ((LAS unsigned*)(lds + RING_BYTES))[u] = 0u;
    __syncthreads();
    const int lo = args.ph_lo, hi = args.ph_hi;
    XcdBarrier bar; bar.bar = (unsigned*)(ws + WS_CTL) + CW_BAR; bar.x = 0; bar.st = nullptr;
    if (hi - lo > 1) bar = xcd_barrier_post((unsigned*)(ws + WS_CTL) + CW_BAR, (volatile LAS unsigned*)(lds + MISC_OFF) + 8);
#define IN(k) (lo <= (k) && (k) < hi)
#define SEAM(k) do { if (IN(k) && IN((k) + 1)) xcd_barrier(bar); } while (0)
    float* mod = (float*)(ws + WS_MOD);
    if (IN(0)) { REPS(0) p0_prologue(args, lds, vcu, G, tid, lane, wave); SEAM(0); }
    if (IN(1)) { REPS(1) p1_modulate(args, vcu, G, lane, wave); SEAM(1); }
    if (IN(2)) {
        pg8::Gemm g{(const bf16*)(ws + WS_XM), (const bf16*)(ws + WS_WIN), MROWS, INC, DM}; pg8::StaticOrder S; S.init(MROWS, INC, G, bx);
        Epi1 E{(bf16*)(ws + WS_Q), (bf16*)(ws + WS_KC), (bf16*)(ws + WS_VC), (bf16*)(ws + WS_KL), (bf16*)(ws + WS_VL), (bf16*)(ws + WS_RQ), (bf16*)(ws + WS_RI), (bf16*)(ws + WS_RG),
               (float*)(ws + WS_GF), (float*)(ws + WS_GB), args.out + OUT_K, args.out + OUT_V, (const float*)(ws + WS_ROPE), args.in[14], args.in[15]};
        REPS(2) pg8::gemm_phase<Epi1, pg8::StaticOrder, true, true>(lds, g, S, E);
        SEAM(2);
    }
    if (IN(3)) {
        REPS(3) mixer_phase(args, lds, tid, lane, wave, rep_);
        SEAM(3);
    }
    if (IN(4)) {
        pg8::Gemm g{(const bf16*)(ws + WS_MIX), (const bf16*)(ws + WS_WOUT), MROWS, DM, DM}; pg8::StaticOrder S; S.init(MROWS, DM, G, bx);
        EpiRes E{args.in[0], args.in[1], nullptr, args.out + OUT_Y, mod + 2048};
        REPS(4) pg8::gemm_phase<EpiRes, pg8::StaticOrder, true, true>(lds, g, S, E);
        SEAM(4);
    }
    if (IN(5)) { ln_rows(args, args.in[19], args.in[20], true, vcu, G, lane, wave); SEAM(5); }
    if (IN(6)) {
        pg8::Gemm g{(const bf16*)(ws + WS_XM), (const bf16*)(ws + WS_WUP), MROWS, FF2, DM}; pg8::StaticOrder S; S.init(MROWS, FF2, G, bx);
        EpiH E{(bf16*)(ws + WS_H)};
        REPS(6) pg8::gemm_phase<EpiH, pg8::StaticOrder, true, true>(lds, g, S, E);
        SEAM(6);
    }
    if (IN(7)) { REPS(7) conv_gate(args, vcu, G, tid); SEAM(7); }
    if (IN(8)) {
        pg8::Gemm g{(const bf16*)(ws + WS_G), (const bf16*)(ws + WS_WDN), MROWS, DM, FF}; pg8::StaticOrder S; S.init(MROWS, DM, G, bx);
        EpiRes E{args.in[0], args.in[1], args.out + OUT_Y, args.out + OUT_Y, mod + 5120};
        pg8::gemm_phase<EpiRes, pg8::StaticOrder, true, true>(lds, g, S, E);
        SEAM(8);
    }
    if (IN(9)) { ln_rows(args, args.in[25], args.in[26], false, vcu, G, lane, wave); }
#undef IN
#undef SEAM
}

extern "C" void kernel_launch(void* const* d_in, const int* in_sizes, int n_in, void* d_out, int out_size, void* d_ws, size_t ws_size, hipStream_t stream) {
    static int grid = 0;
    if (grid == 0) {
        if (n_in != 27 || out_size != 18874368 || ws_size < WS_END) { fprintf(stderr, "kernel_launch: unexpected shapes (n_in %d, out %d, ws %zu)\n", n_in, out_size, ws_size); grid = -1; return; }
        int dev = 0, cus = 0, per_cu = 0;
        if (hipGetDevice(&dev) != hipSuccess || hipDeviceGetAttribute(&cus, hipDeviceAttributeMultiprocessorCount, dev) != hipSuccess) { grid = -1; return; }
        if (hipFuncSetAttribute((const void*)fwd, hipFuncAttributeMaxDynamicSharedMemorySize, LDS_BYTES) != hipSuccess) { fprintf(stderr, "kernel_launch: hipFuncSetAttribute failed\n"); grid = -1; return; }
        if (hipOccupancyMaxActiveBlocksPerMultiprocessor(&per_cu, (const void*)fwd, NTHR, LDS_BYTES) != hipSuccess || per_cu < 1) { fprintf(stderr, "kernel_launch: occupancy query reports %d\n", per_cu); per_cu = 1; }
        (void)hipGetLastError();
        grid = cus;
    }
    if (grid < 0) return;
    (void)hipMemsetAsync((char*)d_ws + WS_CTL, 0, CTL_ZERO_BYTES, stream);
    Args a{};
    for (int i = 0; i < 27; ++i) a.in[i] = (const float*)d_in[i];
    a.out = (float*)d_out; a.ws = (unsigned char*)d_ws;
    if (MK_N_LAUNCHES == 1) { a.ph_lo = 0; a.ph_hi = NPH; hipLaunchKernelGGL(fwd, dim3(grid), dim3(NTHR), LDS_BYTES, stream, a); }
    else for (int li = 0; li < NPH; ++li) { a.ph_lo = li; a.ph_hi = li + 1; hipLaunchKernelGGL(fwd, dim3(grid), dim3(NTHR), LDS_BYTES, stream, a); }
}
```

```cpp
#include <hip/hip_runtime.h>
#include <cstdio>
#include <cstdint>
#define MK_N_LAUNCHES 1
namespace pg8 {
#define PG8_LAS __attribute__((address_space(3)))
typedef unsigned short bf16_t;
typedef short bf16x8 __attribute__((ext_vector_type(8)));
typedef float f32x4 __attribute__((ext_vector_type(4)));
typedef unsigned u32x4 __attribute__((ext_vector_type(4)));
constexpr int BM = 256, BK = 64, HALF = 128, HTB = HALF * BK * 2  , STAGE_BYTES = 8 * HTB, NXCD = 8, WGM = 8;

__host__ __device__ __forceinline__ int lds_byte(int r, int c) { const int st = (r >> 4) * 2 + (c >> 5), rr = r & 15, cc = c & 31, ob = rr * 64 + cc * 2; return st * 1024 + (ob ^ (((ob >> 9) & 1) << 5)); }
__host__ __device__ __forceinline__ void stage_rc(int b, int& R, int& C) { const int st = b / 1024, sb = b % 1024, swz = sb ^ (((sb >> 9) & 1) << 5); R = (st >> 1) * 16 + swz / 64; C = (st & 1) * 32 + (swz % 64) / 2; }
__host__ __device__ __forceinline__ int perm32(int rho) { const int n = rho >> 4, i = rho & 15; return 8 * (i >> 2) + 4 * n + (i & 3); }

struct Unit { int pm, pn; };
struct Gemm { const bf16_t* A; const bf16_t* Bt; int M, N, K; };

struct StaticOrder {
    int nM, nN, nwg, G, c;
    __host__ __device__ void init(int M, int N, int G_, int c_) { nM = M / BM; nN = N / BM; nwg = nM * nN; G = G_; c = c_; }
    __host__ __device__ bool next(int i, Unit& u) const {
        const long L = (long)i * G + c; if (L >= nwg) return false;
        int wgid = (int)L; { const int q = nwg / NXCD, r = nwg % NXCD, xcd = wgid % NXCD, off = wgid / NXCD; wgid = (xcd < r ? xcd * (q + 1) : r * (q + 1) + (xcd - r) * q) + off; }
        const int nig = WGM * nN, gid = wgid / nig, fm = gid * WGM, gsz = (nM - fm) < WGM ? (nM - fm) : WGM;
        u.pm = fm + ((wgid % nig) % gsz); u.pn = (wgid % nig) / gsz; return true;
    }
    __device__ __forceinline__ void a_ready(const Unit&) const {}
    __device__ __forceinline__ void done(const Unit&) const {}
};

__device__ __forceinline__ unsigned cvt_pk_bf16(float lo, float hi) { unsigned r; asm volatile("v_cvt_pk_bf16_f32 %0, %1, %2" : "=v"(r) : "v"(lo), "v"(hi)); return r; }
typedef float f32x2 __attribute__((ext_vector_type(2)));
template <class Epi, class Sched, bool ALIGN_EPI = false, bool SP2 = false>
__device__ __forceinline__ void gemm_phase(PG8_LAS unsigned char* lds, const Gemm g, const Sched& S, const Epi& E) {
    const int tid = threadIdx.x, wid = __builtin_amdgcn_readfirstlane(tid >> 6), lane = tid & 63, wr = wid >> 2, wc = wid & 3, fr = lane & 15, fq = lane >> 4;
    const int K = g.K, nt = K / BK;
    unsigned voffA[2], voffB[2];
#pragma unroll
    for (int i = 0; i < 2; ++i) { int R, C; stage_rc(tid * 16 + i * 8192, R, C); const int Rb = Epi::PERM ? ((R & ~31) + perm32(R & 31)) : R;
        voffA[i] = (unsigned)(R * K + C) * 2u; voffB[i] = (unsigned)(Rb * K + C) * 2u; }
    const size_t kstep = (size_t)(BK * 2);
    const size_t hstep = (size_t)HALF * K * 2;
    const size_t tstep = 2 * hstep;
    const unsigned ldsw = (unsigned)wid * 1024u;
    const int aoff = lds_byte(wr * 64 + fr, fq * 8), boff = lds_byte(wc * 32 + fr, fq * 8);
#define PG8_SA(b, h) (((b) * 2 + (h)) * HTB)
#define PG8_SB(b, h) ((4 + (b) * 2 + (h)) * HTB)
#define PG8_STAGE(bufoff, gbase, voff) do { _Pragma("unroll") for (int _i = 0; _i < 2; ++_i) \
        __builtin_amdgcn_global_load_lds((const unsigned*)((const char*)(gbase) + (voff)[_i]), (PG8_LAS unsigned*)(lds + (bufoff) + ldsw + _i * 8192), 16, 0, 0); } while (0)
#define PG8_LDA(dst, b, h) do { _Pragma("unroll") for (int m = 0; m < 4; ++m) _Pragma("unroll") for (int k = 0; k < 2; ++k) dst[m][k] = *(const PG8_LAS bf16x8*)(lds + PG8_SA(b, h) + aoff + m * 2048 + k * 1024); } while (0)
#define PG8_LDB(dst, b, h) do { _Pragma("unroll") for (int n = 0; n < 2; ++n) _Pragma("unroll") for (int k = 0; k < 2; ++k) dst[n][k] = *(const PG8_LAS bf16x8*)(lds + PG8_SB(b, h) + boff + n * 2048 + k * 1024); } while (0)
#define PG8_MMA(ai, bj, At, Bt) do { __builtin_amdgcn_s_setprio(1); _Pragma("unroll") for (int m = 0; m < 4; ++m) _Pragma("unroll") for (int n = 0; n < 2; ++n) _Pragma("unroll") for (int k = 0; k < 2; ++k) \
        acc[ai][bj][m][n] = __builtin_amdgcn_mfma_f32_16x16x32_bf16(Bt[n][k], At[m][k], acc[ai][bj][m][n], 0, 0, 0); __builtin_amdgcn_s_setprio(0); } while (0)
#define PG8_WAIT_V(n) asm volatile("s_waitcnt vmcnt(" #n ")" ::: "memory")
#define PG8_WAIT_L(n) asm volatile("s_waitcnt lgkmcnt(" #n ")" ::: "memory")
#define PG8_BAR __builtin_amdgcn_s_barrier()
#define PG8_SCHED __builtin_amdgcn_sched_barrier(0)
    Unit cur, nxt; int ui = 0;
    if (!S.next(0, cur)) return;
    f32x4 acc[2][2][4][2];
#pragma unroll
    for (int a = 0; a < 2; ++a)
#pragma unroll
        for (int b = 0; b < 2; ++b)
#pragma unroll
            for (int m = 0; m < 4; ++m)
#pragma unroll
                for (int n = 0; n < 2; ++n) acc[a][b][m][n] = (f32x4){0.f, 0.f, 0.f, 0.f};
    bf16x8 At[4][2], B0[2][2], B1[2][2];
    const char* cA = (const char*)g.A + (size_t)cur.pm * tstep; const char* cB = (const char*)g.Bt + (size_t)cur.pn * tstep;
    S.a_ready(cur);
    if constexpr (SP2) {
        PG8_STAGE(PG8_SB(0, 0), cB, voffB); PG8_STAGE(PG8_SB(0, 1), cB + hstep, voffB); PG8_STAGE(PG8_SA(0, 0), cA, voffA); PG8_STAGE(PG8_SA(0, 1), cA + hstep, voffA);
        if (wr == 1) PG8_BAR;
        PG8_WAIT_V(2); PG8_BAR;
        PG8_STAGE(PG8_SB(1, 0), cB + kstep, voffB); PG8_STAGE(PG8_SA(1, 0), cA + kstep, voffA); PG8_STAGE(PG8_SB(1, 1), cB + hstep + kstep, voffB);
        PG8_WAIT_V(6); PG8_BAR;
    } else {
        PG8_STAGE(PG8_SB(0, 0), cB, voffB); PG8_STAGE(PG8_SA(0, 0), cA, voffA); PG8_STAGE(PG8_SB(0, 1), cB + hstep, voffB); PG8_STAGE(PG8_SA(0, 1), cA + hstep, voffA);
        if (wr == 1) PG8_BAR;
        PG8_WAIT_V(4); PG8_BAR;
        PG8_STAGE(PG8_SB(1, 0), cB + kstep, voffB); PG8_STAGE(PG8_SA(1, 0), cA + kstep, voffA); PG8_STAGE(PG8_SB(1, 1), cB + hstep + kstep, voffB);
        PG8_WAIT_V(6); PG8_BAR;
    }
    for (;;) {
        const bool has_next = S.next(ui + 1, nxt);
        const char* nA = has_next ? (const char*)g.A + (size_t)nxt.pm * tstep : cA; const char* nB = has_next ? (const char*)g.Bt + (size_t)nxt.pn * tstep : cB;
        for (int t = 0; t < nt; t += 2) {
            const bool last = (t == nt - 2);
            const char* a1 = cA + (size_t)(t + 1) * kstep;
            const char* a2 = last ? nA : cA + (size_t)(t + 2) * kstep; const char* b2 = last ? nB : cB + (size_t)(t + 2) * kstep;
            const char* a3 = a2 + kstep; const char* b3 = b2 + kstep;
            if (last && has_next) S.a_ready(nxt);
            if constexpr (SP2) {
            PG8_LDB(B0, 0, 0); PG8_LDB(B1, 0, 1); PG8_SCHED; PG8_LDA(At, 0, 0); PG8_STAGE(PG8_SA(1, 1), a1 + hstep, voffA);
            PG8_WAIT_V(8); PG8_WAIT_L(0); PG8_BAR; PG8_MMA(0, 0, At, B0); PG8_MMA(0, 1, At, B1); PG8_BAR; PG8_SCHED;
            PG8_LDA(At, 0, 1); PG8_STAGE(PG8_SB(0, 0), b2, voffB); PG8_STAGE(PG8_SB(0, 1), b2 + hstep, voffB); PG8_STAGE(PG8_SA(0, 0), a2, voffA);
            PG8_WAIT_V(8); PG8_WAIT_L(0); PG8_BAR; PG8_MMA(1, 0, At, B0); PG8_MMA(1, 1, At, B1); PG8_BAR; PG8_SCHED;
            PG8_LDB(B0, 1, 0); PG8_LDB(B1, 1, 1); PG8_SCHED; PG8_LDA(At, 1, 0); PG8_STAGE(PG8_SA(0, 1), a2 + hstep, voffA);
            PG8_WAIT_V(8); PG8_WAIT_L(0); PG8_BAR; PG8_MMA(0, 0, At, B0); PG8_MMA(0, 1, At, B1); PG8_BAR; PG8_SCHED;
            PG8_LDA(At, 1, 1); PG8_STAGE(PG8_SB(1, 0), b3, voffB); PG8_STAGE(PG8_SB(1, 1), b3 + hstep, voffB); PG8_STAGE(PG8_SA(1, 0), a3, voffA);
            PG8_WAIT_V(8); PG8_WAIT_L(0); PG8_BAR; PG8_MMA(1, 0, At, B0); PG8_MMA(1, 1, At, B1); PG8_BAR; PG8_SCHED;
            } else {
            PG8_LDB(B0, 0, 0); PG8_SCHED; PG8_LDA(At, 0, 0); PG8_STAGE(PG8_SA(1, 1), a1 + hstep, voffA);
            PG8_WAIT_L(8); PG8_BAR; PG8_WAIT_L(0); PG8_MMA(0, 0, At, B0); PG8_BAR; PG8_SCHED;
            PG8_LDB(B1, 0, 1); PG8_STAGE(PG8_SB(0, 0), b2, voffB);
            PG8_BAR; PG8_WAIT_L(0); PG8_MMA(0, 1, At, B1); PG8_BAR;
            PG8_LDA(At, 0, 1); PG8_STAGE(PG8_SA(0, 0), a2, voffA);
            PG8_BAR; PG8_WAIT_L(0); PG8_MMA(1, 0, At, B0); PG8_BAR; PG8_SCHED;
            PG8_STAGE(PG8_SB(0, 1), b2 + hstep, voffB);
            PG8_WAIT_V(6); PG8_BAR; PG8_MMA(1, 1, At, B1); PG8_BAR;
            PG8_LDB(B0, 1, 0); PG8_SCHED; PG8_LDA(At, 1, 0); PG8_STAGE(PG8_SA(0, 1), a2 + hstep, voffA);
            PG8_WAIT_L(8); PG8_BAR; PG8_WAIT_L(0); PG8_MMA(0, 0, At, B0); PG8_BAR; PG8_SCHED;
            PG8_LDB(B1, 1, 1); PG8_STAGE(PG8_SB(1, 0), b3, voffB);
            PG8_BAR; PG8_WAIT_L(0); PG8_MMA(0, 1, At, B1); PG8_BAR;
            PG8_LDA(At, 1, 1); PG8_STAGE(PG8_SA(1, 0), a3, voffA);
            PG8_BAR; PG8_WAIT_L(0); PG8_MMA(1, 0, At, B0); PG8_BAR; PG8_SCHED;
            PG8_STAGE(PG8_SB(1, 1), b3 + hstep, voffB);
            PG8_WAIT_V(6); PG8_BAR; PG8_MMA(1, 1, At, B1); PG8_BAR;
            }
        }
        if constexpr (ALIGN_EPI) { if (wr == 0) PG8_BAR; }
        if constexpr (!Epi::AFTER_DRAIN) { E(acc, cur, wr, wc, fr, fq); S.done(cur); }
        if (!has_next) break;
#pragma unroll
        for (int a = 0; a < 2; ++a)
#pragma unroll
            for (int b = 0; b < 2; ++b)
#pragma unroll
                for (int m = 0; m < 4; ++m)
#pragma unroll
                    for (int n = 0; n < 2; ++n) acc[a][b][m][n] = (f32x4){0.f, 0.f, 0.f, 0.f};
        cur = nxt; cA = nA; cB = nB; ++ui;
        if constexpr (ALIGN_EPI) { if (wr == 1) PG8_BAR; }
    }
    PG8_WAIT_V(0);
    if constexpr (!ALIGN_EPI) { if (wr == 0) PG8_BAR; }
    PG8_BAR;
    if constexpr (Epi::AFTER_DRAIN) { E.fused(acc, cur, wr, wc, fr, fq, lds, wid, lane); S.done(cur); }
#undef PG8_SA
#undef PG8_SB
#undef PG8_STAGE
#undef PG8_LDA
#undef PG8_LDB
#undef PG8_MMA
#undef PG8_WAIT_V
#undef PG8_WAIT_L
#undef PG8_BAR
#undef PG8_SCHED
}
}
constexpr int DM = 1024, NCTX = 4096, NLAT = 8192, MROWS = 12288;
constexpr int CSEQ = 256, LSEQ = 1024, PAST = 512, LKEYS = 1536;
constexpr int INC = 4096, FF = 2816, FF2 = 5632, AW = 512;
constexpr float ALPHA = 1.189207115002721f, LN_EPS = 1e-5f;
constexpr float QSCALE = 0.125f * 1.4426950408889634f;
constexpr int NWAVES = 8, NTHR = 512;
constexpr int LDS_BYTES = 147456;
constexpr int RING_BYTES = 131072, MISC_OFF = RING_BYTES + 320;

constexpr size_t MiB = 1u << 20;
constexpr size_t WS_CTL = 0, CTL_ZERO_BYTES = 65536;
constexpr size_t WS_MOD = 1 * MiB;
constexpr size_t WS_ROPE = 1 * MiB + 512 * 1024;
constexpr size_t WS_WIN = 2 * MiB, WS_WOUT = 10 * MiB, WS_WUP = 12 * MiB, WS_WDN = 23 * MiB;
constexpr size_t WS_XM = 29 * MiB;
constexpr size_t WS_MIX = 29 * MiB;
constexpr size_t WS_IMG = 53 * MiB;
constexpr size_t IMG_BYTES = 17408;
constexpr size_t WS_Q = 155 * MiB, WS_KC = 167 * MiB, WS_VC = 171 * MiB, WS_KL = 175 * MiB, WS_VL = 187 * MiB;
constexpr size_t WS_RG = 199 * MiB, WS_OF = 211 * MiB, WS_OB = 223 * MiB;
constexpr size_t WS_H = 53 * MiB;
constexpr size_t WS_G = 185 * MiB;
constexpr size_t WS_END = 251 * MiB;
constexpr size_t OUT_Y = 0, OUT_K = 12582912, OUT_V = OUT_K + 2097152, OUT_S = OUT_V + 2097152;
constexpr int CW_BAR = 4096;

#define GAS __attribute__((address_space(1)))
#define LAS __attribute__((address_space(3)))
typedef unsigned short bf16;
typedef unsigned v4u __attribute__((ext_vector_type(4)));
typedef unsigned v2u __attribute__((ext_vector_type(2)));
typedef float f32x4 __attribute__((ext_vector_type(4)));
typedef short bf16x8 __attribute__((ext_vector_type(8)));
typedef GAS unsigned gu32;
#define RLX_AGENT __ATOMIC_RELAXED, __HIP_MEMORY_SCOPE_AGENT
#define LDS_WAIT() asm volatile("s_waitcnt lgkmcnt(0)" ::: "memory")
#define VM_WAIT() asm volatile("s_waitcnt vmcnt(0)" ::: "memory")
__device__ __forceinline__ unsigned f2bf(float f) { unsigned u = __builtin_bit_cast(unsigned, f); return (u + 0x7fffu + ((u >> 16) & 1u)) >> 16; }
typedef float f32x2_t __attribute__((ext_vector_type(2))); typedef __bf16 bf16x2_t __attribute__((ext_vector_type(2)));
__device__ __forceinline__ unsigned pk2(float lo, float hi) { f32x2_t v = {lo, hi}; bf16x2_t b = __builtin_convertvector(v, bf16x2_t); return __builtin_bit_cast(unsigned, b); }
__device__ __forceinline__ float bflo(unsigned w) { return __uint_as_float(w << 16); }
__device__ __forceinline__ float bfhi(unsigned w) { return __uint_as_float(w & 0xffff0000u); }
__device__ __forceinline__ float wave_sum(float v) {
#pragma unroll
    for (int o = 1; o < 64; o <<= 1) v += __shfl_xor(v, o);
    return v;
}
__device__ __forceinline__ float wave_max(float v) {
#pragma unroll
    for (int o = 1; o < 64; o <<= 1) v = fmaxf(v, __shfl_xor(v, o));
    return v;
}
__device__ __forceinline__ float sigmoidf_(float z) { return 1.0f / (1.0f + __expf(-z)); }
__device__ __forceinline__ float siluf_(float z) { return z / (1.0f + __expf(-z)); }

struct Args { const float* in[27]; float* out; unsigned char* ws; int ph_lo, ph_hi; };
#define XB_TMO      128
#define XB_XCNT(j)  (256  + 64 * (j))
#define XB_XSUB(j)  (1280 + 64 * (j))
#define XB_XGEN(j)  (2304 + 64 * (j))
#define XB_TOP      3328
#define XB_TOPGEN   3392
#define XCD_BAR_WORDS 3456
#define XB_SPIN_CAP (1u << 18)

__device__ __forceinline__ unsigned xb_ld(unsigned* p)              { return __hip_atomic_load(p, __ATOMIC_RELAXED, __HIP_MEMORY_SCOPE_AGENT); }
__device__ __forceinline__ unsigned xb_add(unsigned* p, unsigned v) { return __hip_atomic_fetch_add(p, v, __ATOMIC_RELAXED, __HIP_MEMORY_SCOPE_AGENT); }
__device__ __forceinline__ unsigned xb_xcc_id() { return (unsigned)__builtin_amdgcn_s_getreg((3 << 11) | 20) & 0xFu; }
#define XB_SPIN(cond, bar) do { unsigned _sp = 0; while (cond) { __builtin_amdgcn_s_sleep(1); \
    if ((++_sp & 255u) == 0u) { if (xb_ld(&(bar)[XB_TMO])) break; if (_sp > XB_SPIN_CAP) { atomicAdd(&(bar)[XB_TMO], 1u); break; } } } } while (0)

struct XcdBarrier {
    unsigned* bar; unsigned x;
    volatile LAS unsigned* st;
};

__device__ __forceinline__ XcdBarrier xcd_barrier_post(unsigned* bar, volatile LAS unsigned* st) {
    XcdBarrier b; b.bar = bar; b.x = xb_xcc_id(); b.st = st;
    if (threadIdx.x == 0) (void)xb_add(&bar[XB_XCNT(b.x)], 1u);
    return b;
}
__device__ __forceinline__ void xcd_barrier_complete(unsigned* bar, unsigned x, unsigned& nloc, unsigned& nx) {
    const unsigned G = gridDim.x * gridDim.y * gridDim.z;
    unsigned sum, cnt, mine, sp = 0u;
    for (;;) {
        sum = 0u; cnt = 0u; mine = 0u;
#pragma unroll
        for (unsigned j = 0; j < 16; ++j) { const unsigned c = xb_ld(&bar[XB_XCNT(j)]); sum += c; cnt += (c > 0u) ? 1u : 0u; mine = (j == x) ? c : mine; }
        if (sum == G) break;
        __builtin_amdgcn_s_sleep(1);
        if ((++sp & 255u) == 0u) { if (xb_ld(&bar[XB_TMO])) break; if (sp > XB_SPIN_CAP) { atomicAdd(&bar[XB_TMO], 1u); break; } }
    }
    nloc = mine > 0u ? mine : 1u; nx = cnt > 0u ? cnt : 1u;
}

__device__ __forceinline__ void xcd_barrier(const XcdBarrier& b) {
    asm volatile("s_waitcnt vmcnt(0)" ::: "memory");
    __syncthreads();
    if (threadIdx.x == 0) {
        unsigned* bar = b.bar;
        __builtin_amdgcn_s_waitcnt(0);
        unsigned nloc = b.st[0], nx = b.st[1];
        if (nloc == 0u) { xcd_barrier_complete(bar, b.x, nloc, nx); b.st[0] = nloc; b.st[1] = nx; }
        const unsigned old = xb_add(&bar[XB_XSUB(b.x)], 1u);
        const unsigned gen = old / nloc;
        if (old + 1u == (gen + 1u) * nloc) {
            __builtin_amdgcn_fence(__ATOMIC_RELEASE, "agent");
            asm volatile("s_waitcnt vmcnt(0)" ::: "memory");
            const unsigned og = xb_add(&bar[XB_TOP], 1u);
            const unsigned tg = og / nx;
            if (og + 1u == (tg + 1u) * nx) xb_add(&bar[XB_TOPGEN], 1u);
            else XB_SPIN(xb_ld(&bar[XB_TOPGEN]) == tg, bar);
            __builtin_amdgcn_fence(__ATOMIC_ACQUIRE, "agent");
            xb_add(&bar[XB_XGEN(b.x)], 1u);
            asm volatile("s_waitcnt vmcnt(0)" ::: "memory");
        } else {
            XB_SPIN(xb_ld(&bar[XB_XGEN(b.x)]) == gen, bar);
            __builtin_amdgcn_fence(__ATOMIC_ACQUIRE, "agent");
            asm volatile("s_waitcnt vmcnt(0)" ::: "memory");
        }
    }
    __syncthreads();
}

__device__ __forceinline__ int mod_index(int row) { return row < NCTX ? 0 : 1 + ((row - NCTX) >> 10); }
__device__ __forceinline__ const float* xrow_ptr(const float* xp, const float* xs, int row) { return row < NCTX ? xp + (size_t)row * DM : xs + (size_t)(row - NCTX) * DM; }
__device__ __forceinline__ v2u pk4(f32x4 v) { v2u w; w.x = pk2(v[0], v[1]); w.y = pk2(v[2], v[3]); return w; }

template <int CTRL> __device__ __forceinline__ float dpp_f(float x) { return __builtin_bit_cast(float, __builtin_amdgcn_update_dpp(0, __builtin_bit_cast(int, x), CTRL, 0xf, 0xf, true)); }
__device__ __forceinline__ float row_prefix(float x) { x += dpp_f<0x111>(x); x += dpp_f<0x112>(x); x += dpp_f<0x114>(x); x += dpp_f<0x118>(x); return x; }
__device__ __forceinline__ float row_suffix(float x) { x += dpp_f<0x101>(x); x += dpp_f<0x102>(x); x += dpp_f<0x104>(x); x += dpp_f<0x108>(x); return x; }
struct Epi1 {
    static constexpr bool PERM = false, AFTER_DRAIN = false;
    bf16 *Q, *KC, *VC, *KL, *VL, *RG; unsigned char* IMG; float *outK, *outV; const float* rope; const float *lbf, *lbb;
    __device__ __forceinline__ void operator()(const f32x4 (&acc)[2][2][4][2], const pg8::Unit& u, int wr, int wc, int fr, int fq) const {
        const bool ctx = u.pm < 16;
        if (u.pn < 4) {
            const int grp = u.pn >> 1, cbase = (u.pn & 1) * 256, half = wc & 1;
#pragma unroll
            for (int ai = 0; ai < 2; ++ai)
#pragma unroll
                for (int m = 0; m < 4; ++m) {
                    const int row = u.pm * 256 + ai * 128 + wr * 64 + m * 16 + fr;
                    f32x4 cs0 = (f32x4){1.f, 0.f, 1.f, 0.f}, cs1 = cs0;
                    if (!ctx) { const int t = (row - NCTX) & 1023; const int pos = half ? (t & 63) : (t >> 6);
                        const float* tp = rope + (size_t)pos * 32 + 8 * fq; cs0 = *(const f32x4*)tp; cs1 = *(const f32x4*)(tp + 4); }
#pragma unroll
                    for (int bj = 0; bj < 2; ++bj) {
                        const f32x4 x1 = acc[ai][bj][m][0], x2 = acc[ai][bj][m][1]; f32x4 o1, o2;
                        o1[0] = x1[0] * cs0[0] - x2[0] * cs0[1]; o2[0] = x1[0] * cs0[1] + x2[0] * cs0[0];
                        o1[1] = x1[1] * cs0[2] - x2[1] * cs0[3]; o2[1] = x1[1] * cs0[3] + x2[1] * cs0[2];
                        o1[2] = x1[2] * cs1[0] - x2[2] * cs1[1]; o2[2] = x1[2] * cs1[1] + x2[2] * cs1[0];
                        o1[3] = x1[3] * cs1[2] - x2[3] * cs1[3]; o2[3] = x1[3] * cs1[3] + x2[3] * cs1[2];
                        const int cg = cbase + bj * 128 + wc * 32 + 4 * fq;
                        if (grp == 0) { *(v2u*)(Q + (size_t)row * AW + cg) = pk4(o1 * QSCALE); *(v2u*)(Q + (size_t)row * AW + cg + 16) = pk4(o2 * QSCALE); }
                        else if (ctx) { *(f32x4*)(outK + (size_t)row * AW + cg) = x1; *(f32x4*)(outK + (size_t)row * AW + cg + 16) = x2;
                                        *(v2u*)(KC + (size_t)row * AW + cg) = pk4(x1); *(v2u*)(KC + (size_t)row * AW + cg + 16) = pk4(x2); }
                        else { const int b = (row - NCTX) >> 10, t = (row - NCTX) & 1023; bf16* kp = KL + ((size_t)b * LKEYS + PAST + t) * AW + cg;
                               *(v2u*)kp = pk4(o1); *(v2u*)(kp + 16) = pk4(o2); }
                    }
                }
            return;
        }
        if (u.pn >= 6 && u.pn < 14) {
            const int T = u.pn - 6, head = T >> 1, chg = 64 * T + 16 * wc + 4 * fq, d0 = 64 * (T & 1) + 16 * wc + 4 * fq;
            const int chunk16 = 8 * (T & 1) + 4 * (wc >> 1) + fq, inoff = 8 * (wc & 1);
            f32x4 lf4, lb4;
            { const f32x4 a0 = *(const f32x4*)(lbf + chg), a1 = *(const f32x4*)(lbf + AW + chg), b0 = *(const f32x4*)(lbb + chg), b1 = *(const f32x4*)(lbb + AW + chg);
#pragma unroll
              for (int i = 0; i < 4; ++i) { lf4[i] = sigmoidf_(a0[i] - a1[i]); lb4[i] = sigmoidf_(b0[i] - b1[i]); } }
            const int lane15 = (threadIdx.x & 48) | 15;
#pragma unroll
            for (int ai = 0; ai < 2; ++ai)
#pragma unroll
                for (int m = 0; m < 4; ++m) {
                    const int row = u.pm * 256 + ai * 128 + wr * 64 + m * 16 + fr, chunk = row >> 4;
                    unsigned char* imf = IMG + ((size_t)(chunk * 4 + head) * 2) * IMG_BYTES; unsigned char* imb = imf + IMG_BYTES;
                    const f32x4 q4 = acc[ai][0][m][0], zf = acc[ai][0][m][1], zb = acc[ai][1][m][0], v4 = acc[ai][1][m][1];
                    const int sf = fr, sb = 15 - fr;
                    f32x4 qef, kdf, kef, qeb, kdb, keb, decf, decb;
#pragma unroll
                    for (int i = 0; i < 4; ++i) {
                        const float ff = lf4[i] + (1.0f - lf4[i]) * sigmoidf_(zf[i]), fb = lb4[i] + (1.0f - lb4[i]) * sigmoidf_(zb[i]);
                        const float cf = row_prefix(__logf(ff)), cb = row_suffix(__logf(fb));
                        const float tf = __shfl(cf, lane15), tb = __shfl(cb, lane15 - 15);
                        const float ef = __expf(cf), eb = __expf(cb), rf_ = __builtin_amdgcn_rcpf(ef), rb_ = __builtin_amdgcn_rcpf(eb), df = __expf(tf), db = __expf(tb);
                        qef[i] = q4[i] * ef; kdf[i] = (1.0f - ff) * rf_; kef[i] = (1.0f - ff) * rf_ * df; decf[i] = df;
                        qeb[i] = q4[i] * eb; kdb[i] = (1.0f - fb) * rb_; keb[i] = (1.0f - fb) * rb_ * db; decb[i] = db;
                    }
                    *(v2u*)(imf + sf * 256 + 16 * (chunk16 ^ sf) + inoff) = pk4(qef); *(v2u*)(imf + 4096 + sf * 256 + 16 * (chunk16 ^ sf) + inoff) = pk4(kdf);
                    *(v2u*)(imb + sb * 256 + 16 * (chunk16 ^ sb) + inoff) = pk4(qeb); *(v2u*)(imb + 4096 + sb * 256 + 16 * (chunk16 ^ sb) + inoff) = pk4(kdb);
                    const v2u kfw = pk4(kef), kbw = pk4(keb), vw = pk4(v4);
#pragma unroll
                    for (int i = 0; i < 4; ++i) { const unsigned sh = (i & 1) * 16; const unsigned short a_ = (unsigned short)((i < 2 ? kfw.x : kfw.y) >> sh), b_ = (unsigned short)((i < 2 ? kbw.x : kbw.y) >> sh), v_ = (unsigned short)((i < 2 ? vw.x : vw.y) >> sh);
                        *(bf16*)(imf + 8192 + (d0 + i) * 32 + sf * 2) = a_; *(bf16*)(imb + 8192 + (d0 + i) * 32 + sb * 2) = b_;
                        *(bf16*)(imf + 12288 + (d0 + i) * 32 + sf * 2) = v_; *(bf16*)(imb + 12288 + (d0 + i) * 32 + sb * 2) = v_; }
                    if (fr == 0) { *(f32x4*)(imf + 16384 + d0 * 4) = decf; *(f32x4*)(imb + 16384 + d0 * 4) = decb; }
                }
            return;
        }
        const int cbase = (u.pn & 1) * 256;
#pragma unroll
        for (int ai = 0; ai < 2; ++ai)
#pragma unroll
            for (int m = 0; m < 4; ++m) {
                const int row = u.pm * 256 + ai * 128 + wr * 64 + m * 16 + fr;
#pragma unroll
                for (int bj = 0; bj < 2; ++bj)
#pragma unroll
                    for (int n = 0; n < 2; ++n) {
                        const int cg = cbase + bj * 128 + wc * 32 + n * 16 + 4 * fq; const f32x4 v = acc[ai][bj][m][n]; const size_t o = (size_t)row * AW + cg;
                        if (u.pn < 6) { const int head = (cbase >> 7) + bj, e0 = wc * 32 + n * 16 + 4 * fq;
                                        if (ctx) { *(f32x4*)(outV + o) = v; const int b = row >> 8, l = row & 255; bf16* vp = VC + ((size_t)(b * 4 + head) * 128 + e0) * CSEQ + l;
#pragma unroll
                                            for (int i = 0; i < 4; ++i) vp[(size_t)i * CSEQ] = (bf16)f2bf(v[i]); }
                                        else { const int b = (row - NCTX) >> 10, t = (row - NCTX) & 1023; bf16* vp = VL + ((size_t)(b * 4 + head) * 128 + e0) * LKEYS + PAST + t;
#pragma unroll
                                            for (int i = 0; i < 4; ++i) vp[(size_t)i * LKEYS] = (bf16)f2bf(v[i]); } }
                        else { f32x4 w;
#pragma unroll
                            for (int i = 0; i < 4; ++i) w[i] = siluf_(v[i]);
                            *(v2u*)(RG + o) = pk4(w); }
                    }
            }
    }
};
struct EpiRes {
    static constexpr bool PERM = false, AFTER_DRAIN = false;
    const float *xp, *xs; const float* ybase; float* out; const float* gate;
    __device__ __forceinline__ void operator()(const f32x4 (&acc)[2][2][4][2], const pg8::Unit& u, int wr, int wc, int fr, int fq) const {
        const int mi = u.pm < 16 ? 0 : 1 + ((u.pm - 16) >> 2); const float* gp = gate + (size_t)mi * 6144;
        f32x4 gv[2][2];
#pragma unroll
        for (int bj = 0; bj < 2; ++bj)
#pragma unroll
            for (int n = 0; n < 2; ++n) gv[bj][n] = *(const f32x4*)(gp + u.pn * 256 + bj * 128 + wc * 32 + n * 16 + 4 * fq);
#pragma unroll
        for (int ai = 0; ai < 2; ++ai)
#pragma unroll
            for (int m = 0; m < 4; ++m) {
                const int row = u.pm * 256 + ai * 128 + wr * 64 + m * 16 + fr;
                const float* bp = ybase ? ybase + (size_t)row * DM : xrow_ptr(xp, xs, row);
#pragma unroll
                for (int bj = 0; bj < 2; ++bj)
#pragma unroll
                    for (int n = 0; n < 2; ++n) { const int col = u.pn * 256 + bj * 128 + wc * 32 + n * 16 + 4 * fq;
                        const f32x4 b = *(const f32x4*)(bp + col); *(f32x4*)(out + (size_t)row * DM + col) = b * ALPHA + gv[bj][n] * acc[ai][bj][m][n]; }
            }
    }
};
struct EpiH {
    static constexpr bool PERM = false, AFTER_DRAIN = false;
    bf16* H;
    __device__ __forceinline__ void operator()(const f32x4 (&acc)[2][2][4][2], const pg8::Unit& u, int wr, int wc, int fr, int fq) const {
#pragma unroll
        for (int ai = 0; ai < 2; ++ai)
#pragma unroll
            for (int m = 0; m < 4; ++m) {
                const int row = u.pm * 256 + ai * 128 + wr * 64 + m * 16 + fr;
#pragma unroll
                for (int bj = 0; bj < 2; ++bj)
#pragma unroll
                    for (int n = 0; n < 2; ++n) { const int col = u.pn * 256 + bj * 128 + wc * 32 + n * 16 + 4 * fq; *(v2u*)(H + (size_t)row * FF2 + col) = pk4(acc[ai][bj][m][n]); }
            }
    }
};
__device__ __forceinline__ int win_row(int n) {
    if (n < 1536 || n >= 3584) return n;
    const int ty = (n - 1536) >> 9, ch = (n - 1536) & 511, T = ch >> 6, wc = (ch >> 4) & 3, j = ch & 15;
    return 1536 + 256 * T + 128 * (ty >> 1) + 32 * wc + 16 * (ty & 1) + j;
}
template <bool WIN> __device__ __forceinline__ void p0_transpose_item(const float* W, int K, int N, bf16* WT, int k0, int n0, int orow0, LAS float* scr, int lane) {
#pragma unroll 8
    for (int i = 0; i < 32; ++i) { const int kk = 2 * i + (lane >> 5); scr[kk * 33 + (lane & 31)] = W[(size_t)(k0 + kk) * N + n0 + (lane & 31)]; }
    LDS_WAIT(); asm volatile("" ::: "memory");
    const int c = lane & 7;
#pragma unroll
    for (int j = 0; j < 4; ++j) { const int n = (lane >> 3) + 8 * j; const LAS float* s = scr + (8 * c) * 33 + n;
        v4u o; o.x = pk2(s[0 * 33], s[1 * 33]); o.y = pk2(s[2 * 33], s[3 * 33]); o.z = pk2(s[4 * 33], s[5 * 33]); o.w = pk2(s[6 * 33], s[7 * 33]);
        *(GAS v4u*)(WT + (size_t)(WIN ? win_row(n0 + n) : orow0 + n) * K + k0 + 8 * c) = o; }
    LDS_WAIT(); asm volatile("" ::: "memory");
}
__device__ __forceinline__ void p0_prologue(const Args& a, LAS unsigned char* lds, int vcu, int G, int tid, int lane, int wave) {
    unsigned char* ws = a.ws;
    {
        LAS float* cl = (LAS float*)lds;
        LAS float* red = (LAS float*)(lds + 40960);
        float* mod = (float*)(ws + WS_MOD);
        const float* wada = a.in[7]; const float* bada = a.in[8];
        bool filled = false;
        for (int cb = vcu; cb < 192; cb += G) {
            if (!filled) {
                for (int i = tid; i < 9 * 1024; i += NTHR) { const int m = i >> 10, k = i & 1023; const float v = (m == 0) ? a.in[6][k] : a.in[5][(m - 1) * 1024 + k]; cl[i] = siluf_(v); }
                filled = true; __syncthreads();
            }
            const int n0 = cb * 32, kr = lane >> 3, c4 = lane & 7;
            f32x4 acc[9];
#pragma unroll
            for (int m = 0; m < 9; ++m) acc[m] = (f32x4){0.f, 0.f, 0.f, 0.f};
            for (int it = 0; it < 16; ++it) { const int k = wave * 128 + it * 8 + kr; const f32x4 wv = *(const f32x4*)(wada + (size_t)k * 6144 + n0 + 4 * c4);
#pragma unroll
                for (int m = 0; m < 9; ++m) acc[m] += wv * cl[m * 1024 + k]; }
#pragma unroll
            for (int m = 0; m < 9; ++m)
#pragma unroll
                for (int i = 0; i < 4; ++i) { float v = acc[m][i]; v += __shfl_xor(v, 8); v += __shfl_xor(v, 16); v += __shfl_xor(v, 32); acc[m][i] = v; }
            if (kr == 0) {
#pragma unroll
                for (int m = 0; m < 9; ++m) *(LAS f32x4*)(red + (wave * 9 + m) * 32 + 4 * c4) = acc[m]; }
            __syncthreads();
            if (tid < 288) { const int m = tid >> 5, cc = tid & 31; float s = bada[n0 + cc];
#pragma unroll
                for (int w = 0; w < 8; ++w) s += red[(w * 9 + m) * 32 + cc];
                mod[(size_t)m * 6144 + n0 + cc] = s; }
            __syncthreads();
        }
        __syncthreads();
    }
    if (vcu == (G > 200 ? 200 : 0)) {
        float* rope = (float*)(ws + WS_ROPE);
        for (int i = tid; i < 1024; i += NTHR) { const int pos = i >> 4, j = i & 15;
            const float freq = 1.0f / powf(10000.0f, (float)j * (1.0f / 16.0f)); const float angf = (float)pos * freq; const double ang = (double)angf;
            const double nq = __builtin_rint(ang * 0.63661977236758134308); const double r = __builtin_fma(-nq, 1.5707963267948966192, ang) - nq * 6.123233995736766e-17; const double r2 = r * r;
            double sn = r * (1.0 + r2 * (-1.0 / 6 + r2 * (1.0 / 120 + r2 * (-1.0 / 5040 + r2 * (1.0 / 362880 + r2 * (-1.0 / 39916800 + r2 * (1.0 / 6227020800.0)))))));
            double cn = 1.0 + r2 * (-0.5 + r2 * (1.0 / 24 + r2 * (-1.0 / 720 + r2 * (1.0 / 40320 + r2 * (-1.0 / 3628800 + r2 * (1.0 / 479001600 + r2 * (-1.0 / 87178291200.0)))))));
            const int q = ((int)nq) & 3; double cc, ss;
            if (q == 0) { cc = cn; ss = sn; } else if (q == 1) { cc = -sn; ss = cn; } else if (q == 2) { cc = -cn; ss = -sn; } else { cc = sn; ss = -cn; }
            rope[2 * i] = (float)cc; rope[2 * i + 1] = (float)ss; }
    }
    {
        bf16* KL = (bf16*)(ws + WS_KL); bf16* VL = (bf16*)(ws + WS_VL);
        const int gt = vcu * NTHR + tid, NGT = G * NTHR;
        for (int i = gt; i < 524288; i += NGT) { const int rowi = i >> 7, c4 = i & 127, b = rowi >> 9, j = rowi & 511;
            const f32x4 v = *(const f32x4*)(a.in[2] + (size_t)i * 4);
            *(v2u*)(KL + ((size_t)b * LKEYS + j) * AW + 4 * c4) = pk4(v); }
        for (int i = gt; i < 524288; i += NGT) { const int j = i & 511, c4 = (i >> 9) & 127, b = i >> 16;
            const f32x4 v = *(const f32x4*)(a.in[3] + ((size_t)(b * 512 + j) * 512 + 4 * c4));
            bf16* vp = VL + ((size_t)b * 512 + 4 * c4) * LKEYS + j;
#pragma unroll
            for (int k = 0; k < 4; ++k) vp[(size_t)k * LKEYS] = (bf16)f2bf(v[k]); }
    }
    {
        LAS float* scr = (LAS float*)(lds + wave * 16384);
        const int gw = vcu * NWAVES + wave, NGW = G * NWAVES;
        constexpr int I_IN = 16 * 128, I_OUT = 16 * 32, I_UP = 16 * 176, I_DN = 44 * 32, NITEMS = I_IN + I_OUT + I_UP + I_DN;
        for (int it = gw; it < NITEMS; it += NGW) {
            int r = it;
            if (r < I_IN) { const int kb = r / 128, nb = r % 128; p0_transpose_item<true>(a.in[9], DM, INC, (bf16*)(ws + WS_WIN), 64 * kb, 32 * nb, 32 * nb, scr, lane); continue; } r -= I_IN;
            if (r < I_OUT) { const int kb = r / 32, nb = r % 32; p0_transpose_item<false>(a.in[18], DM, DM, (bf16*)(ws + WS_WOUT), 64 * kb, 32 * nb, 32 * nb, scr, lane); continue; } r -= I_OUT;
            if (r < I_UP) { const int kb = r / 176, nb = r % 176, n0 = 32 * nb; const int n1 = n0 < FF ? n0 : n0 - FF; const int orow = 256 * (n1 >> 7) + (n0 < FF ? 0 : 128) + (n1 & 127);
                p0_transpose_item<false>(a.in[21], DM, FF2, (bf16*)(ws + WS_WUP), 64 * kb, n0, orow, scr, lane); continue; } r -= I_UP;
            { const int kb = r / 32, nb = r % 32; p0_transpose_item<false>(a.in[24], FF, DM, (bf16*)(ws + WS_WDN), 64 * kb, 32 * nb, 32 * nb, scr, lane); }
        }
    }
}
__device__ __forceinline__ void p1_modulate(const Args& a, int vcu, int G, int lane, int wave) {
    const float* mod = (const float*)(a.ws + WS_MOD); bf16* XM = (bf16*)(a.ws + WS_XM);
    const int gw = vcu * NWAVES + wave, NGW = G * NWAVES;
    for (int row = gw; row < MROWS; row += NGW) {
        const float* xr = xrow_ptr(a.in[0], a.in[1], row); const float* mp = mod + (size_t)mod_index(row) * 6144;
#pragma unroll
        for (int j = 0; j < 4; ++j) { const int c = 4 * (lane + 64 * j); const f32x4 x = *(const f32x4*)(xr + c), sh = *(const f32x4*)(mp + c), sc = *(const f32x4*)(mp + 1024 + c);
            *(v2u*)(XM + (size_t)row * DM + c) = pk4(x * (sc + 1.0f) + sh); }
    }
}
__device__ __forceinline__ void ln_rows(const Args& a, const float* g, const float* bta, bool write_xm, int vcu, int G, int lane, int wave) {
    float* Y = a.out + OUT_Y; const float* mod = (const float*)(a.ws + WS_MOD); bf16* XM = (bf16*)(a.ws + WS_XM);
    const int gw = vcu * NWAVES + wave, NGW = G * NWAVES;
    for (int row = gw; row < MROWS; row += NGW) {
        float* yr = Y + (size_t)row * DM; f32x4 v[4]; float s = 0.f;
#pragma unroll
        for (int j = 0; j < 4; ++j) { v[j] = *(const f32x4*)(yr + 4 * (lane + 64 * j)); s += (v[j][0] + v[j][1]) + (v[j][2] + v[j][3]); }
        const float mean = wave_sum(s) * (1.0f / DM); float s2 = 0.f;
#pragma unroll
        for (int j = 0; j < 4; ++j) { v[j] = v[j] - mean; s2 += (v[j][0] * v[j][0] + v[j][1] * v[j][1]) + (v[j][2] * v[j][2] + v[j][3] * v[j][3]); }
        const float rstd = 1.0f / sqrtf(wave_sum(s2) * (1.0f / DM) + LN_EPS);
        const float* mp = mod + (size_t)mod_index(row) * 6144;
#pragma unroll
        for (int j = 0; j < 4; ++j) { const int c = 4 * (lane + 64 * j); const f32x4 x1 = v[j] * rstd * *(const f32x4*)(g + c) + *(const f32x4*)(bta + c);
            *(f32x4*)(yr + c) = x1;
            if (write_xm) { const f32x4 sh = *(const f32x4*)(mp + 3072 + c), sc = *(const f32x4*)(mp + 4096 + c); *(v2u*)(XM + (size_t)row * DM + c) = pk4(x1 * (sc + 1.0f) + sh); } }
    }
}
__device__ __forceinline__ void conv_gate(const Args& a, int vcu, int G, int tid) {
    const bf16* H = (const bf16*)(a.ws + WS_H); bf16* Gt = (bf16*)(a.ws + WS_G); const float* cw = a.in[22]; const float* cb = a.in[23];
    const int gt = vcu * NTHR + tid, NGT = G * NTHR; constexpr int PER_ROW = 22 * 32;
    for (int i = gt; i < MROWS * PER_ROW; i += NGT) {
        const int row = i / PER_ROW, r2 = i % PER_ROW, pn = r2 >> 5, jj = (r2 & 31) * 4;
        const int t = row < NCTX ? (row & 255) : ((row - NCTX) & 1023), L = row < NCTX ? CSEQ : LSEQ;
        const bool hp = t > 0, hn = t < L - 1;
        const int ca = 128 * pn + jj, cu = FF + ca;
        const bf16* hp0 = H + (size_t)row * FF2 + 256 * pn + jj;
        const v2u z = (v2u){0u, 0u};
        const v2u a0 = hp ? *(const v2u*)(hp0 - FF2) : z, a1 = *(const v2u*)hp0, a2 = hn ? *(const v2u*)(hp0 + FF2) : z;
        const v2u u0 = hp ? *(const v2u*)(hp0 - FF2 + 128) : z, u1 = *(const v2u*)(hp0 + 128), u2 = hn ? *(const v2u*)(hp0 + FF2 + 128) : z;
        const f32x4 wa0 = *(const f32x4*)(cw + ca), wa1 = *(const f32x4*)(cw + FF2 + ca), wa2 = *(const f32x4*)(cw + 2 * FF2 + ca), ba = *(const f32x4*)(cb + ca);
        const f32x4 wu0 = *(const f32x4*)(cw + cu), wu1 = *(const f32x4*)(cw + FF2 + cu), wu2 = *(const f32x4*)(cw + 2 * FF2 + cu), bu = *(const f32x4*)(cb + cu);
        const f32x4 A0 = (f32x4){bflo(a0.x), bfhi(a0.x), bflo(a0.y), bfhi(a0.y)}, A1 = (f32x4){bflo(a1.x), bfhi(a1.x), bflo(a1.y), bfhi(a1.y)}, A2 = (f32x4){bflo(a2.x), bfhi(a2.x), bflo(a2.y), bfhi(a2.y)};
        const f32x4 U0 = (f32x4){bflo(u0.x), bfhi(u0.x), bflo(u0.y), bfhi(u0.y)}, U1 = (f32x4){bflo(u1.x), bfhi(u1.x), bflo(u1.y), bfhi(u1.y)}, U2 = (f32x4){bflo(u2.x), bfhi(u2.x), bflo(u2.y), bfhi(u2.y)};
        const f32x4 av = A0 * wa0 + A1 * wa1 + A2 * wa2 + ba, uv = U0 * wu0 + U1 * wu1 + U2 * wu2 + bu; f32x4 gv;
#pragma unroll
        for (int k = 0; k < 4; ++k) gv[k] = siluf_(av[k]) * uv[k];
        *(v2u*)(Gt + (size_t)row * FF + ca) = pk4(gv);
    }
}
__device__ __forceinline__ float calc_lam(const Args& a, int lane) {
    const float s1 = wave_sum(a.in[10][lane] * a.in[11][lane]), s2 = wave_sum(a.in[12][lane] * a.in[13][lane]);
    return expf(s1) - expf(s2) + 0.2f;
}
constexpr int RN_SLOT = 17408, RN_NSLOT = 4;
#define RN_WAITV(n) asm volatile("s_waitcnt vmcnt(" #n ")" ::: "memory")
__device__ __forceinline__ void rnn_item(const Args& a, LAS unsigned char* lds, int item, int tid, int lane, int wave) {
    unsigned char* ws = a.ws;
    const bf16* RG = (const bf16*)(ws + WS_RG); bf16* OF = (bf16*)(ws + WS_OF); bf16* OB = (bf16*)(ws + WS_OB); bf16* MIX = (bf16*)(ws + WS_MIX); const float* rnng = a.in[17];
    const int fr = lane & 15, g = lane >> 4, e = 16 * wave + fr;
    const bool ctx = item < 64; const int bi = ctx ? item : item - 64, b = bi >> 2, h = bi & 3;
    const int L = ctx ? CSEQ : LSEQ, row0 = ctx ? b * CSEQ : NCTX + b * LSEQ, NC = L / 16, chunk0 = row0 >> 4;
    const unsigned ldsw = (unsigned)wave * 1024u;
    for (int dir = 0; dir < 2; ++dir) {
        f32x4 acc[8];
        if (ctx) {
#pragma unroll
            for (int i = 0; i < 8; ++i) acc[i] = (f32x4){0.f, 0.f, 0.f, 0.f};
        } else { const float* s0 = a.in[4] + ((size_t)(b * 2 + dir) * 4 + h) * 16384;
#pragma unroll
            for (int i = 0; i < 8; ++i)
#pragma unroll
                for (int r = 0; r < 4; ++r) acc[i][r] = s0[(size_t)(16 * i + 4 * g + r) * 128 + e]; }
        asm volatile("s_waitcnt vmcnt(0)" ::: "memory");
        const unsigned char* img0 = ws + WS_IMG + ((size_t)(chunk0 * 4 + h) * 2 + dir) * IMG_BYTES;
        bf16* OD = dir ? OB : OF;
#define RN_STAGE(c_) do { const int cc_ = (c_) < NC ? (c_) : NC - 1; const unsigned char* src_ = img0 + (size_t)(dir ? NC - 1 - cc_ : cc_) * (8 * IMG_BYTES) + lane * 16; \
        LAS unsigned char* dst_ = lds + ((c_) & 3) * RN_SLOT; \
        __builtin_amdgcn_global_load_lds((const unsigned*)(src_ + ldsw), (LAS unsigned*)(dst_ + ldsw), 16, 0, 0); \
        __builtin_amdgcn_global_load_lds((const unsigned*)(src_ + ldsw + 8192), (LAS unsigned*)(dst_ + ldsw + 8192), 16, 0, 0); \
        __builtin_amdgcn_global_load_lds((const unsigned*)(src_ + 16384), (LAS unsigned*)(dst_ + 16384), 16, 0, 0); } while (0)
        RN_STAGE(0); RN_STAGE(1); RN_STAGE(2);
        for (int c = 0; c < NC; ++c) {
            if (c >= 3) RN_WAITV(18); else if (c == 2) RN_WAITV(14); else if (c == 1) RN_WAITV(10); else RN_WAITV(6);
            __builtin_amdgcn_s_barrier(); asm volatile("" ::: "memory");
            RN_STAGE(c + 3);
            LAS unsigned char* buf = lds + (c & 3) * RN_SLOT;
            bf16x8 qf[4], kf[4];
#pragma unroll
            for (int kk = 0; kk < 4; ++kk) { const int off = fr * 256 + 16 * ((4 * kk + g) ^ fr); qf[kk] = *(const LAS bf16x8*)(buf + off); kf[kk] = *(const LAS bf16x8*)(buf + 4096 + off); }
            const v2u vw = *(const LAS v2u*)(buf + 12288 + e * 32 + g * 8);
            const bf16x8 vb = __builtin_bit_cast(bf16x8, (v4u){vw.x, vw.y, 0u, 0u});
            f32x4 pT = (f32x4){0.f, 0.f, 0.f, 0.f};
#pragma unroll
            for (int kk = 0; kk < 4; ++kk) pT = __builtin_amdgcn_mfma_f32_16x16x32_bf16(kf[kk], qf[kk], pT, 0, 0, 0);
#pragma unroll
            for (int r = 0; r < 4; ++r) pT[r] = (4 * g + r <= fr) ? pT[r] : 0.f;
            const bf16x8 pa = __builtin_bit_cast(bf16x8, (v4u){pk2(pT[0], pT[1]), pk2(pT[2], pT[3]), 0u, 0u});
            f32x4 o = __builtin_amdgcn_mfma_f32_16x16x32_bf16(pa, vb, (f32x4){0.f, 0.f, 0.f, 0.f}, 0, 0, 0);
#pragma unroll
            for (int kk = 0; kk < 4; ++kk) {
                const bf16x8 sb = __builtin_bit_cast(bf16x8, (v4u){pk2(acc[2 * kk][0], acc[2 * kk][1]), pk2(acc[2 * kk][2], acc[2 * kk][3]), pk2(acc[2 * kk + 1][0], acc[2 * kk + 1][1]), pk2(acc[2 * kk + 1][2], acc[2 * kk + 1][3])});
                o = __builtin_amdgcn_mfma_f32_16x16x32_bf16(qf[kk], sb, o, 0, 0, 0); }
#pragma unroll
            for (int i = 0; i < 8; ++i) { const f32x4 dc = *(const LAS f32x4*)(buf + 16384 + (16 * i + 4 * g) * 4);
                const v2u kw = *(const LAS v2u*)(buf + 8192 + (16 * i + fr) * 32 + g * 8); const bf16x8 ka = __builtin_bit_cast(bf16x8, (v4u){kw.x, kw.y, 0u, 0u});
                acc[i] = __builtin_amdgcn_mfma_f32_16x16x32_bf16(ka, vb, acc[i] * dc, 0, 0, 0); }
            { const int s0_ = c * 16 + 4 * g, t0 = dir ? L - 1 - s0_ : s0_; bf16* op = OD + (size_t)(row0 + t0) * AW + h * 128 + e; const int st = dir ? -AW : AW;
              const unsigned w01 = pk2(o[0], o[1]), w23 = pk2(o[2], o[3]);
              op[0] = (bf16)w01; op[st] = (bf16)(w01 >> 16); op[2 * st] = (bf16)w23; op[3 * st] = (bf16)(w23 >> 16); }
        }
#undef RN_STAGE
        asm volatile("s_waitcnt vmcnt(0)" ::: "memory");
        if (ctx) { float* so = a.out + OUT_S + ((size_t)(b * 2 + dir) * 4 + h) * 16384;
#pragma unroll
            for (int i = 0; i < 8; ++i)
#pragma unroll
                for (int r = 0; r < 4; ++r) so[(size_t)(16 * i + 4 * g + r) * 128 + e] = acc[i][r]; }
        __threadfence(); __syncthreads();
    }
    { const float2 gn = *(const float2*)(rnng + h * 128 + 2 * lane);
      for (int tb = 0; tb < L; tb += 64) {
        unsigned o1[8], o2[8], gw[8];
#pragma unroll
        for (int j = 0; j < 8; ++j) { const size_t o = (size_t)(row0 + tb + 8 * wave + j) * AW + h * 128 + 2 * lane; o1[j] = *(const unsigned*)(OF + o); o2[j] = *(const unsigned*)(OB + o); gw[j] = *(const unsigned*)(RG + o); }
#pragma unroll
        for (int j = 0; j < 8; ++j) { const float ox = bflo(o1[j]) + bflo(o2[j]), oy = bfhi(o1[j]) + bfhi(o2[j]); const float ss = wave_sum(ox * ox + oy * oy); const float r = __builtin_amdgcn_rsqf(ss * (1.0f / 128.0f) + LN_EPS);
            *(unsigned*)(MIX + (size_t)(row0 + tb + 8 * wave + j) * DM + AW + h * 128 + 2 * lane) = pk2(ox * r * gn.x * bflo(gw[j]), oy * r * gn.y * bfhi(gw[j])); }
      } }
    __syncthreads();
}
typedef float f32x16 __attribute__((ext_vector_type(16)));
constexpr int AT_K = 0, AT_V = 32768, AT_TILE = 16384;
__device__ __forceinline__ int crow16(int r, int hi) { return (r & 3) + 8 * (r >> 2) + 4 * hi; }
__device__ __forceinline__ void attn_unit(const Args& a, LAS unsigned char* lds, int unit, float lam, int tid, int lane, int wave) {
    unsigned char* ws = a.ws;
    const bool ctx = unit >= 256; const int ui = ctx ? unit - 256 : unit;
    const int qb = ctx ? (ui & 1) : (ui & 7), bh = ctx ? (ui >> 1) : (ui >> 3), b = bh >> 2, h = bh & 3;
    const int nk = ctx ? CSEQ : LKEYS, NT = nk / 64, row0 = (ctx ? b * CSEQ : NCTX + b * LSEQ) + qb * 128;
    const bf16* Kp = (const bf16*)(ws + (ctx ? WS_KC : WS_KL)) + (size_t)b * nk * AW + h * 128;
    const bf16* Vp = (const bf16*)(ws + (ctx ? WS_VC : WS_VL)) + (size_t)bh * 128 * nk;
    const int rg = wave & 3, map = wave >> 2, r32 = lane & 31, hi = lane >> 5;
    const int qrow = row0 + rg * 32 + r32;
    bf16x8 qf[4];
    { const bf16* qp = (const bf16*)(ws + WS_Q) + (size_t)qrow * AW + h * 128 + map * 64 + 8 * hi;
#pragma unroll
      for (int ks = 0; ks < 4; ++ks) qf[ks] = *(const bf16x8*)(qp + 16 * ks); }
    const int krow = tid >> 4, kch = tid & 15, ve = tid >> 3, vch = tid & 7, vxx = (ve >> 1) & 15;
    const unsigned ksrc = (unsigned)(krow * AW + kch * 8), vsrc = (unsigned)(ve * nk + vch * 8);
    const int kdst = AT_K + 256 * krow + 16 * (kch ^ (((krow & 3) << 2) | ((krow >> 2) & 3))), vdst = AT_V + 128 * ve + 16 * (vch ^ (vxx >> 1)); const bool vswap = vxx & 1;
    v4u kr[2], vr[2];
#define AT_LOAD(t) do { _Pragma("unroll") for (int i_ = 0; i_ < 2; ++i_) { kr[i_] = *(const v4u*)(Kp + ksrc + (size_t)((t) * 64 + 32 * i_) * AW); vr[i_] = *(const v4u*)(Vp + vsrc + (size_t)(64 * i_) * nk + (t) * 64); } } while (0)
#define AT_STORE(bufo) do { _Pragma("unroll") for (int i_ = 0; i_ < 2; ++i_) { *(LAS v4u*)(lds + (bufo) + kdst + 8192 * i_) = kr[i_]; \
        const v4u vv_ = vswap ? (v4u){vr[i_].z, vr[i_].w, vr[i_].x, vr[i_].y} : vr[i_]; *(LAS v4u*)(lds + (bufo) + vdst + 8192 * i_) = vv_; } } while (0)
    int koff[4];
    { const int x = ((r32 & 3) << 2) | ((r32 >> 2) & 3);
#pragma unroll
      for (int ks = 0; ks < 4; ++ks) koff[ks] = AT_K + 256 * r32 + 16 * ((8 * map + 2 * ks + hi) ^ x); }
    const int vbase = AT_V + 128 * r32, vx = 8 * ((r32 >> 1) & 15);
    f32x16 O[4];
#pragma unroll
    for (int eb = 0; eb < 4; ++eb)
#pragma unroll
        for (int r = 0; r < 16; ++r) O[eb][r] = 0.f;
    float m_run = -1.0e30f, l_run = 0.f;
    AT_LOAD(0); AT_STORE(0);
    if (NT > 1) AT_LOAD(1);
    __syncthreads();
    for (int t = 0; t < NT; ++t) {
        const int cur = (t & 1) * AT_TILE;
        f32x16 st[2];
#pragma unroll
        for (int mb = 0; mb < 2; ++mb) {
#pragma unroll
            for (int r = 0; r < 16; ++r) st[mb][r] = 0.f;
#pragma unroll
            for (int ks = 0; ks < 4; ++ks) { const bf16x8 kf = *(const LAS bf16x8*)(lds + cur + koff[ks] + 8192 * mb); st[mb] = __builtin_amdgcn_mfma_f32_32x32x16_bf16(kf, qf[ks], st[mb], 0, 0, 0); } }
        if (t + 1 < NT) { AT_STORE(AT_TILE - cur); if (t + 2 < NT) AT_LOAD(t + 2); }
        float mx = st[0][0];
#pragma unroll
        for (int r = 1; r < 16; ++r) mx = fmaxf(mx, st[0][r]);
#pragma unroll
        for (int r = 0; r < 16; ++r) mx = fmaxf(mx, st[1][r]);
        mx = fmaxf(mx, __shfl_xor(mx, 32));
        if (__any(mx > m_run)) { const float mn = fmaxf(m_run, mx), f = __builtin_amdgcn_exp2f(m_run - mn); m_run = mn; l_run *= f;
#pragma unroll
            for (int eb = 0; eb < 4; ++eb)
#pragma unroll
                for (int r = 0; r < 16; ++r) O[eb][r] *= f; }
        bf16x8 pf[2][2]; float ls = 0.f;
#pragma unroll
        for (int mb = 0; mb < 2; ++mb) {
#pragma unroll
            for (int r = 0; r < 16; ++r) { st[mb][r] = __builtin_amdgcn_exp2f(st[mb][r] - m_run); ls += st[mb][r]; }
#pragma unroll
            for (int sp = 0; sp < 2; ++sp) pf[mb][sp] = __builtin_bit_cast(bf16x8, (v4u){pk2(st[mb][8 * sp], st[mb][8 * sp + 1]), pk2(st[mb][8 * sp + 2], st[mb][8 * sp + 3]), pk2(st[mb][8 * sp + 4], st[mb][8 * sp + 5]), pk2(st[mb][8 * sp + 6], st[mb][8 * sp + 7])}); }
        l_run += ls;
#pragma unroll
        for (int eb = 0; eb < 4; ++eb) { __builtin_amdgcn_sched_barrier(0);
#pragma unroll
            for (int mb = 0; mb < 2; ++mb)
#pragma unroll
                for (int sp = 0; sp < 2; ++sp) { const int u1 = 8 * mb + 4 * sp + hi;
                    const v2u lo = *(const LAS v2u*)(lds + cur + vbase + 4096 * eb + ((8 * u1) ^ vx)), hv = *(const LAS v2u*)(lds + cur + vbase + 4096 * eb + ((8 * (u1 + 2)) ^ vx));
                    O[eb] = __builtin_amdgcn_mfma_f32_32x32x16_bf16(__builtin_bit_cast(bf16x8, (v4u){lo.x, lo.y, hv.x, hv.y}), pf[mb][sp], O[eb], 0, 0, 0); } }
        __syncthreads();
    }
#undef AT_LOAD
#undef AT_STORE
    l_run += __shfl_xor(l_run, 32);
    LAS float* ex = (LAS float*)lds + (size_t)rg * 4096 + lane;
    if (map == 1) { const float sc = lam / l_run;
#pragma unroll
        for (int eb = 0; eb < 4; ++eb)
#pragma unroll
            for (int r = 0; r < 16; ++r) ex[(eb * 16 + r) * 64] = O[eb][r] * sc; }
    __syncthreads();
    if (map == 0) { const float il = 1.0f / l_run; float ss = 0.f;
#pragma unroll
        for (int eb = 0; eb < 4; ++eb)
#pragma unroll
            for (int r = 0; r < 16; ++r) { const float v = O[eb][r] * il - ex[(eb * 16 + r) * 64]; O[eb][r] = v; ss += v * v; }
        ss += __shfl_xor(ss, 32);
        const float rn = 0.8f / sqrtf(ss * (1.0f / 128.0f) + LN_EPS); const float* ag = a.in[16] + h * 128;
        bf16* mp = (bf16*)(ws + WS_MIX) + (size_t)qrow * DM + h * 128;
#pragma unroll
        for (int eb = 0; eb < 4; ++eb)
#pragma unroll
            for (int rq = 0; rq < 4; ++rq) { const int e0 = 32 * eb + 8 * rq + 4 * hi; const f32x4 gn = *(const f32x4*)(ag + e0);
                f32x4 o4; o4[0] = O[eb][4 * rq] * rn * gn[0]; o4[1] = O[eb][4 * rq + 1] * rn * gn[1]; o4[2] = O[eb][4 * rq + 2] * rn * gn[2]; o4[3] = O[eb][4 * rq + 3] * rn * gn[3];
                *(v2u*)(mp + e0) = pk4(o4); } }
    __syncthreads();
}
__device__ __forceinline__ void mixer_phase(const Args& a, LAS unsigned char* lds, int tid, int lane, int wave, int rep) {
    unsigned* ctr = (unsigned*)(a.ws + WS_CTL) + 256 + 64 * rep;
    volatile LAS unsigned* slot = (volatile LAS unsigned*)(lds + MISC_OFF + 64);
    const float lam = calc_lam(a, lane);
    for (;;) {
        if (tid == 0) slot[0] = __hip_atomic_fetch_add(ctr, 1u, __ATOMIC_RELAXED, __HIP_MEMORY_SCOPE_AGENT);
        __syncthreads();
        const int it = (int)slot[0];
        __syncthreads();
        if (it >= 480) break;
        int tid_ = tid; asm volatile("" : "+v"(tid_));
        const int lane_ = tid_ & 63;
#ifndef PROBE_SKIP
#define PROBE_SKIP 0
#endif
        const bool do_rnn = !(rep == 1 && PROBE_SKIP == 1), do_att = !(rep == 1 && PROBE_SKIP == 2);
        if (it < 32) { if (do_rnn) rnn_item(a, lds, 64 + it, tid_, lane_, wave); }
        else if (it < 288) { if (do_att) attn_unit(a, lds, it - 32, lam, tid_, lane_, wave); }
        else if (it < 352) { if (do_rnn) rnn_item(a, lds, it - 288, tid_, lane_, wave); }
        else if (do_att) attn_unit(a, lds, 256 + (it - 352), lam, tid_, lane_, wave);
    }
}
#ifndef MK_N_LAUNCHES
#define MK_N_LAUNCHES 1
#endif
constexpr int NPH = 10;
#ifndef PROBE_PH
#define PROBE_PH -1
#endif
#ifndef PROBE_MASK
#if PROBE_PH >= 0
#define PROBE_MASK (1 << PROBE_PH)
#else
#define PROBE_MASK 0
#endif
#endif
#define PRB(k) ((PROBE_MASK >> (k)) & 1)
#define REPS(k) for (int rep_ = 0; rep_ < (PRB(k) ? 2 : 1); ++rep_, (PRB(k) && rep_ == 1) ? xcd_barrier(bar) : (void)0)
__global__ void __launch_bounds__(NTHR, 2) fwd(Args args) {
    extern __shared__ __attribute__((aligned(16))) unsigned char lds_[];
    LAS unsigned char* lds = (LAS unsigned char*)lds_;
    const int tid = threadIdx.x, lane = tid & 63, wave = __builtin_amdgcn_readfirstlane(tid >> 6);
    const int G = gridDim.x, bx = blockIdx.x, vcu = (G % 8 == 0) ? (bx % 8) * (G / 8) + bx / 8 : bx;
    unsigned char* ws = args.ws;
    for (int u = tid; u < (LDS_BYTES - RING_BYTES) / 4; u += NTHR) ((LAS unsigned*)(lds + RING_BYTES))[u] = 0u;
    __syncthreads();
    const int lo = args.ph_lo, hi = args.ph_hi;
    XcdBarrier bar; bar.bar = (unsigned*)(ws + WS_CTL) + CW_BAR; bar.x = 0; bar.st = nullptr;
    if (hi - lo > 1) bar = xcd_barrier_post((unsigned*)(ws + WS_CTL) + CW_BAR, (volatile LAS unsigned*)(lds + MISC_OFF) + 8);
#define IN(k) (lo <= (k) && (k) < hi)
#define SEAM(k) do { if (IN(k) && IN((k) + 1)) xcd_barrier(bar); } while (0)
    float* mod = (float*)(ws + WS_MOD);
    if (IN(0)) { REPS(0) p0_prologue(args, lds, vcu, G, tid, lane, wave); SEAM(0); }
    if (IN(1)) { REPS(1) p1_modulate(args, vcu, G, lane, wave); SEAM(1); }
    if (IN(2)) {
        pg8::Gemm g{(const bf16*)(ws + WS_XM), (const bf16*)(ws + WS_WIN), MROWS, INC, DM}; pg8::StaticOrder S; S.init(MROWS, INC, G, bx);
        Epi1 E{(bf16*)(ws + WS_Q), (bf16*)(ws + WS_KC), (bf16*)(ws + WS_VC), (bf16*)(ws + WS_KL), (bf16*)(ws + WS_VL), (bf16*)(ws + WS_RG), ws + WS_IMG,
               args.out + OUT_K, args.out + OUT_V, (const float*)(ws + WS_ROPE), args.in[14], args.in[15]};
        REPS(2) pg8::gemm_phase<Epi1, pg8::StaticOrder, true, true>(lds, g, S, E);
        SEAM(2);
    }
    if (IN(3)) {
        REPS(3) mixer_phase(args, lds, tid, lane, wave, rep_);
        SEAM(3);
    }
    if (IN(4)) {
        pg8::Gemm g{(const bf16*)(ws + WS_MIX), (const bf16*)(ws + WS_WOUT), MROWS, DM, DM}; pg8::StaticOrder S; S.init(MROWS, DM, G, bx);
        EpiRes E{args.in[0], args.in[1], nullptr, args.out + OUT_Y, mod + 2048};
        REPS(4) pg8::gemm_phase<EpiRes, pg8::StaticOrder, true, true>(lds, g, S, E);
        SEAM(4);
    }
    if (IN(5)) { ln_rows(args, args.in[19], args.in[20], true, vcu, G, lane, wave); SEAM(5); }
    if (IN(6)) {
        pg8::Gemm g{(const bf16*)(ws + WS_XM), (const bf16*)(ws + WS_WUP), MROWS, FF2, DM}; pg8::StaticOrder S; S.init(MROWS, FF2, G, bx);
        EpiH E{(bf16*)(ws + WS_H)};
        REPS(6) pg8::gemm_phase<EpiH, pg8::StaticOrder, true, true>(lds, g, S, E);
        SEAM(6);
    }
    if (IN(7)) { REPS(7) conv_gate(args, vcu, G, tid); SEAM(7); }
    if (IN(8)) {
        pg8::Gemm g{(const bf16*)(ws + WS_G), (const bf16*)(ws + WS_WDN), MROWS, DM, FF}; pg8::StaticOrder S; S.init(MROWS, DM, G, bx);
        EpiRes E{args.in[0], args.in[1], args.out + OUT_Y, args.out + OUT_Y, mod + 5120};
        pg8::gemm_phase<EpiRes, pg8::StaticOrder, true, true>(lds, g, S, E);
        SEAM(8);
    }
    if (IN(9)) { ln_rows(args, args.in[25], args.in[26], false, vcu, G, lane, wave); }
#undef IN
#undef SEAM
}

extern "C" void kernel_launch(void* const* d_in, const int* in_sizes, int n_in, void* d_out, int out_size, void* d_ws, size_t ws_size, hipStream_t stream) {
    static int grid = 0;
    if (grid == 0) {
        if (n_in != 27 || out_size != 18874368 || ws_size < WS_END) { fprintf(stderr, "kernel_launch: unexpected shapes (n_in %d, out %d, ws %zu)\n", n_in, out_size, ws_size); grid = -1; return; }
        int dev = 0, cus = 0, per_cu = 0;
        if (hipGetDevice(&dev) != hipSuccess || hipDeviceGetAttribute(&cus, hipDeviceAttributeMultiprocessorCount, dev) != hipSuccess) { grid = -1; return; }
        if (hipFuncSetAttribute((const void*)fwd, hipFuncAttributeMaxDynamicSharedMemorySize, LDS_BYTES) != hipSuccess) { fprintf(stderr, "kernel_launch: hipFuncSetAttribute failed\n"); grid = -1; return; }
        if (hipOccupancyMaxActiveBlocksPerMultiprocessor(&per_cu, (const void*)fwd, NTHR, LDS_BYTES) != hipSuccess || per_cu < 1) { fprintf(stderr, "kernel_launch: occupancy query reports %d\n", per_cu); per_cu = 1; }
        (void)hipGetLastError();
        grid = cus;
    }
    if (grid < 0) return;
    (void)hipMemsetAsync((char*)d_ws + WS_CTL, 0, CTL_ZERO_BYTES, stream);
    Args a{};
    for (int i = 0; i < 27; ++i) a.in[i] = (const float*)d_in[i];
    a.out = (float*)d_out; a.ws = (unsigned char*)d_ws;
    if (MK_N_LAUNCHES == 1) { a.ph_lo = 0; a.ph_hi = NPH; hipLaunchKernelGGL(fwd, dim3(grid), dim3(NTHR), LDS_BYTES, stream, a); }
    else for (int li = 0; li < NPH; ++li) { a.ph_lo = li; a.ph_hi = li + 1; hipLaunchKernelGGL(fwd, dim3(grid), dim3(NTHR), LDS_BYTES, stream, a); }
}
```

```cpp
#include <hip/hip_runtime.h>
#include <cstdio>
#include <cstdint>
#define MK_N_LAUNCHES 1
namespace pg8 {
#define PG8_LAS __attribute__((address_space(3)))
typedef unsigned short bf16_t;
typedef short bf16x8 __attribute__((ext_vector_type(8)));
typedef float f32x4 __attribute__((ext_vector_type(4)));
typedef unsigned u32x4 __attribute__((ext_vector_type(4)));
constexpr int BM = 256, BK = 64, HALF = 128, HTB = HALF * BK * 2  , STAGE_BYTES = 8 * HTB, NXCD = 8, WGM = 8;

__host__ __device__ __forceinline__ int lds_byte(int r, int c) { const int st = (r >> 4) * 2 + (c >> 5), rr = r & 15, cc = c & 31, ob = rr * 64 + cc * 2; return st * 1024 + (ob ^ (((ob >> 9) & 1) << 5)); }
__host__ __device__ __forceinline__ void stage_rc(int b, int& R, int& C) { const int st = b / 1024, sb = b % 1024, swz = sb ^ (((sb >> 9) & 1) << 5); R = (st >> 1) * 16 + swz / 64; C = (st & 1) * 32 + (swz % 64) / 2; }
__host__ __device__ __forceinline__ int perm32(int rho) { const int n = rho >> 4, i = rho & 15; return 8 * (i >> 2) + 4 * n + (i & 3); }

struct Unit { int pm, pn; };
struct Gemm { const bf16_t* A; const bf16_t* Bt; int M, N, K; };

struct StaticOrder {
    int nM, nN, nwg, G, c;
    __host__ __device__ void init(int M, int N, int G_, int c_) { nM = M / BM; nN = N / BM; nwg = nM * nN; G = G_; c = c_; }
    __host__ __device__ bool next(int i, Unit& u) const {
        const long L = (long)i * G + c; if (L >= nwg) return false;
        int wgid = (int)L; { const int q = nwg / NXCD, r = nwg % NXCD, xcd = wgid % NXCD, off = wgid / NXCD; wgid = (xcd < r ? xcd * (q + 1) : r * (q + 1) + (xcd - r) * q) + off; }
        const int nig = WGM * nN, gid = wgid / nig, fm = gid * WGM, gsz = (nM - fm) < WGM ? (nM - fm) : WGM;
        u.pm = fm + ((wgid % nig) % gsz); u.pn = (wgid % nig) / gsz; return true;
    }
    __device__ __forceinline__ void a_ready(const Unit&) const {}
    __device__ __forceinline__ void done(const Unit&) const {}
};

__device__ __forceinline__ unsigned cvt_pk_bf16(float lo, float hi) { unsigned r; asm volatile("v_cvt_pk_bf16_f32 %0, %1, %2" : "=v"(r) : "v"(lo), "v"(hi)); return r; }
typedef float f32x2 __attribute__((ext_vector_type(2)));
template <class Epi, class Sched, bool ALIGN_EPI = false, bool SP2 = false>
__device__ __forceinline__ void gemm_phase(PG8_LAS unsigned char* lds, const Gemm g, const Sched& S, const Epi& E) {
    const int tid = threadIdx.x, wid = __builtin_amdgcn_readfirstlane(tid >> 6), lane = tid & 63, wr = wid >> 2, wc = wid & 3, fr = lane & 15, fq = lane >> 4;
    const int K = g.K, nt = K / BK;
    unsigned voffA[2], voffB[2];
#pragma unroll
    for (int i = 0; i < 2; ++i) { int R, C; stage_rc(tid * 16 + i * 8192, R, C); const int Rb = Epi::PERM ? ((R & ~31) + perm32(R & 31)) : R;
        voffA[i] = (unsigned)(R * K + C) * 2u; voffB[i] = (unsigned)(Rb * K + C) * 2u; }
    const size_t kstep = (size_t)(BK * 2);
    const size_t hstep = (size_t)HALF * K * 2;
    const size_t tstep = 2 * hstep;
    const unsigned ldsw = (unsigned)wid * 1024u;
    const int aoff = lds_byte(wr * 64 + fr, fq * 8), boff = lds_byte(wc * 32 + fr, fq * 8);
#define PG8_SA(b, h) (((b) * 2 + (h)) * HTB)
#define PG8_SB(b, h) ((4 + (b) * 2 + (h)) * HTB)
#define PG8_STAGE(bufoff, gbase, voff) do { _Pragma("unroll") for (int _i = 0; _i < 2; ++_i) \
        __builtin_amdgcn_global_load_lds((const unsigned*)((const char*)(gbase) + (voff)[_i]), (PG8_LAS unsigned*)(lds + (bufoff) + ldsw + _i * 8192), 16, 0, 0); } while (0)
#define PG8_LDA(dst, b, h) do { _Pragma("unroll") for (int m = 0; m < 4; ++m) _Pragma("unroll") for (int k = 0; k < 2; ++k) dst[m][k] = *(const PG8_LAS bf16x8*)(lds + PG8_SA(b, h) + aoff + m * 2048 + k * 1024); } while (0)
#define PG8_LDB(dst, b, h) do { _Pragma("unroll") for (int n = 0; n < 2; ++n) _Pragma("unroll") for (int k = 0; k < 2; ++k) dst[n][k] = *(const PG8_LAS bf16x8*)(lds + PG8_SB(b, h) + boff + n * 2048 + k * 1024); } while (0)
#define PG8_MMA(ai, bj, At, Bt) do { __builtin_amdgcn_s_setprio(1); _Pragma("unroll") for (int m = 0; m < 4; ++m) _Pragma("unroll") for (int n = 0; n < 2; ++n) _Pragma("unroll") for (int k = 0; k < 2; ++k) \
        acc[ai][bj][m][n] = __builtin_amdgcn_mfma_f32_16x16x32_bf16(Bt[n][k], At[m][k], acc[ai][bj][m][n], 0, 0, 0); __builtin_amdgcn_s_setprio(0); } while (0)
#define PG8_WAIT_V(n) asm volatile("s_waitcnt vmcnt(" #n ")" ::: "memory")
#define PG8_WAIT_L(n) asm volatile("s_waitcnt lgkmcnt(" #n ")" ::: "memory")
#define PG8_BAR __builtin_amdgcn_s_barrier()
#define PG8_SCHED __builtin_amdgcn_sched_barrier(0)
    Unit cur, nxt; int ui = 0;
    if (!S.next(0, cur)) return;
    f32x4 acc[2][2][4][2];
#pragma unroll
    for (int a = 0; a < 2; ++a)
#pragma unroll
        for (int b = 0; b < 2; ++b)
#pragma unroll
            for (int m = 0; m < 4; ++m)
#pragma unroll
                for (int n = 0; n < 2; ++n) acc[a][b][m][n] = (f32x4){0.f, 0.f, 0.f, 0.f};
    bf16x8 At[4][2], B0[2][2], B1[2][2];
    const char* cA = (const char*)g.A + (size_t)cur.pm * tstep; const char* cB = (const char*)g.Bt + (size_t)cur.pn * tstep;
    S.a_ready(cur);
    if constexpr (SP2) {
        PG8_STAGE(PG8_SB(0, 0), cB, voffB); PG8_STAGE(PG8_SB(0, 1), cB + hstep, voffB); PG8_STAGE(PG8_SA(0, 0), cA, voffA); PG8_STAGE(PG8_SA(0, 1), cA + hstep, voffA);
        if (wr == 1) PG8_BAR;
        PG8_WAIT_V(2); PG8_BAR;
        PG8_STAGE(PG8_SB(1, 0), cB + kstep, voffB); PG8_STAGE(PG8_SA(1, 0), cA + kstep, voffA); PG8_STAGE(PG8_SB(1, 1), cB + hstep + kstep, voffB);
        PG8_WAIT_V(6); PG8_BAR;
    } else {
        PG8_STAGE(PG8_SB(0, 0), cB, voffB); PG8_STAGE(PG8_SA(0, 0), cA, voffA); PG8_STAGE(PG8_SB(0, 1), cB + hstep, voffB); PG8_STAGE(PG8_SA(0, 1), cA + hstep, voffA);
        if (wr == 1) PG8_BAR;
        PG8_WAIT_V(4); PG8_BAR;
        PG8_STAGE(PG8_SB(1, 0), cB + kstep, voffB); PG8_STAGE(PG8_SA(1, 0), cA + kstep, voffA); PG8_STAGE(PG8_SB(1, 1), cB + hstep + kstep, voffB);
        PG8_WAIT_V(6); PG8_BAR;
    }
    for (;;) {
        const bool has_next = S.next(ui + 1, nxt);
        const char* nA = has_next ? (const char*)g.A + (size_t)nxt.pm * tstep : cA; const char* nB = has_next ? (const char*)g.Bt + (size_t)nxt.pn * tstep : cB;
        for (int t = 0; t < nt; t += 2) {
            const bool last = (t == nt - 2);
            const char* a1 = cA + (size_t)(t + 1) * kstep;
            const char* a2 = last ? nA : cA + (size_t)(t + 2) * kstep; const char* b2 = last ? nB : cB + (size_t)(t + 2) * kstep;
            const char* a3 = a2 + kstep; const char* b3 = b2 + kstep;
            if (last && has_next) S.a_ready(nxt);
            if constexpr (SP2) {
            PG8_LDB(B0, 0, 0); PG8_LDB(B1, 0, 1); PG8_SCHED; PG8_LDA(At, 0, 0); PG8_STAGE(PG8_SA(1, 1), a1 + hstep, voffA);
            PG8_WAIT_V(8); PG8_WAIT_L(0); PG8_BAR; PG8_MMA(0, 0, At, B0); PG8_MMA(0, 1, At, B1); PG8_BAR; PG8_SCHED;
            PG8_LDA(At, 0, 1); PG8_STAGE(PG8_SB(0, 0), b2, voffB); PG8_STAGE(PG8_SB(0, 1), b2 + hstep, voffB); PG8_STAGE(PG8_SA(0, 0), a2, voffA);
            PG8_WAIT_V(8); PG8_WAIT_L(0); PG8_BAR; PG8_MMA(1, 0, At, B0); PG8_MMA(1, 1, At, B1); PG8_BAR; PG8_SCHED;
            PG8_LDB(B0, 1, 0); PG8_LDB(B1, 1, 1); PG8_SCHED; PG8_LDA(At, 1, 0); PG8_STAGE(PG8_SA(0, 1), a2 + hstep, voffA);
            PG8_WAIT_V(8); PG8_WAIT_L(0); PG8_BAR; PG8_MMA(0, 0, At, B0); PG8_MMA(0, 1, At, B1); PG8_BAR; PG8_SCHED;
            PG8_LDA(At, 1, 1); PG8_STAGE(PG8_SB(1, 0), b3, voffB); PG8_STAGE(PG8_SB(1, 1), b3 + hstep, voffB); PG8_STAGE(PG8_SA(1, 0), a3, voffA);
            PG8_WAIT_V(8); PG8_WAIT_L(0); PG8_BAR; PG8_MMA(1, 0, At, B0); PG8_MMA(1, 1, At, B1); PG8_BAR; PG8_SCHED;
            } else {
            PG8_LDB(B0, 0, 0); PG8_SCHED; PG8_LDA(At, 0, 0); PG8_STAGE(PG8_SA(1, 1), a1 + hstep, voffA);
            PG8_WAIT_L(8); PG8_BAR; PG8_WAIT_L(0); PG8_MMA(0, 0, At, B0); PG8_BAR; PG8_SCHED;
            PG8_LDB(B1, 0, 1); PG8_STAGE(PG8_SB(0, 0), b2, voffB);
            PG8_BAR; PG8_WAIT_L(0); PG8_MMA(0, 1, At, B1); PG8_BAR;
            PG8_LDA(At, 0, 1); PG8_STAGE(PG8_SA(0, 0), a2, voffA);
            PG8_BAR; PG8_WAIT_L(0); PG8_MMA(1, 0, At, B0); PG8_BAR; PG8_SCHED;
            PG8_STAGE(PG8_SB(0, 1), b2 + hstep, voffB);
            PG8_WAIT_V(6); PG8_BAR; PG8_MMA(1, 1, At, B1); PG8_BAR;
            PG8_LDB(B0, 1, 0); PG8_SCHED; PG8_LDA(At, 1, 0); PG8_STAGE(PG8_SA(0, 1), a2 + hstep, voffA);
            PG8_WAIT_L(8); PG8_BAR; PG8_WAIT_L(0); PG8_MMA(0, 0, At, B0); PG8_BAR; PG8_SCHED;
            PG8_LDB(B1, 1, 1); PG8_STAGE(PG8_SB(1, 0), b3, voffB);
            PG8_BAR; PG8_WAIT_L(0); PG8_MMA(0, 1, At, B1); PG8_BAR;
            PG8_LDA(At, 1, 1); PG8_STAGE(PG8_SA(1, 0), a3, voffA);
            PG8_BAR; PG8_WAIT_L(0); PG8_MMA(1, 0, At, B0); PG8_BAR; PG8_SCHED;
            PG8_STAGE(PG8_SB(1, 1), b3 + hstep, voffB);
            PG8_WAIT_V(6); PG8_BAR; PG8_MMA(1, 1, At, B1); PG8_BAR;
            }
        }
        if constexpr (ALIGN_EPI) { if (wr == 0) PG8_BAR; }
        if constexpr (!Epi::AFTER_DRAIN) { E(acc, cur, wr, wc, fr, fq); S.done(cur); }
        if (!has_next) break;
#pragma unroll
        for (int a = 0; a < 2; ++a)
#pragma unroll
            for (int b = 0; b < 2; ++b)
#pragma unroll
                for (int m = 0; m < 4; ++m)
#pragma unroll
                    for (int n = 0; n < 2; ++n) acc[a][b][m][n] = (f32x4){0.f, 0.f, 0.f, 0.f};
        cur = nxt; cA = nA; cB = nB; ++ui;
        if constexpr (ALIGN_EPI) { if (wr == 1) PG8_BAR; }
    }
    PG8_WAIT_V(0);
    if constexpr (!ALIGN_EPI) { if (wr == 0) PG8_BAR; }
    PG8_BAR;
    if constexpr (Epi::AFTER_DRAIN) { E.fused(acc, cur, wr, wc, fr, fq, lds, wid, lane); S.done(cur); }
#undef PG8_SA
#undef PG8_SB
#undef PG8_STAGE
#undef PG8_LDA
#undef PG8_LDB
#undef PG8_MMA
#undef PG8_WAIT_V
#undef PG8_WAIT_L
#undef PG8_BAR
#undef PG8_SCHED
}
}
constexpr int DM = 1024, NCTX = 4096, NLAT = 8192, MROWS = 12288;
constexpr int CSEQ = 256, LSEQ = 1024, PAST = 512, LKEYS = 1536;
constexpr int INC = 4096, FF = 2816, FF2 = 5632, AW = 512;
constexpr float ALPHA = 1.189207115002721f, LN_EPS = 1e-5f;
constexpr float QSCALE = 0.125f * 1.4426950408889634f;
constexpr int NWAVES = 8, NTHR = 512;
constexpr int LDS_BYTES = 147456;
constexpr int RING_BYTES = 131072, MISC_OFF = RING_BYTES + 320;

constexpr size_t MiB = 1u << 20;
constexpr size_t WS_CTL = 0, CTL_ZERO_BYTES = 65536;
constexpr size_t WS_MOD = 1 * MiB;
constexpr size_t WS_ROPE = 1 * MiB + 512 * 1024;
constexpr size_t WS_WIN = 2 * MiB, WS_WOUT = 10 * MiB, WS_WUP = 12 * MiB, WS_WDN = 23 * MiB;
constexpr size_t WS_XM = 29 * MiB;
constexpr size_t WS_MIX = 29 * MiB;
constexpr size_t WS_IMG = 53 * MiB;
constexpr size_t IMG_BYTES = 17408;
constexpr size_t WS_Q = 155 * MiB, WS_KC = 167 * MiB, WS_VC = 171 * MiB, WS_KL = 175 * MiB, WS_VL = 187 * MiB;
constexpr size_t WS_RG = 199 * MiB, WS_OF = 211 * MiB, WS_OB = 223 * MiB;
constexpr size_t WS_H = 53 * MiB;
constexpr size_t WS_G = 185 * MiB;
constexpr size_t WS_END = 251 * MiB;
constexpr size_t OUT_Y = 0, OUT_K = 12582912, OUT_V = OUT_K + 2097152, OUT_S = OUT_V + 2097152;
constexpr int CW_BAR = 4096;

#define GAS __attribute__((address_space(1)))
#define LAS __attribute__((address_space(3)))
typedef unsigned short bf16;
typedef unsigned v4u __attribute__((ext_vector_type(4)));
typedef unsigned v2u __attribute__((ext_vector_type(2)));
typedef float f32x4 __attribute__((ext_vector_type(4)));
typedef short bf16x8 __attribute__((ext_vector_type(8)));
typedef GAS unsigned gu32;
#define RLX_AGENT __ATOMIC_RELAXED, __HIP_MEMORY_SCOPE_AGENT
#define LDS_WAIT() asm volatile("s_waitcnt lgkmcnt(0)" ::: "memory")
#define VM_WAIT() asm volatile("s_waitcnt vmcnt(0)" ::: "memory")
__device__ __forceinline__ unsigned f2bf(float f) { unsigned u = __builtin_bit_cast(unsigned, f); return (u + 0x7fffu + ((u >> 16) & 1u)) >> 16; }
typedef float f32x2_t __attribute__((ext_vector_type(2))); typedef __bf16 bf16x2_t __attribute__((ext_vector_type(2)));
__device__ __forceinline__ unsigned pk2(float lo, float hi) { f32x2_t v = {lo, hi}; bf16x2_t b = __builtin_convertvector(v, bf16x2_t); return __builtin_bit_cast(unsigned, b); }
__device__ __forceinline__ float bflo(unsigned w) { return __uint_as_float(w << 16); }
__device__ __forceinline__ float bfhi(unsigned w) { return __uint_as_float(w & 0xffff0000u); }
template <int CTRL> __device__ __forceinline__ float dppf(float x) { return __builtin_bit_cast(float, __builtin_amdgcn_update_dpp(0, __builtin_bit_cast(int, x), CTRL, 0xf, 0xf, true)); }
__device__ __forceinline__ float wave_sum(float v) {
    v += dppf<0xB1>(v); v += dppf<0x4E>(v); v += dppf<0x124>(v); v += dppf<0x128>(v);
    const int vi = __builtin_bit_cast(int, v);
    return (__builtin_bit_cast(float, __builtin_amdgcn_readlane(vi, 0)) + __builtin_bit_cast(float, __builtin_amdgcn_readlane(vi, 16))) + (__builtin_bit_cast(float, __builtin_amdgcn_readlane(vi, 32)) + __builtin_bit_cast(float, __builtin_amdgcn_readlane(vi, 48)));
}
__device__ __forceinline__ float wave_max(float v) {
#pragma unroll
    for (int o = 1; o < 64; o <<= 1) v = fmaxf(v, __shfl_xor(v, o));
    return v;
}
__device__ __forceinline__ float sigmoidf_(float z) { return 1.0f / (1.0f + __expf(-z)); }
__device__ __forceinline__ float siluf_(float z) { return z / (1.0f + __expf(-z)); }

struct Args { const float* in[27]; float* out; unsigned char* ws; int ph_lo, ph_hi; };
#define XB_TMO      128
#define XB_XCNT(j)  (256  + 64 * (j))
#define XB_XSUB(j)  (1280 + 64 * (j))
#define XB_XGEN(j)  (2304 + 64 * (j))
#define XB_TOP      3328
#define XB_TOPGEN   3392
#define XCD_BAR_WORDS 3456
#define XB_SPIN_CAP (1u << 18)

__device__ __forceinline__ unsigned xb_ld(unsigned* p)              { return __hip_atomic_load(p, __ATOMIC_RELAXED, __HIP_MEMORY_SCOPE_AGENT); }
__device__ __forceinline__ unsigned xb_add(unsigned* p, unsigned v) { return __hip_atomic_fetch_add(p, v, __ATOMIC_RELAXED, __HIP_MEMORY_SCOPE_AGENT); }
__device__ __forceinline__ unsigned xb_xcc_id() { return (unsigned)__builtin_amdgcn_s_getreg((3 << 11) | 20) & 0xFu; }
#define XB_SPIN(cond, bar) do { unsigned _sp = 0; while (cond) { __builtin_amdgcn_s_sleep(1); \
    if ((++_sp & 255u) == 0u) { if (xb_ld(&(bar)[XB_TMO])) break; if (_sp > XB_SPIN_CAP) { atomicAdd(&(bar)[XB_TMO], 1u); break; } } } } while (0)

struct XcdBarrier {
    unsigned* bar; unsigned x;
    volatile LAS unsigned* st;
};

__device__ __forceinline__ XcdBarrier xcd_barrier_post(unsigned* bar, volatile LAS unsigned* st) {
    XcdBarrier b; b.bar = bar; b.x = xb_xcc_id(); b.st = st;
    if (threadIdx.x == 0) (void)xb_add(&bar[XB_XCNT(b.x)], 1u);
    return b;
}
__device__ __forceinline__ void xcd_barrier_complete(unsigned* bar, unsigned x, unsigned& nloc, unsigned& nx) {
    const unsigned G = gridDim.x * gridDim.y * gridDim.z;
    unsigned sum, cnt, mine, sp = 0u;
    for (;;) {
        sum = 0u; cnt = 0u; mine = 0u;
#pragma unroll
        for (unsigned j = 0; j < 16; ++j) { const unsigned c = xb_ld(&bar[XB_XCNT(j)]); sum += c; cnt += (c > 0u) ? 1u : 0u; mine = (j == x) ? c : mine; }
        if (sum == G) break;
        __builtin_amdgcn_s_sleep(1);
        if ((++sp & 255u) == 0u) { if (xb_ld(&bar[XB_TMO])) break; if (sp > XB_SPIN_CAP) { atomicAdd(&bar[XB_TMO], 1u); break; } }
    }
    nloc = mine > 0u ? mine : 1u; nx = cnt > 0u ? cnt : 1u;
}

__device__ __forceinline__ void xcd_barrier(const XcdBarrier& b) {
    asm volatile("s_waitcnt vmcnt(0)" ::: "memory");
    __syncthreads();
    if (threadIdx.x == 0) {
        unsigned* bar = b.bar;
        __builtin_amdgcn_s_waitcnt(0);
        unsigned nloc = b.st[0], nx = b.st[1];
        if (nloc == 0u) { xcd_barrier_complete(bar, b.x, nloc, nx); b.st[0] = nloc; b.st[1] = nx; }
        const unsigned old = xb_add(&bar[XB_XSUB(b.x)], 1u);
        const unsigned gen = old / nloc;
        if (old + 1u == (gen + 1u) * nloc) {
            __builtin_amdgcn_fence(__ATOMIC_RELEASE, "agent");
            asm volatile("s_waitcnt vmcnt(0)" ::: "memory");
            const unsigned og = xb_add(&bar[XB_TOP], 1u);
            const unsigned tg = og / nx;
            if (og + 1u == (tg + 1u) * nx) xb_add(&bar[XB_TOPGEN], 1u);
            else XB_SPIN(xb_ld(&bar[XB_TOPGEN]) == tg, bar);
            __builtin_amdgcn_fence(__ATOMIC_ACQUIRE, "agent");
            xb_add(&bar[XB_XGEN(b.x)], 1u);
            asm volatile("s_waitcnt vmcnt(0)" ::: "memory");
        } else {
            XB_SPIN(xb_ld(&bar[XB_XGEN(b.x)]) == gen, bar);
            __builtin_amdgcn_fence(__ATOMIC_ACQUIRE, "agent");
            asm volatile("s_waitcnt vmcnt(0)" ::: "memory");
        }
    }
    __syncthreads();
}

__device__ __forceinline__ int mod_index(int row) { return row < NCTX ? 0 : 1 + ((row - NCTX) >> 10); }
__device__ __forceinline__ const float* xrow_ptr(const float* xp, const float* xs, int row) { return row < NCTX ? xp + (size_t)row * DM : xs + (size_t)(row - NCTX) * DM; }
__device__ __forceinline__ v2u pk4(f32x4 v) { v2u w; w.x = pk2(v[0], v[1]); w.y = pk2(v[2], v[3]); return w; }

template <int CTRL> __device__ __forceinline__ float dpp_f(float x) { return __builtin_bit_cast(float, __builtin_amdgcn_update_dpp(0, __builtin_bit_cast(int, x), CTRL, 0xf, 0xf, true)); }
__device__ __forceinline__ float row_prefix(float x) { x += dpp_f<0x111>(x); x += dpp_f<0x112>(x); x += dpp_f<0x114>(x); x += dpp_f<0x118>(x); return x; }
__device__ __forceinline__ float row_suffix(float x) { x += dpp_f<0x101>(x); x += dpp_f<0x102>(x); x += dpp_f<0x104>(x); x += dpp_f<0x108>(x); return x; }
struct Epi1 {
    static constexpr bool PERM = false, AFTER_DRAIN = false;
    bf16 *Q, *KC, *VC, *KL, *VL, *RG; unsigned char* IMG; float *outK, *outV; const float* rope; const float *lbf, *lbb;
    __device__ __forceinline__ void operator()(const f32x4 (&acc)[2][2][4][2], const pg8::Unit& u, int wr, int wc, int fr, int fq) const {
        const bool ctx = u.pm < 16;
        if (u.pn < 4) {
            const int grp = u.pn >> 1, cbase = (u.pn & 1) * 256, half = wc & 1;
#pragma unroll
            for (int ai = 0; ai < 2; ++ai)
#pragma unroll
                for (int m = 0; m < 4; ++m) {
                    const int row = u.pm * 256 + ai * 128 + wr * 64 + m * 16 + fr;
                    f32x4 cs0 = (f32x4){1.f, 0.f, 1.f, 0.f}, cs1 = cs0;
                    if (!ctx) { const int t = (row - NCTX) & 1023; const int pos = half ? (t & 63) : (t >> 6);
                        const float* tp = rope + (size_t)pos * 32 + 8 * fq; cs0 = *(const f32x4*)tp; cs1 = *(const f32x4*)(tp + 4); }
#pragma unroll
                    for (int bj = 0; bj < 2; ++bj) {
                        const f32x4 x1 = acc[ai][bj][m][0], x2 = acc[ai][bj][m][1]; f32x4 o1, o2;
                        o1[0] = x1[0] * cs0[0] - x2[0] * cs0[1]; o2[0] = x1[0] * cs0[1] + x2[0] * cs0[0];
                        o1[1] = x1[1] * cs0[2] - x2[1] * cs0[3]; o2[1] = x1[1] * cs0[3] + x2[1] * cs0[2];
                        o1[2] = x1[2] * cs1[0] - x2[2] * cs1[1]; o2[2] = x1[2] * cs1[1] + x2[2] * cs1[0];
                        o1[3] = x1[3] * cs1[2] - x2[3] * cs1[3]; o2[3] = x1[3] * cs1[3] + x2[3] * cs1[2];
                        const int cg = cbase + bj * 128 + wc * 32 + 4 * fq;
                        if (grp == 0) { *(v2u*)(Q + (size_t)row * AW + cg) = pk4(o1 * QSCALE); *(v2u*)(Q + (size_t)row * AW + cg + 16) = pk4(o2 * QSCALE); }
                        else if (ctx) { *(f32x4*)(outK + (size_t)row * AW + cg) = x1; *(f32x4*)(outK + (size_t)row * AW + cg + 16) = x2;
                                        *(v2u*)(KC + (size_t)row * AW + cg) = pk4(x1); *(v2u*)(KC + (size_t)row * AW + cg + 16) = pk4(x2); }
                        else { const int b = (row - NCTX) >> 10, t = (row - NCTX) & 1023; bf16* kp = KL + ((size_t)b * LKEYS + PAST + t) * AW + cg;
                               *(v2u*)kp = pk4(o1); *(v2u*)(kp + 16) = pk4(o2); }
                    }
                }
            return;
        }
        if (u.pn >= 6 && u.pn < 14) {
            const int T = u.pn - 6, head = T >> 1, chg = 64 * T + 16 * wc + 4 * fq, d0 = 64 * (T & 1) + 16 * wc + 4 * fq;
            const int chunk16 = 8 * (T & 1) + 4 * (wc >> 1) + fq, inoff = 8 * (wc & 1);
            f32x4 lf4, lb4;
            { const f32x4 a0 = *(const f32x4*)(lbf + chg), a1 = *(const f32x4*)(lbf + AW + chg), b0 = *(const f32x4*)(lbb + chg), b1 = *(const f32x4*)(lbb + AW + chg);
#pragma unroll
              for (int i = 0; i < 4; ++i) { lf4[i] = sigmoidf_(a0[i] - a1[i]); lb4[i] = sigmoidf_(b0[i] - b1[i]); } }
            const int lane15 = (threadIdx.x & 48) | 15;
#pragma unroll
            for (int ai = 0; ai < 2; ++ai)
#pragma unroll
                for (int m = 0; m < 4; ++m) {
                    const int row = u.pm * 256 + ai * 128 + wr * 64 + m * 16 + fr, chunk = row >> 4;
                    unsigned char* imf = IMG + ((size_t)(chunk * 4 + head) * 2) * IMG_BYTES; unsigned char* imb = imf + IMG_BYTES;
                    const f32x4 q4 = acc[ai][0][m][0], zf = acc[ai][0][m][1], zb = acc[ai][1][m][0], v4 = acc[ai][1][m][1];
                    const int sf = fr, sb = 15 - fr;
                    f32x4 qef, kdf, kef, qeb, kdb, keb, decf, decb;
#pragma unroll
                    for (int i = 0; i < 4; ++i) {
                        const float ff = lf4[i] + (1.0f - lf4[i]) * sigmoidf_(zf[i]), fb = lb4[i] + (1.0f - lb4[i]) * sigmoidf_(zb[i]);
                        const float cf = row_prefix(__logf(ff)), cb = row_suffix(__logf(fb));
                        const float tf = __shfl(cf, lane15), tb = __shfl(cb, lane15 - 15);
                        const float ef = __expf(cf), eb = __expf(cb), rf_ = __builtin_amdgcn_rcpf(ef), rb_ = __builtin_amdgcn_rcpf(eb), df = __expf(tf), db = __expf(tb);
                        qef[i] = q4[i] * ef; kdf[i] = (1.0f - ff) * rf_; kef[i] = (1.0f - ff) * rf_ * df; decf[i] = df;
                        qeb[i] = q4[i] * eb; kdb[i] = (1.0f - fb) * rb_; keb[i] = (1.0f - fb) * rb_ * db; decb[i] = db;
                    }
                    *(v2u*)(imf + sf * 256 + 16 * (chunk16 ^ sf) + inoff) = pk4(qef); *(v2u*)(imf + 4096 + sf * 256 + 16 * (chunk16 ^ sf) + inoff) = pk4(kdf);
                    *(v2u*)(imb + sb * 256 + 16 * (chunk16 ^ sb) + inoff) = pk4(qeb); *(v2u*)(imb + 4096 + sb * 256 + 16 * (chunk16 ^ sb) + inoff) = pk4(kdb);
                    const v2u kfw = pk4(kef), kbw = pk4(keb), vw = pk4(v4);
#pragma unroll
                    for (int i = 0; i < 4; ++i) { const unsigned sh = (i & 1) * 16; const unsigned short a_ = (unsigned short)((i < 2 ? kfw.x : kfw.y) >> sh), b_ = (unsigned short)((i < 2 ? kbw.x : kbw.y) >> sh), v_ = (unsigned short)((i < 2 ? vw.x : vw.y) >> sh);
                        *(bf16*)(imf + 8192 + (d0 + i) * 32 + sf * 2) = a_; *(bf16*)(imb + 8192 + (d0 + i) * 32 + sb * 2) = b_;
                        *(bf16*)(imf + 12288 + (d0 + i) * 32 + sf * 2) = v_; *(bf16*)(imb + 12288 + (d0 + i) * 32 + sb * 2) = v_; }
                    if (fr == 0) { *(f32x4*)(imf + 16384 + d0 * 4) = decf; *(f32x4*)(imb + 16384 + d0 * 4) = decb; }
                }
            return;
        }
        const int cbase = (u.pn & 1) * 256;
#pragma unroll
        for (int ai = 0; ai < 2; ++ai)
#pragma unroll
            for (int m = 0; m < 4; ++m) {
                const int row = u.pm * 256 + ai * 128 + wr * 64 + m * 16 + fr;
#pragma unroll
                for (int bj = 0; bj < 2; ++bj)
#pragma unroll
                    for (int n = 0; n < 2; ++n) {
                        const int cg = cbase + bj * 128 + wc * 32 + n * 16 + 4 * fq; const f32x4 v = acc[ai][bj][m][n]; const size_t o = (size_t)row * AW + cg;
                        if (u.pn < 6) { const int head = (cbase >> 7) + bj, e0 = wc * 32 + n * 16 + 4 * fq;
                                        if (ctx) { *(f32x4*)(outV + o) = v; const int b = row >> 8, l = row & 255; bf16* vp = VC + ((size_t)(b * 4 + head) * 128 + e0) * CSEQ + l;
#pragma unroll
                                            for (int i = 0; i < 4; ++i) vp[(size_t)i * CSEQ] = (bf16)f2bf(v[i]); }
                                        else { const int b = (row - NCTX) >> 10, t = (row - NCTX) & 1023; bf16* vp = VL + ((size_t)(b * 4 + head) * 128 + e0) * LKEYS + PAST + t;
#pragma unroll
                                            for (int i = 0; i < 4; ++i) vp[(size_t)i * LKEYS] = (bf16)f2bf(v[i]); } }
                        else { f32x4 w;
#pragma unroll
                            for (int i = 0; i < 4; ++i) w[i] = siluf_(v[i]);
                            *(v2u*)(RG + o) = pk4(w); }
                    }
            }
    }
};
struct EpiRes {
    static constexpr bool PERM = false, AFTER_DRAIN = false;
    const float *xp, *xs; const float* ybase; float* out; const float* gate;
    __device__ __forceinline__ void operator()(const f32x4 (&acc)[2][2][4][2], const pg8::Unit& u, int wr, int wc, int fr, int fq) const {
        const int mi = u.pm < 16 ? 0 : 1 + ((u.pm - 16) >> 2); const float* gp = gate + (size_t)mi * 6144;
        f32x4 gv[2][2];
#pragma unroll
        for (int bj = 0; bj < 2; ++bj)
#pragma unroll
            for (int n = 0; n < 2; ++n) gv[bj][n] = *(const f32x4*)(gp + u.pn * 256 + bj * 128 + wc * 32 + n * 16 + 4 * fq);
#pragma unroll
        for (int ai = 0; ai < 2; ++ai)
#pragma unroll
            for (int m = 0; m < 4; ++m) {
                const int row = u.pm * 256 + ai * 128 + wr * 64 + m * 16 + fr;
                const float* bp = ybase ? ybase + (size_t)row * DM : xrow_ptr(xp, xs, row);
#pragma unroll
                for (int bj = 0; bj < 2; ++bj)
#pragma unroll
                    for (int n = 0; n < 2; ++n) { const int col = u.pn * 256 + bj * 128 + wc * 32 + n * 16 + 4 * fq;
                        const f32x4 b = *(const f32x4*)(bp + col); *(f32x4*)(out + (size_t)row * DM + col) = b * ALPHA + gv[bj][n] * acc[ai][bj][m][n]; }
            }
    }
};
struct EpiH {
    static constexpr bool PERM = false, AFTER_DRAIN = false;
    bf16* H;
    __device__ __forceinline__ void operator()(const f32x4 (&acc)[2][2][4][2], const pg8::Unit& u, int wr, int wc, int fr, int fq) const {
#pragma unroll
        for (int ai = 0; ai < 2; ++ai)
#pragma unroll
            for (int m = 0; m < 4; ++m) {
                const int row = u.pm * 256 + ai * 128 + wr * 64 + m * 16 + fr;
#pragma unroll
                for (int bj = 0; bj < 2; ++bj)
#pragma unroll
                    for (int n = 0; n < 2; ++n) { const int col = u.pn * 256 + bj * 128 + wc * 32 + n * 16 + 4 * fq; *(v2u*)(H + (size_t)row * FF2 + col) = pk4(acc[ai][bj][m][n]); }
            }
    }
};
__device__ __forceinline__ int win_row(int n) {
    if (n < 1536 || n >= 3584) return n;
    const int ty = (n - 1536) >> 9, ch = (n - 1536) & 511, T = ch >> 6, wc = (ch >> 4) & 3, j = ch & 15;
    return 1536 + 256 * T + 128 * (ty >> 1) + 32 * wc + 16 * (ty & 1) + j;
}
template <bool WIN> __device__ __forceinline__ void p0_transpose_item(const float* W, int K, int N, bf16* WT, int k0, int n0, int orow0, LAS float* scr, int lane) {
#pragma unroll 8
    for (int i = 0; i < 32; ++i) { const int kk = 2 * i + (lane >> 5); scr[kk * 33 + (lane & 31)] = W[(size_t)(k0 + kk) * N + n0 + (lane & 31)]; }
    LDS_WAIT(); asm volatile("" ::: "memory");
    const int c = lane & 7;
#pragma unroll
    for (int j = 0; j < 4; ++j) { const int n = (lane >> 3) + 8 * j; const LAS float* s = scr + (8 * c) * 33 + n;
        v4u o; o.x = pk2(s[0 * 33], s[1 * 33]); o.y = pk2(s[2 * 33], s[3 * 33]); o.z = pk2(s[4 * 33], s[5 * 33]); o.w = pk2(s[6 * 33], s[7 * 33]);
        *(GAS v4u*)(WT + (size_t)(WIN ? win_row(n0 + n) : orow0 + n) * K + k0 + 8 * c) = o; }
    LDS_WAIT(); asm volatile("" ::: "memory");
}
__device__ __forceinline__ void p0_prologue(const Args& a, LAS unsigned char* lds, int vcu, int G, int tid, int lane, int wave) {
    unsigned char* ws = a.ws;
    {
        LAS float* cl = (LAS float*)lds;
        LAS float* red = (LAS float*)(lds + 40960);
        float* mod = (float*)(ws + WS_MOD);
        const float* wada = a.in[7]; const float* bada = a.in[8];
        bool filled = false;
        for (int cb = vcu; cb < 192; cb += G) {
            if (!filled) {
                for (int i = tid; i < 9 * 1024; i += NTHR) { const int m = i >> 10, k = i & 1023; const float v = (m == 0) ? a.in[6][k] : a.in[5][(m - 1) * 1024 + k]; cl[i] = siluf_(v); }
                filled = true; __syncthreads();
            }
            const int n0 = cb * 32, kr = lane >> 3, c4 = lane & 7;
            f32x4 acc[9];
#pragma unroll
            for (int m = 0; m < 9; ++m) acc[m] = (f32x4){0.f, 0.f, 0.f, 0.f};
            for (int it = 0; it < 16; ++it) { const int k = wave * 128 + it * 8 + kr; const f32x4 wv = *(const f32x4*)(wada + (size_t)k * 6144 + n0 + 4 * c4);
#pragma unroll
                for (int m = 0; m < 9; ++m) acc[m] += wv * cl[m * 1024 + k]; }
#pragma unroll
            for (int m = 0; m < 9; ++m)
#pragma unroll
                for (int i = 0; i < 4; ++i) { float v = acc[m][i]; v += __shfl_xor(v, 8); v += __shfl_xor(v, 16); v += __shfl_xor(v, 32); acc[m][i] = v; }
            if (kr == 0) {
#pragma unroll
                for (int m = 0; m < 9; ++m) *(LAS f32x4*)(red + (wave * 9 + m) * 32 + 4 * c4) = acc[m]; }
            __syncthreads();
            if (tid < 288) { const int m = tid >> 5, cc = tid & 31; float s = bada[n0 + cc];
#pragma unroll
                for (int w = 0; w < 8; ++w) s += red[(w * 9 + m) * 32 + cc];
                mod[(size_t)m * 6144 + n0 + cc] = s; }
            __syncthreads();
        }
        __syncthreads();
    }
    if (vcu == (G > 200 ? 200 : 0)) {
        float* rope = (float*)(ws + WS_ROPE);
        for (int i = tid; i < 1024; i += NTHR) { const int pos = i >> 4, j = i & 15;
            const float freq = 1.0f / powf(10000.0f, (float)j * (1.0f / 16.0f)); const float angf = (float)pos * freq; const double ang = (double)angf;
            const double nq = __builtin_rint(ang * 0.63661977236758134308); const double r = __builtin_fma(-nq, 1.5707963267948966192, ang) - nq * 6.123233995736766e-17; const double r2 = r * r;
            double sn = r * (1.0 + r2 * (-1.0 / 6 + r2 * (1.0 / 120 + r2 * (-1.0 / 5040 + r2 * (1.0 / 362880 + r2 * (-1.0 / 39916800 + r2 * (1.0 / 6227020800.0)))))));
            double cn = 1.0 + r2 * (-0.5 + r2 * (1.0 / 24 + r2 * (-1.0 / 720 + r2 * (1.0 / 40320 + r2 * (-1.0 / 3628800 + r2 * (1.0 / 479001600 + r2 * (-1.0 / 87178291200.0)))))));
            const int q = ((int)nq) & 3; double cc, ss;
            if (q == 0) { cc = cn; ss = sn; } else if (q == 1) { cc = -sn; ss = cn; } else if (q == 2) { cc = -cn; ss = -sn; } else { cc = sn; ss = -cn; }
            rope[2 * i] = (float)cc; rope[2 * i + 1] = (float)ss; }
    }
    {
        bf16* KL = (bf16*)(ws + WS_KL); bf16* VL = (bf16*)(ws + WS_VL);
        const int gt = vcu * NTHR + tid, NGT = G * NTHR;
        for (int i = gt; i < 524288; i += NGT) { const int rowi = i >> 7, c4 = i & 127, b = rowi >> 9, j = rowi & 511;
            const f32x4 v = *(const f32x4*)(a.in[2] + (size_t)i * 4);
            *(v2u*)(KL + ((size_t)b * LKEYS + j) * AW + 4 * c4) = pk4(v); }
        for (int i = gt; i < 524288; i += NGT) { const int j = i & 511, c4 = (i >> 9) & 127, b = i >> 16;
            const f32x4 v = *(const f32x4*)(a.in[3] + ((size_t)(b * 512 + j) * 512 + 4 * c4));
            bf16* vp = VL + ((size_t)b * 512 + 4 * c4) * LKEYS + j;
#pragma unroll
            for (int k = 0; k < 4; ++k) vp[(size_t)k * LKEYS] = (bf16)f2bf(v[k]); }
    }
    {
        LAS float* scr = (LAS float*)(lds + wave * 16384);
        const int gw = vcu * NWAVES + wave, NGW = G * NWAVES;
        constexpr int I_IN = 16 * 128, I_OUT = 16 * 32, I_UP = 16 * 176, I_DN = 44 * 32, NITEMS = I_IN + I_OUT + I_UP + I_DN;
        for (int it = gw; it < NITEMS; it += NGW) {
            int r = it;
            if (r < I_IN) { const int kb = r / 128, nb = r % 128; p0_transpose_item<true>(a.in[9], DM, INC, (bf16*)(ws + WS_WIN), 64 * kb, 32 * nb, 32 * nb, scr, lane); continue; } r -= I_IN;
            if (r < I_OUT) { const int kb = r / 32, nb = r % 32; p0_transpose_item<false>(a.in[18], DM, DM, (bf16*)(ws + WS_WOUT), 64 * kb, 32 * nb, 32 * nb, scr, lane); continue; } r -= I_OUT;
            if (r < I_UP) { const int kb = r / 176, nb = r % 176, n0 = 32 * nb; const int n1 = n0 < FF ? n0 : n0 - FF; const int orow = 256 * (n1 >> 7) + (n0 < FF ? 0 : 128) + (n1 & 127);
                p0_transpose_item<false>(a.in[21], DM, FF2, (bf16*)(ws + WS_WUP), 64 * kb, n0, orow, scr, lane); continue; } r -= I_UP;
            { const int kb = r / 32, nb = r % 32; p0_transpose_item<false>(a.in[24], FF, DM, (bf16*)(ws + WS_WDN), 64 * kb, 32 * nb, 32 * nb, scr, lane); }
        }
    }
}
__device__ __forceinline__ void p1_modulate(const Args& a, int vcu, int G, int lane, int wave) {
    const float* mod = (const float*)(a.ws + WS_MOD); bf16* XM = (bf16*)(a.ws + WS_XM);
    const int gw = vcu * NWAVES + wave, NGW = G * NWAVES;
    for (int row = gw; row < MROWS; row += NGW) {
        const float* xr = xrow_ptr(a.in[0], a.in[1], row); const float* mp = mod + (size_t)mod_index(row) * 6144;
#pragma unroll
        for (int j = 0; j < 4; ++j) { const int c = 4 * (lane + 64 * j); const f32x4 x = *(const f32x4*)(xr + c), sh = *(const f32x4*)(mp + c), sc = *(const f32x4*)(mp + 1024 + c);
            *(v2u*)(XM + (size_t)row * DM + c) = pk4(x * (sc + 1.0f) + sh); }
    }
}
__device__ __forceinline__ void ln_rows(const Args& a, const float* g, const float* bta, bool write_xm, int vcu, int G, int lane, int wave) {
    float* Y = a.out + OUT_Y; const float* mod = (const float*)(a.ws + WS_MOD); bf16* XM = (bf16*)(a.ws + WS_XM);
    const int gw = vcu * NWAVES + wave, NGW = G * NWAVES;
    for (int row = gw; row < MROWS; row += NGW) {
        float* yr = Y + (size_t)row * DM; f32x4 v[4]; float s = 0.f;
#pragma unroll
        for (int j = 0; j < 4; ++j) { v[j] = *(const f32x4*)(yr + 4 * (lane + 64 * j)); s += (v[j][0] + v[j][1]) + (v[j][2] + v[j][3]); }
        const float mean = wave_sum(s) * (1.0f / DM); float s2 = 0.f;
#pragma unroll
        for (int j = 0; j < 4; ++j) { v[j] = v[j] - mean; s2 += (v[j][0] * v[j][0] + v[j][1] * v[j][1]) + (v[j][2] * v[j][2] + v[j][3] * v[j][3]); }
        const float rstd = 1.0f / sqrtf(wave_sum(s2) * (1.0f / DM) + LN_EPS);
        const float* mp = mod + (size_t)mod_index(row) * 6144;
#pragma unroll
        for (int j = 0; j < 4; ++j) { const int c = 4 * (lane + 64 * j); const f32x4 x1 = v[j] * rstd * *(const f32x4*)(g + c) + *(const f32x4*)(bta + c);
            *(f32x4*)(yr + c) = x1;
            if (write_xm) { const f32x4 sh = *(const f32x4*)(mp + 3072 + c), sc = *(const f32x4*)(mp + 4096 + c); *(v2u*)(XM + (size_t)row * DM + c) = pk4(x1 * (sc + 1.0f) + sh); } }
    }
}
__device__ __forceinline__ void conv_gate(const Args& a, int vcu, int G, int tid) {
    const bf16* H = (const bf16*)(a.ws + WS_H); bf16* Gt = (bf16*)(a.ws + WS_G); const float* cw = a.in[22]; const float* cb = a.in[23];
    const int gt = vcu * NTHR + tid, NGT = G * NTHR; constexpr int PER_ROW = 22 * 32;
    for (int i = gt; i < MROWS * PER_ROW; i += NGT) {
        const int row = i / PER_ROW, r2 = i % PER_ROW, pn = r2 >> 5, jj = (r2 & 31) * 4;
        const int t = row < NCTX ? (row & 255) : ((row - NCTX) & 1023), L = row < NCTX ? CSEQ : LSEQ;
        const bool hp = t > 0, hn = t < L - 1;
        const int ca = 128 * pn + jj, cu = FF + ca;
        const bf16* hp0 = H + (size_t)row * FF2 + 256 * pn + jj;
        const v2u z = (v2u){0u, 0u};
        const v2u a0 = hp ? *(const v2u*)(hp0 - FF2) : z, a1 = *(const v2u*)hp0, a2 = hn ? *(const v2u*)(hp0 + FF2) : z;
        const v2u u0 = hp ? *(const v2u*)(hp0 - FF2 + 128) : z, u1 = *(const v2u*)(hp0 + 128), u2 = hn ? *(const v2u*)(hp0 + FF2 + 128) : z;
        const f32x4 wa0 = *(const f32x4*)(cw + ca), wa1 = *(const f32x4*)(cw + FF2 + ca), wa2 = *(const f32x4*)(cw + 2 * FF2 + ca), ba = *(const f32x4*)(cb + ca);
        const f32x4 wu0 = *(const f32x4*)(cw + cu), wu1 = *(const f32x4*)(cw + FF2 + cu), wu2 = *(const f32x4*)(cw + 2 * FF2 + cu), bu = *(const f32x4*)(cb + cu);
        const f32x4 A0 = (f32x4){bflo(a0.x), bfhi(a0.x), bflo(a0.y), bfhi(a0.y)}, A1 = (f32x4){bflo(a1.x), bfhi(a1.x), bflo(a1.y), bfhi(a1.y)}, A2 = (f32x4){bflo(a2.x), bfhi(a2.x), bflo(a2.y), bfhi(a2.y)};
        const f32x4 U0 = (f32x4){bflo(u0.x), bfhi(u0.x), bflo(u0.y), bfhi(u0.y)}, U1 = (f32x4){bflo(u1.x), bfhi(u1.x), bflo(u1.y), bfhi(u1.y)}, U2 = (f32x4){bflo(u2.x), bfhi(u2.x), bflo(u2.y), bfhi(u2.y)};
        const f32x4 av = A0 * wa0 + A1 * wa1 + A2 * wa2 + ba, uv = U0 * wu0 + U1 * wu1 + U2 * wu2 + bu; f32x4 gv;
#pragma unroll
        for (int k = 0; k < 4; ++k) gv[k] = siluf_(av[k]) * uv[k];
        *(v2u*)(Gt + (size_t)row * FF + ca) = pk4(gv);
    }
}
__device__ __forceinline__ float calc_lam(const Args& a, int lane) {
    const float s1 = wave_sum(a.in[10][lane] * a.in[11][lane]), s2 = wave_sum(a.in[12][lane] * a.in[13][lane]);
    return expf(s1) - expf(s2) + 0.2f;
}
constexpr int RN_SLOT = 17408, RN_NSLOT = 6, RN_OBUF = 6 * 17408;
#define RN_WAITV(n) asm volatile("s_waitcnt vmcnt(" #n ")" ::: "memory")
__device__ __forceinline__ void rnn_item(const Args& a, LAS unsigned char* lds, int item, int dir, int tid, int lane, int wave) {
    unsigned char* ws = a.ws;
    bf16* OF = (bf16*)(ws + WS_OF); bf16* OB = (bf16*)(ws + WS_OB);
    const int fr = lane & 15, g = lane >> 4, e = 16 * wave + fr;
    const bool ctx = item < 64; const int bi = ctx ? item : item - 64, b = bi >> 2, h = bi & 3;
    const int L = ctx ? CSEQ : LSEQ, row0 = ctx ? b * CSEQ : NCTX + b * LSEQ, NC = L / 16, chunk0 = row0 >> 4;
    const unsigned ldsw = (unsigned)wave * 1024u;
    {
        f32x4 acc[8];
        if (ctx) {
#pragma unroll
            for (int i = 0; i < 8; ++i) acc[i] = (f32x4){0.f, 0.f, 0.f, 0.f};
        } else { const float* s0 = a.in[4] + ((size_t)(b * 2 + dir) * 4 + h) * 16384;
#pragma unroll
            for (int i = 0; i < 8; ++i)
#pragma unroll
                for (int r = 0; r < 4; ++r) acc[i][r] = s0[(size_t)(16 * i + 4 * g + r) * 128 + e]; }
        asm volatile("s_waitcnt vmcnt(0)" ::: "memory");
        const unsigned char* img0 = ws + WS_IMG + ((size_t)(chunk0 * 4 + h) * 2 + dir) * IMG_BYTES;
        bf16* OD = dir ? OB : OF;
#define RN_STAGE(c_) do { const int cc_ = (c_) < NC ? (c_) : NC - 1; const unsigned char* src_ = img0 + (size_t)(dir ? NC - 1 - cc_ : cc_) * (8 * IMG_BYTES) + lane * 16; \
        LAS unsigned char* dst_ = lds + ((c_) % RN_NSLOT) * RN_SLOT; \
        __builtin_amdgcn_global_load_lds((const unsigned*)(src_ + ldsw), (LAS unsigned*)(dst_ + ldsw), 16, 0, 0); \
        __builtin_amdgcn_global_load_lds((const unsigned*)(src_ + ldsw + 8192), (LAS unsigned*)(dst_ + ldsw + 8192), 16, 0, 0); \
        if (wave == 0) __builtin_amdgcn_global_load_lds((const unsigned*)(src_ + 16384), (LAS unsigned*)(dst_ + 16384), 16, 0, 0); } while (0)
#define RN_FLUSH(cf_) do { const int sp_ = 2 * wave + (lane >> 5), s_ = (cf_) * 16 + sp_, t_ = dir ? L - 1 - s_ : s_; \
        const v2u w_ = *(const LAS v2u*)(lds + RN_OBUF + ((cf_) & 1) * 4096 + sp_ * 256 + (lane & 31) * 8); \
        *(v2u*)(OD + (size_t)(row0 + t_) * AW + h * 128 + (lane & 31) * 4) = w_; } while (0)
        RN_STAGE(0); RN_STAGE(1); RN_STAGE(2); RN_STAGE(3); RN_STAGE(4);
        for (int c = 0; c < NC; ++c) {
            if (wave == 0) { if (c >= 5) RN_WAITV(16); else if (c == 0) RN_WAITV(12); else if (c == 1) RN_WAITV(9); else if (c == 2) RN_WAITV(6); else if (c == 3) RN_WAITV(3); else RN_WAITV(0); }
            else { if (c >= 5) RN_WAITV(12); else if (c == 0) RN_WAITV(8); else if (c == 1) RN_WAITV(6); else if (c == 2) RN_WAITV(4); else if (c == 3) RN_WAITV(2); else RN_WAITV(0); }
            asm volatile("s_waitcnt lgkmcnt(0)" ::: "memory"); __builtin_amdgcn_s_barrier(); asm volatile("" ::: "memory");
            if (c > 0) RN_FLUSH(c - 1);
            RN_STAGE(c + 5);
            LAS unsigned char* buf = lds + (c % RN_NSLOT) * RN_SLOT;
            bf16x8 qf[4], kf[4];
#pragma unroll
            for (int kk = 0; kk < 4; ++kk) { const int off = fr * 256 + 16 * ((4 * kk + g) ^ fr); qf[kk] = *(const LAS bf16x8*)(buf + off); kf[kk] = *(const LAS bf16x8*)(buf + 4096 + off); }
            const v2u vw = *(const LAS v2u*)(buf + 12288 + e * 32 + g * 8);
            const bf16x8 vb = __builtin_bit_cast(bf16x8, (v4u){vw.x, vw.y, 0u, 0u});
            f32x4 pT = (f32x4){0.f, 0.f, 0.f, 0.f};
#pragma unroll
            for (int kk = 0; kk < 4; ++kk) pT = __builtin_amdgcn_mfma_f32_16x16x32_bf16(kf[kk], qf[kk], pT, 0, 0, 0);
#pragma unroll
            for (int r = 0; r < 4; ++r) pT[r] = (4 * g + r <= fr) ? pT[r] : 0.f;
            const bf16x8 pa = __builtin_bit_cast(bf16x8, (v4u){pk2(pT[0], pT[1]), pk2(pT[2], pT[3]), 0u, 0u});
            f32x4 o = __builtin_amdgcn_mfma_f32_16x16x32_bf16(pa, vb, (f32x4){0.f, 0.f, 0.f, 0.f}, 0, 0, 0);
#pragma unroll
            for (int kk = 0; kk < 4; ++kk) {
                const bf16x8 sb = __builtin_bit_cast(bf16x8, (v4u){pk2(acc[2 * kk][0], acc[2 * kk][1]), pk2(acc[2 * kk][2], acc[2 * kk][3]), pk2(acc[2 * kk + 1][0], acc[2 * kk + 1][1]), pk2(acc[2 * kk + 1][2], acc[2 * kk + 1][3])});
                o = __builtin_amdgcn_mfma_f32_16x16x32_bf16(qf[kk], sb, o, 0, 0, 0); }
#pragma unroll
            for (int i = 0; i < 8; ++i) { const f32x4 dc = *(const LAS f32x4*)(buf + 16384 + (16 * i + 4 * g) * 4);
                const v2u kw = *(const LAS v2u*)(buf + 8192 + (16 * i + fr) * 32 + g * 8); const bf16x8 ka = __builtin_bit_cast(bf16x8, (v4u){kw.x, kw.y, 0u, 0u});
                acc[i] = __builtin_amdgcn_mfma_f32_16x16x32_bf16(ka, vb, acc[i] * dc, 0, 0, 0); }
            { LAS bf16* ob = (LAS bf16*)(lds + RN_OBUF + (c & 1) * 4096) + (4 * g) * 128 + e;
              const unsigned w01 = pk2(o[0], o[1]), w23 = pk2(o[2], o[3]);
              ob[0] = (bf16)w01; ob[128] = (bf16)(w01 >> 16); ob[256] = (bf16)w23; ob[384] = (bf16)(w23 >> 16); }
        }
        asm volatile("s_waitcnt lgkmcnt(0)" ::: "memory"); __builtin_amdgcn_s_barrier(); asm volatile("" ::: "memory");
        RN_FLUSH(NC - 1);
#undef RN_STAGE
#undef RN_FLUSH
        asm volatile("s_waitcnt vmcnt(0)" ::: "memory");
        if (ctx) { float* so = a.out + OUT_S + ((size_t)(b * 2 + dir) * 4 + h) * 16384;
#pragma unroll
            for (int i = 0; i < 8; ++i)
#pragma unroll
                for (int r = 0; r < 4; ++r) so[(size_t)(16 * i + 4 * g + r) * 128 + e] = acc[i][r]; }
        __threadfence(); __syncthreads();
    }
    __syncthreads();
}
__device__ __forceinline__ void rnn_finalize(const Args& a, int vcu, int G, int lane, int wave) {
    unsigned char* ws = a.ws;
    const bf16* RG = (const bf16*)(ws + WS_RG); const bf16* OF = (const bf16*)(ws + WS_OF); const bf16* OB = (const bf16*)(ws + WS_OB); bf16* MIX = (bf16*)(ws + WS_MIX); const float* rnng = a.in[17];
    const int gw = vcu * NWAVES + wave, NGW = G * NWAVES;
    float2 gn[4];
#pragma unroll
    for (int h = 0; h < 4; ++h) gn[h] = *(const float2*)(rnng + h * 128 + 2 * lane);
    for (int r0 = gw * 2; r0 < MROWS; r0 += NGW * 2) {
        unsigned o1[2][4], o2[2][4], gw_[2][4];
#pragma unroll
        for (int j = 0; j < 2; ++j)
#pragma unroll
            for (int h = 0; h < 4; ++h) { const size_t o = (size_t)(r0 + j) * AW + h * 128 + 2 * lane; o1[j][h] = *(const unsigned*)(OF + o); o2[j][h] = *(const unsigned*)(OB + o); gw_[j][h] = *(const unsigned*)(RG + o); }
#pragma unroll
        for (int j = 0; j < 2; ++j)
#pragma unroll
            for (int h = 0; h < 4; ++h) { const float ox = bflo(o1[j][h]) + bflo(o2[j][h]), oy = bfhi(o1[j][h]) + bfhi(o2[j][h]); const float ss = wave_sum(ox * ox + oy * oy); const float r = __builtin_amdgcn_rsqf(ss * (1.0f / 128.0f) + LN_EPS);
                *(unsigned*)(MIX + (size_t)(r0 + j) * DM + AW + h * 128 + 2 * lane) = pk2(ox * r * gn[h].x * bflo(gw_[j][h]), oy * r * gn[h].y * bfhi(gw_[j][h])); }
    }
}
typedef float f32x16 __attribute__((ext_vector_type(16)));
constexpr int AT_K = 0, AT_V = 32768, AT_TILE = 16384;
__device__ __forceinline__ int crow16(int r, int hi) { return (r & 3) + 8 * (r >> 2) + 4 * hi; }
__device__ __forceinline__ void attn_unit(const Args& a, LAS unsigned char* lds, int unit, float lam, int tid, int lane, int wave) {
    unsigned char* ws = a.ws;
    const bool ctx = unit >= 256; const int ui = ctx ? unit - 256 : unit;
    const int qb = ctx ? (ui & 1) : (ui & 7), bh = ctx ? (ui >> 1) : (ui >> 3), b = bh >> 2, h = bh & 3;
    const int nk = ctx ? CSEQ : LKEYS, NT = nk / 64, row0 = (ctx ? b * CSEQ : NCTX + b * LSEQ) + qb * 128;
    const bf16* Kp = (const bf16*)(ws + (ctx ? WS_KC : WS_KL)) + (size_t)b * nk * AW + h * 128;
    const bf16* Vp = (const bf16*)(ws + (ctx ? WS_VC : WS_VL)) + (size_t)bh * 128 * nk;
    const int rg = wave & 3, map = wave >> 2, r32 = lane & 31, hi = lane >> 5;
    const int qrow = row0 + rg * 32 + r32;
    bf16x8 qf[4];
    { const bf16* qp = (const bf16*)(ws + WS_Q) + (size_t)qrow * AW + h * 128 + map * 64 + 8 * hi;
#pragma unroll
      for (int ks = 0; ks < 4; ++ks) qf[ks] = *(const bf16x8*)(qp + 16 * ks); }
    const int krow = tid >> 4, kch = tid & 15, ve = tid >> 3, vch = tid & 7, vxx = (ve >> 1) & 15;
    const unsigned ksrc = (unsigned)(krow * AW + kch * 8), vsrc = (unsigned)(ve * nk + vch * 8);
    const int kdst = AT_K + 256 * krow + 16 * (kch ^ (((krow & 3) << 2) | ((krow >> 2) & 3))), vdst = AT_V + 128 * ve + 16 * (vch ^ (vxx >> 1)); const bool vswap = vxx & 1;
    v4u kr[2], vr[2];
#define AT_LOAD(t) do { _Pragma("unroll") for (int i_ = 0; i_ < 2; ++i_) { kr[i_] = *(const v4u*)(Kp + ksrc + (size_t)((t) * 64 + 32 * i_) * AW); vr[i_] = *(const v4u*)(Vp + vsrc + (size_t)(64 * i_) * nk + (t) * 64); } } while (0)
#define AT_STORE(bufo) do { _Pragma("unroll") for (int i_ = 0; i_ < 2; ++i_) { *(LAS v4u*)(lds + (bufo) + kdst + 8192 * i_) = kr[i_]; \
        const v4u vv_ = vswap ? (v4u){vr[i_].z, vr[i_].w, vr[i_].x, vr[i_].y} : vr[i_]; *(LAS v4u*)(lds + (bufo) + vdst + 8192 * i_) = vv_; } } while (0)
    int koff[4];
    { const int x = ((r32 & 3) << 2) | ((r32 >> 2) & 3);
#pragma unroll
      for (int ks = 0; ks < 4; ++ks) koff[ks] = AT_K + 256 * r32 + 16 * ((8 * map + 2 * ks + hi) ^ x); }
    const int vbase = AT_V + 128 * r32, vx = 8 * ((r32 >> 1) & 15);
    f32x16 O[4];
#pragma unroll
    for (int eb = 0; eb < 4; ++eb)
#pragma unroll
        for (int r = 0; r < 16; ++r) O[eb][r] = 0.f;
    float m_run = -1.0e30f, l_run = 0.f;
    AT_LOAD(0); AT_STORE(0);
    if (NT > 1) AT_LOAD(1);
    __syncthreads();
    for (int t = 0; t < NT; ++t) {
        const int cur = (t & 1) * AT_TILE;
        f32x16 st[2];
#pragma unroll
        for (int mb = 0; mb < 2; ++mb) {
#pragma unroll
            for (int r = 0; r < 16; ++r) st[mb][r] = 0.f;
#pragma unroll
            for (int ks = 0; ks < 4; ++ks) { const bf16x8 kf = *(const LAS bf16x8*)(lds + cur + koff[ks] + 8192 * mb); st[mb] = __builtin_amdgcn_mfma_f32_32x32x16_bf16(kf, qf[ks], st[mb], 0, 0, 0); } }
        if (t + 1 < NT) { AT_STORE(AT_TILE - cur); if (t + 2 < NT) AT_LOAD(t + 2); }
        float mx = st[0][0];
#pragma unroll
        for (int r = 1; r < 16; ++r) mx = fmaxf(mx, st[0][r]);
#pragma unroll
        for (int r = 0; r < 16; ++r) mx = fmaxf(mx, st[1][r]);
        mx = fmaxf(mx, __shfl_xor(mx, 32));
        if (__any(mx > m_run)) { const float mn = fmaxf(m_run, mx), f = __builtin_amdgcn_exp2f(m_run - mn); m_run = mn; l_run *= f;
#pragma unroll
            for (int eb = 0; eb < 4; ++eb)
#pragma unroll
                for (int r = 0; r < 16; ++r) O[eb][r] *= f; }
        bf16x8 pf[2][2]; float ls = 0.f;
#pragma unroll
        for (int mb = 0; mb < 2; ++mb) {
#pragma unroll
            for (int r = 0; r < 16; ++r) { st[mb][r] = __builtin_amdgcn_exp2f(st[mb][r] - m_run); ls += st[mb][r]; }
#pragma unroll
            for (int sp = 0; sp < 2; ++sp) pf[mb][sp] = __builtin_bit_cast(bf16x8, (v4u){pk2(st[mb][8 * sp], st[mb][8 * sp + 1]), pk2(st[mb][8 * sp + 2], st[mb][8 * sp + 3]), pk2(st[mb][8 * sp + 4], st[mb][8 * sp + 5]), pk2(st[mb][8 * sp + 6], st[mb][8 * sp + 7])}); }
        l_run += ls;
#pragma unroll
        for (int eb = 0; eb < 4; ++eb) { __builtin_amdgcn_sched_barrier(0);
#pragma unroll
            for (int mb = 0; mb < 2; ++mb)
#pragma unroll
                for (int sp = 0; sp < 2; ++sp) { const int u1 = 8 * mb + 4 * sp + hi;
                    const v2u lo = *(const LAS v2u*)(lds + cur + vbase + 4096 * eb + ((8 * u1) ^ vx)), hv = *(const LAS v2u*)(lds + cur + vbase + 4096 * eb + ((8 * (u1 + 2)) ^ vx));
                    O[eb] = __builtin_amdgcn_mfma_f32_32x32x16_bf16(__builtin_bit_cast(bf16x8, (v4u){lo.x, lo.y, hv.x, hv.y}), pf[mb][sp], O[eb], 0, 0, 0); } }
        __syncthreads();
    }
#undef AT_LOAD
#undef AT_STORE
    l_run += __shfl_xor(l_run, 32);
    LAS float* ex = (LAS float*)lds + (size_t)rg * 4096 + lane;
    if (map == 1) { const float sc = lam / l_run;
#pragma unroll
        for (int eb = 0; eb < 4; ++eb)
#pragma unroll
            for (int r = 0; r < 16; ++r) ex[(eb * 16 + r) * 64] = O[eb][r] * sc; }
    __syncthreads();
    if (map == 0) { const float il = 1.0f / l_run; float ss = 0.f;
#pragma unroll
        for (int eb = 0; eb < 4; ++eb)
#pragma unroll
            for (int r = 0; r < 16; ++r) { const float v = O[eb][r] * il - ex[(eb * 16 + r) * 64]; O[eb][r] = v; ss += v * v; }
        ss += __shfl_xor(ss, 32);
        const float rn = 0.8f / sqrtf(ss * (1.0f / 128.0f) + LN_EPS); const float* ag = a.in[16] + h * 128;
        bf16* mp = (bf16*)(ws + WS_MIX) + (size_t)qrow * DM + h * 128;
#pragma unroll
        for (int eb = 0; eb < 4; ++eb)
#pragma unroll
            for (int rq = 0; rq < 4; ++rq) { const int e0 = 32 * eb + 8 * rq + 4 * hi; const f32x4 gn = *(const f32x4*)(ag + e0);
                f32x4 o4; o4[0] = O[eb][4 * rq] * rn * gn[0]; o4[1] = O[eb][4 * rq + 1] * rn * gn[1]; o4[2] = O[eb][4 * rq + 2] * rn * gn[2]; o4[3] = O[eb][4 * rq + 3] * rn * gn[3];
                *(v2u*)(mp + e0) = pk4(o4); } }
    __syncthreads();
}
__device__ __forceinline__ void mixer_phase(const Args& a, LAS unsigned char* lds, int tid, int lane, int wave, int rep) {
    unsigned* ctr = (unsigned*)(a.ws + WS_CTL) + 256 + 64 * rep;
    volatile LAS unsigned* slot = (volatile LAS unsigned*)(lds + MISC_OFF + 64);
    const float lam = calc_lam(a, lane);
    for (;;) {
        if (tid == 0) slot[0] = __hip_atomic_fetch_add(ctr, 1u, __ATOMIC_RELAXED, __HIP_MEMORY_SCOPE_AGENT);
        __syncthreads();
        const int it = (int)slot[0];
        __syncthreads();
        if (it >= 576) break;
        int tid_ = tid; asm volatile("" : "+v"(tid_));
        const int lane_ = tid_ & 63;
#ifndef PROBE_SKIP
#define PROBE_SKIP 0
#endif
        const bool do_rnn = !(rep == 1 && PROBE_SKIP == 1), do_att = !(rep == 1 && PROBE_SKIP == 2);
        if (it < 64) { if (do_rnn) rnn_item(a, lds, 64 + (it >> 1), it & 1, tid_, lane_, wave); }
        else if (it < 320) { if (do_att) attn_unit(a, lds, it - 64, lam, tid_, lane_, wave); }
        else if (it < 448) { if (do_rnn) rnn_item(a, lds, (it - 320) >> 1, it & 1, tid_, lane_, wave); }
        else if (do_att) attn_unit(a, lds, 256 + (it - 448), lam, tid_, lane_, wave);
    }
}
#ifndef MK_N_LAUNCHES
#define MK_N_LAUNCHES 1
#endif
constexpr int NPH = 11;
#ifndef PROBE_PH
#define PROBE_PH -1
#endif
#ifndef PROBE_MASK
#if PROBE_PH >= 0
#define PROBE_MASK (1 << PROBE_PH)
#else
#define PROBE_MASK 0
#endif
#endif
#define PRB(k) ((PROBE_MASK >> (k)) & 1)
#define REPS(k) for (int rep_ = 0; rep_ < (PRB(k) ? 2 : 1); ++rep_, (PRB(k) && rep_ == 1) ? xcd_barrier(bar) : (void)0)
__global__ void __launch_bounds__(NTHR, 2) fwd(Args args) {
    extern __shared__ __attribute__((aligned(16))) unsigned char lds_[];
    LAS unsigned char* lds = (LAS unsigned char*)lds_;
    const int tid = threadIdx.x, lane = tid & 63, wave = __builtin_amdgcn_readfirstlane(tid >> 6);
    const int G = gridDim.x, bx = blockIdx.x, vcu = (G % 8 == 0) ? (bx % 8) * (G / 8) + bx / 8 : bx;
    unsigned char* ws = args.ws;
    for (int u = tid; u < (LDS_BYTES - RING_BYTES) / 4; u += NTHR) ((LAS unsigned*)(lds + RING_BYTES))[u] = 0u;
    __syncthreads();
    const int lo = args.ph_lo, hi = args.ph_hi;
    XcdBarrier bar; bar.bar = (unsigned*)(ws + WS_CTL) + CW_BAR; bar.x = 0; bar.st = nullptr;
    if (hi - lo > 1) bar = xcd_barrier_post((unsigned*)(ws + WS_CTL) + CW_BAR, (volatile LAS unsigned*)(lds + MISC_OFF) + 8);
#define IN(k) (lo <= (k) && (k) < hi)
#define SEAM(k) do { if (IN(k) && IN((k) + 1)) xcd_barrier(bar); } while (0)
    float* mod = (float*)(ws + WS_MOD);
    if (IN(0)) { REPS(0) p0_prologue(args, lds, vcu, G, tid, lane, wave); SEAM(0); }
    if (IN(1)) { REPS(1) p1_modulate(args, vcu, G, lane, wave); SEAM(1); }
    if (IN(2)) {
        pg8::Gemm g{(const bf16*)(ws + WS_XM), (const bf16*)(ws + WS_WIN), MROWS, INC, DM}; pg8::StaticOrder S; S.init(MROWS, INC, G, bx);
        Epi1 E{(bf16*)(ws + WS_Q), (bf16*)(ws + WS_KC), (bf16*)(ws + WS_VC), (bf16*)(ws + WS_KL), (bf16*)(ws + WS_VL), (bf16*)(ws + WS_RG), ws + WS_IMG,
               args.out + OUT_K, args.out + OUT_V, (const float*)(ws + WS_ROPE), args.in[14], args.in[15]};
        REPS(2) pg8::gemm_phase<Epi1, pg8::StaticOrder, true, true>(lds, g, S, E);
        SEAM(2);
    }
    if (IN(3)) {
        REPS(3) mixer_phase(args, lds, tid, lane, wave, rep_);
        SEAM(3);
    }
    if (IN(4)) { rnn_finalize(args, vcu, G, lane, wave); SEAM(4); }
    if (IN(5)) {
        pg8::Gemm g{(const bf16*)(ws + WS_MIX), (const bf16*)(ws + WS_WOUT), MROWS, DM, DM}; pg8::StaticOrder S; S.init(MROWS, DM, G, bx);
        EpiRes E{args.in[0], args.in[1], nullptr, args.out + OUT_Y, mod + 2048};
        REPS(5) pg8::gemm_phase<EpiRes, pg8::StaticOrder, true, true>(lds, g, S, E);
        SEAM(5);
    }
    if (IN(6)) { ln_rows(args, args.in[19], args.in[20], true, vcu, G, lane, wave); SEAM(6); }
    if (IN(7)) {
        pg8::Gemm g{(const bf16*)(ws + WS_XM), (const bf16*)(ws + WS_WUP), MROWS, FF2, DM}; pg8::StaticOrder S; S.init(MROWS, FF2, G, bx);
        EpiH E{(bf16*)(ws + WS_H)};
        REPS(7) pg8::gemm_phase<EpiH, pg8::StaticOrder, true, true>(lds, g, S, E);
        SEAM(7);
    }
    if (IN(8)) { REPS(8) conv_gate(args, vcu, G, tid); SEAM(8); }
    if (IN(9)) {
        pg8::Gemm g{(const bf16*)(ws + WS_G), (const bf16*)(ws + WS_WDN), MROWS, DM, FF}; pg8::StaticOrder S; S.init(MROWS, DM, G, bx);
        EpiRes E{args.in[0], args.in[1], args.out + OUT_Y, args.out + OUT_Y, mod + 5120};
        pg8::gemm_phase<EpiRes, pg8::StaticOrder, true, true>(lds, g, S, E);
        SEAM(9);
    }
    if (IN(10)) { ln_rows(args, args.in[25], args.in[26], false, vcu, G, lane, wave); }
#undef IN
#undef SEAM
}

extern "C" void kernel_launch(void* const* d_in, const int* in_sizes, int n_in, void* d_out, int out_size, void* d_ws, size_t ws_size, hipStream_t stream) {
    static int grid = 0;
    if (grid == 0) {
        if (n_in != 27 || out_size != 18874368 || ws_size < WS_END) { fprintf(stderr, "kernel_launch: unexpected shapes (n_in %d, out %d, ws %zu)\n", n_in, out_size, ws_size); grid = -1; return; }
        int dev = 0, cus = 0, per_cu = 0;
        if (hipGetDevice(&dev) != hipSuccess || hipDeviceGetAttribute(&cus, hipDeviceAttributeMultiprocessorCount, dev) != hipSuccess) { grid = -1; return; }
        if (hipFuncSetAttribute((const void*)fwd, hipFuncAttributeMaxDynamicSharedMemorySize, LDS_BYTES) != hipSuccess) { fprintf(stderr, "kernel_launch: hipFuncSetAttribute failed\n"); grid = -1; return; }
        if (hipOccupancyMaxActiveBlocksPerMultiprocessor(&per_cu, (const void*)fwd, NTHR, LDS_BYTES) != hipSuccess || per_cu < 1) { fprintf(stderr, "kernel_launch: occupancy query reports %d\n", per_cu); per_cu = 1; }
        (void)hipGetLastError();
        grid = cus;
    }
    if (grid < 0) return;
    (void)hipMemsetAsync((char*)d_ws + WS_CTL, 0, CTL_ZERO_BYTES, stream);
    Args a{};
    for (int i = 0; i < 27; ++i) a.in[i] = (const float*)d_in[i];
    a.out = (float*)d_out; a.ws = (unsigned char*)d_ws;
    if (MK_N_LAUNCHES == 1) { a.ph_lo = 0; a.ph_hi = NPH; hipLaunchKernelGGL(fwd, dim3(grid), dim3(NTHR), LDS_BYTES, stream, a); }
    else for (int li = 0; li < NPH; ++li) { a.ph_lo = li; a.ph_hi = li + 1; hipLaunchKernelGGL(fwd, dim3(grid), dim3(NTHR), LDS_BYTES, stream, a); }
}
```
